# Optimizing an MI355X kernel written in HIP

```python
import jax
import jax.numpy as jnp
from jax import lax
import numpy as np

D_MODEL = 2048
BATCH = 4
SEQ = 4096
DEPTH = 4

N_META = 16
BLOCK = 128
FRONT_PAD = (-N_META) % BLOCK
N_A_LAYERS = DEPTH // 2
N_B_LAYERS = DEPTH - N_A_LAYERS
RWKV_HEAD = 64
RWKV_HEADS = D_MODEL // RWKV_HEAD
LORA_DECAY = 96
LORA_ICLR = 96
LORA_VRES = 64
LORA_GATE = 256
SB_HEAD = 128
SB_HEADS = D_MODEL // SB_HEAD
D_FF = -(-8 * D_MODEL // (3 * 256)) * 256
RMS_EPS = 1e-6
GN_EPS = 64e-5

kernel_name = 'hybrid_rwkv7_stickbreaking_yoco'


def _rms_norm(x, g):
    xf = x.astype(jnp.float32)
    y = xf * lax.rsqrt(jnp.mean(xf * xf, axis=-1, keepdims=True) + RMS_EPS)
    return (y * g.astype(jnp.float32)).astype(x.dtype)


def _swiglu(x, w_gate, w_up, w_down):
    return (jax.nn.silu(x @ w_gate) * (x @ w_up)) @ w_down


def _token_shift(x):
    return jnp.pad(x, ((0, 0), (1, 0), (0, 0)))[:, :-1]


def _rwkv7_time_mix(h, v_first, mu, w_r, w_k, w_v, w_o, dec_w0, dec_w1, dec_w2,
                    a_w0, a_w1, a_w2, g_w1, g_w2, k_k, k_a, r_k, gn_w, gn_b, vres):
    b, l, d = h.shape
    xx = _token_shift(h) - h
    xr, xw, xk, xv, xa, xg = (h + xx * mu[i] for i in range(6))
    r = xr @ w_r
    k = xk @ w_k
    v = xv @ w_v
    w = -jax.nn.softplus(-(dec_w0 + jnp.tanh(xw @ dec_w1) @ dec_w2)) - 0.5
    decay = jnp.exp(-jnp.exp(w.astype(jnp.float32)))
    a = jax.nn.sigmoid(a_w0 + (xa @ a_w1) @ a_w2)
    g = jax.nn.sigmoid(xg @ g_w1) @ g_w2
    if vres is None:
        v_first = v
    else:
        v_w0, v_w1, v_w2 = vres
        v = v + (v_first - v) * jax.nn.sigmoid(v_w0 + (xv @ v_w1) @ v_w2)
    heads = lambda t: t.reshape(b, l, RWKV_HEADS, RWKV_HEAD).astype(jnp.float32)
    kk = heads(k * k_k)
    kk = kk * lax.rsqrt(jnp.maximum(jnp.sum(kk * kk, axis=-1, keepdims=True), 1e-24))
    k = k * (1.0 + (a - 1.0) * k_a)
    rh, kh, vh, ah, dh = heads(r), heads(k), heads(v), heads(a), heads(decay)

    def step(state, inp):
        r_t, d_t, k_t, v_t, kk_t, a_t = inp
        sa = jnp.einsum('bhvk,bhk->bhv', state, -kk_t)
        state = (state * d_t[:, :, None, :]
                 + sa[..., None] * (kk_t * a_t)[:, :, None, :]
                 + v_t[..., None] * k_t[:, :, None, :])
        return state, jnp.einsum('bhvk,bhk->bhv', state, r_t)

    seq_first = lambda t: jnp.swapaxes(t, 0, 1)
    s0 = jnp.zeros((b, RWKV_HEADS, RWKV_HEAD, RWKV_HEAD), jnp.float32)
    _, y = lax.scan(step, s0, tuple(seq_first(t) for t in (rh, dh, kh, vh, kk, ah)))
    y = seq_first(y)
    mean = jnp.mean(y, axis=-1, keepdims=True)
    var = jnp.mean(jnp.square(y - mean), axis=-1, keepdims=True)
    y = ((y - mean) * lax.rsqrt(var + GN_EPS)).reshape(b, l, d) * gn_w + gn_b
    bonus = (jnp.sum(rh * kh * r_k, axis=-1, keepdims=True) * vh).reshape(b, l, d)
    out = ((y + bonus).astype(h.dtype) * g) @ w_o
    return out, v_first


def _pad_front_heads(t):
    return jnp.pad(t, ((0, 0), (FRONT_PAD, 0), (0, 0), (0, 0))).transpose(0, 2, 1, 3)


def _shared_kv(h, w_k, w_v, k_gain):
    b, l, _ = h.shape
    k = _rms_norm((h @ w_k).reshape(b, l, SB_HEADS, SB_HEAD), k_gain)
    v = (h @ w_v).reshape(b, l, SB_HEADS, SB_HEAD)
    return _pad_front_heads(k), _pad_front_heads(v)


def _stick_breaking(h, k, v, w_q, q_gain, w_o):
    b, l, d = h.shape
    q = _pad_front_heads(_rms_norm((h @ w_q).reshape(b, l, SB_HEADS, SB_HEAD), q_gain))
    p = l + FRONT_PAD
    nb = p // BLOCK
    q_blocks = q.reshape(b, SB_HEADS, nb, BLOCK, SB_HEAD).transpose(2, 0, 1, 3, 4)
    key_pos = jnp.arange(p)
    scale = SB_HEAD ** -0.5

    def one_block(args):
        q_blk, blk = args
        q_pos = blk * BLOCK + jnp.arange(BLOCK)
        valid = (key_pos[None, :] < q_pos[:, None]) & (key_pos[None, :] >= FRONT_PAD)
        z = jnp.einsum('bhqd,bhkd->bhqk', q_blk, k).astype(jnp.float32) * scale
        log_keep = jnp.where(valid, -jax.nn.softplus(z), 0.0)
        later = lax.cumsum(log_keep, axis=3, reverse=True) - log_keep
        weights = jnp.where(valid, jnp.exp(jax.nn.log_sigmoid(z) + later), 0.0)
        return jnp.einsum('bhqk,bhkd->bhqd', weights.astype(v.dtype), v)

    o = lax.map(one_block, (q_blocks, jnp.arange(nb)))
    o = o.transpose(1, 0, 3, 2, 4).reshape(b, p, d)[:, FRONT_PAD:]
    return o @ w_o


def setup_inputs(seed: int = 0) -> dict:
    key = jax.random.key(seed)
    ks = iter(jax.random.split(key, 48))
    f32 = jnp.float32

    def nrm(shape, scale):
        return jax.random.normal(next(ks), shape, f32) * scale

    def unif(shape, lo, hi):
        return jax.random.uniform(next(ks), shape, f32, lo, hi)

    D, F, NA, NB = D_MODEL, D_FF, N_A_LAYERS, N_B_LAYERS
    d_in = D ** -0.5
    d_out = D ** -0.5 * (2 * DEPTH) ** -0.5
    return {
        'x': nrm((BATCH, SEQ, D), 1.0),
        'meta_tokens': nrm((N_META, D), 1.0),
        'mix_norm_g': 1.0 + nrm((DEPTH, D), 0.02),
        'ffn_norm_g': 1.0 + nrm((DEPTH, D), 0.02),
        'ffn_w_gate': nrm((DEPTH, D, F), d_in),
        'ffn_w_up': nrm((DEPTH, D, F), d_in),
        'ffn_w_down': nrm((DEPTH, F, D), F ** -0.5 * (2 * DEPTH) ** -0.5),
        'rwkv_mu': unif((NA, 6, D), 0.0, 1.0),
        'rwkv_w_r': nrm((NA, D, D), d_in),
        'rwkv_w_k': nrm((NA, D, D), d_in),
        'rwkv_w_v': nrm((NA, D, D), d_in),
        'rwkv_w_o': nrm((NA, D, D), d_out),
        'rwkv_dec_w0': unif((NA, D), -6.0, -1.0),
        'rwkv_dec_w1': nrm((NA, D, LORA_DECAY), d_in),
        'rwkv_dec_w2': nrm((NA, LORA_DECAY, D), 0.1 * LORA_DECAY ** -0.5),
        'rwkv_a_w0': nrm((NA, D), 0.1),
        'rwkv_a_w1': nrm((NA, D, LORA_ICLR), d_in),
        'rwkv_a_w2': nrm((NA, LORA_ICLR, D), 0.1 * LORA_ICLR ** -0.5),
        'rwkv_g_w1': nrm((NA, D, LORA_GATE), d_in),
        'rwkv_g_w2': nrm((NA, LORA_GATE, D), LORA_GATE ** -0.5),
        'rwkv_k_k': 0.85 + nrm((NA, D), 0.02),
        'rwkv_k_a': 1.0 + nrm((NA, D), 0.02),
        'rwkv_r_k': nrm((NA, RWKV_HEADS, RWKV_HEAD), 0.1),
        'rwkv_gn_w': 1.0 + nrm((NA, D), 0.02),
        'rwkv_gn_b': nrm((NA, D), 0.02),
        'rwkv_v_w0': 1.0 + nrm((NA - 1, D), 0.1),
        'rwkv_v_w1': nrm((NA - 1, D, LORA_VRES), d_in),
        'rwkv_v_w2': nrm((NA - 1, LORA_VRES, D), 0.1 * LORA_VRES ** -0.5),
        'kv_norm_g': 1.0 + nrm((D,), 0.02),
        'sb_w_k': nrm((D, D), d_in),
        'sb_w_v': nrm((D, D), d_in),
        'sb_k_gain': 1.0 + nrm((SB_HEAD,), 0.02),
        'sb_w_q': nrm((NB, D, D), d_in),
        'sb_q_gain': 1.0 + nrm((NB, SB_HEAD), 0.02),
        'sb_w_o': nrm((NB, D, D), d_out),
    }


def reference(x, meta_tokens, mix_norm_g, ffn_norm_g, ffn_w_gate, ffn_w_up, ffn_w_down,
              rwkv_mu, rwkv_w_r, rwkv_w_k, rwkv_w_v, rwkv_w_o, rwkv_dec_w0, rwkv_dec_w1,
              rwkv_dec_w2, rwkv_a_w0, rwkv_a_w1, rwkv_a_w2, rwkv_g_w1, rwkv_g_w2, rwkv_k_k,
              rwkv_k_a, rwkv_r_k, rwkv_gn_w, rwkv_gn_b, rwkv_v_w0, rwkv_v_w1, rwkv_v_w2,
              kv_norm_g, sb_w_k, sb_w_v, sb_k_gain, sb_w_q, sb_q_gain, sb_w_o):
    b = x.shape[0]
    meta = jnp.broadcast_to(meta_tokens[None].astype(x.dtype), (b, N_META, D_MODEL))
    h = jnp.concatenate([meta, x], axis=1)
    v_first = None
    k_shared = v_shared = None
    for layer in range(DEPTH):
        hn = _rms_norm(h, mix_norm_g[layer])
        if layer < N_A_LAYERS:
            i = layer
            vres = None if i == 0 else (rwkv_v_w0[i - 1], rwkv_v_w1[i - 1], rwkv_v_w2[i - 1])
            mix, v_first = _rwkv7_time_mix(
                hn, v_first, rwkv_mu[i], rwkv_w_r[i], rwkv_w_k[i], rwkv_w_v[i], rwkv_w_o[i],
                rwkv_dec_w0[i], rwkv_dec_w1[i], rwkv_dec_w2[i], rwkv_a_w0[i], rwkv_a_w1[i],
                rwkv_a_w2[i], rwkv_g_w1[i], rwkv_g_w2[i], rwkv_k_k[i], rwkv_k_a[i], rwkv_r_k[i],
                rwkv_gn_w[i], rwkv_gn_b[i], vres)
        else:
            j = layer - N_A_LAYERS
            if j == 0:
                k_shared, v_shared = _shared_kv(_rms_norm(h, kv_norm_g), sb_w_k, sb_w_v, sb_k_gain)
            mix = _stick_breaking(hn, k_shared, v_shared, sb_w_q[j], sb_q_gain[j], sb_w_o[j])
        h = h + mix
        h = h + _swiglu(_rms_norm(h, ffn_norm_g[layer]), ffn_w_gate[layer], ffn_w_up[layer],
                        ffn_w_down[layer])
    return h[:, N_META:]
```

```cpp
#include <hip/hip_runtime.h>
#include <hip/hip_cooperative_groups.h>
#include <cstdio>
namespace cg = cooperative_groups;

#define LAS __attribute__((address_space(3)))
typedef unsigned short bf16_t;
typedef short bf16x8 __attribute__((ext_vector_type(8)));
typedef float f32x4 __attribute__((ext_vector_type(4)));
typedef unsigned u32x2 __attribute__((ext_vector_type(2)));
typedef unsigned u32x4 __attribute__((ext_vector_type(4)));

constexpr int D = 2048, FF = 5632, NBATCH = 4, SEQ = 4096, NMETA = 16, L = SEQ + NMETA;
constexpr int M = NBATCH * L;
constexpr int MMAIN = NBATCH * SEQ;
constexpr int MP = 16640;
constexpr int NTHR = 512;
constexpr int PPAD = 112, PLEN = 4224;

constexpr size_t SZB = (size_t)MP * D * 2, SZF = 2 * SZB;
constexpr size_t OFF_WA = 0;
constexpr size_t OFF_WB = 37748736;
constexpr size_t OFF_HT = OFF_WB + 83886080;
constexpr size_t OFF_RB = OFF_HT + 1048576;
constexpr size_t OFF_VFIRST = OFF_RB + SZB;
constexpr size_t OFF_KF = OFF_VFIRST + SZB;
constexpr size_t OFF_VF = OFF_KF + SZF;
constexpr size_t OFF_DEC = OFF_VF + SZF;
constexpr size_t OFF_MIX = OFF_DEC + SZF;
constexpr size_t OFF_LORA = OFF_MIX + 3 * SZB;
constexpr size_t SZLORA = (size_t)MP * 256 * 2;
constexpr size_t WS_END = OFF_LORA + 4 * SZLORA;
constexpr size_t OFF_HN2 = OFF_KF, OFF_ACT = OFF_KF + SZB;
constexpr size_t WA_W0 = 0, WA_W1 = 8388608, WA_W2 = 16777216, WA_L1 = 25165824, WA_L2 = 29360128, WSLOT = 1048576;
constexpr size_t WB_WO = 0, WB_F1 = 8388608, WB_F2 = WB_F1 + (size_t)2 * FF * D * 2;

struct Params {
    const float* in[35];
    float* out;
    unsigned char* ws;
};

__device__ __forceinline__ int rowof(int b, int t) { return t < NMETA ? MMAIN + b * NMETA + t : b * SEQ + (t - NMETA); }
__device__ __forceinline__ float* hrow(const Params& P, int r) {
    return r < MMAIN ? P.out + (size_t)r * D : (float*)(P.ws + OFF_HT) + (size_t)(r - MMAIN) * D;
}
__device__ __forceinline__ unsigned cvt_pk_bf16(float lo, float hi) { unsigned r; asm volatile("v_cvt_pk_bf16_f32 %0, %1, %2" : "=v"(r) : "v"(lo), "v"(hi)); return r; }
__device__ __forceinline__ float bf_lo(unsigned x) { return __uint_as_float(x << 16); }
__device__ __forceinline__ float bf_hi(unsigned x) { return __uint_as_float(x & 0xffff0000u); }
template <int CTRL> __device__ __forceinline__ float dpp_mov(float x) {
    return __int_as_float(__builtin_amdgcn_update_dpp(0, __float_as_int(x), CTRL, 0xF, 0xF, true));
}
__device__ __forceinline__ float rowsum16(float x) {
    x += dpp_mov<0x128>(x); x += dpp_mov<0x124>(x); x += dpp_mov<0x122>(x); x += dpp_mov<0x121>(x); return x;
}
__device__ __forceinline__ float wavesum(float x) { x = rowsum16(x); x += __shfl_xor(x, 16); x += __shfl_xor(x, 32); return x; }
__device__ __forceinline__ int otid() { int t = threadIdx.x; asm volatile("" : "+v"(t)); return t; }
__device__ __forceinline__ int obid() { int t = blockIdx.x; asm volatile("" : "+s"(t)); return t; }
__device__ __forceinline__ float sigmoidf_(float x) { return 1.0f / (1.0f + __expf(-x)); }

constexpr int BM = 256, BK = 64, HALF = 128, HTB = HALF * BK * 2, NXCD = 8, WGM = 8, NMT = MMAIN / BM;
__device__ __forceinline__ int lds_byte(int r, int c) { const int st = (r >> 4) * 2 + (c >> 5), rr = r & 15, cc = c & 31, ob = rr * 64 + cc * 2; return st * 1024 + (ob ^ (((ob >> 9) & 1) << 5)); }
__device__ __forceinline__ void stage_rc(int b, int& R, int& C) { const int st = b / 1024, sb = b % 1024, swz = sb ^ (((sb >> 9) & 1) << 5); R = (st >> 1) * 16 + swz / 64; C = (st & 1) * 32 + (swz % 64) / 2; }

struct GD { unsigned long long A, Bt, o0, o1; int N, mode, bin, boff, ldo, pad; };
struct PE { int kind, layer, sub, ng, K, pad; GD g[4]; };
struct Unit { int pm, pn, gi; };

__device__ __forceinline__ bool sched_next(const int Lx, const int c1, const int c2, const int c3, const int c4, Unit& u) {
    if (Lx >= c4) return false;
    int gi = 0, base = 0, top = c1;
    if (Lx >= c1) { gi = 1; base = c1; top = c2; }
    if (Lx >= c2) { gi = 2; base = c2; top = c3; }
    if (Lx >= c3) { gi = 3; base = c3; top = c4; }
    const int nM = NMT, nwg = top - base, nN = nwg / NMT;
    int wgid = Lx - base; { const int q = nwg / NXCD, r = nwg % NXCD, xcd = wgid % NXCD, off = wgid / NXCD; wgid = (xcd < r ? xcd * (q + 1) : r * (q + 1) + (xcd - r) * q) + off; }
    const int nig = WGM * nN, gid = wgid / nig, fm = gid * WGM, gsz = (nM - fm) < WGM ? (nM - fm) : WGM;
    u.pm = fm + ((wgid % nig) % gsz); u.pn = (wgid % nig) / gsz; u.gi = gi; return true;
}

template <int MODE>
__device__ __forceinline__ void epi_elem(const int r, const int c, f32x4 v, void* g_o0, void* g_o1, const f32x4 bv, const int ldo, float* outp, float* htp) {
    if constexpr (MODE == 8) {
        float* p = (r < MMAIN ? outp + (size_t)r * D : htp + (size_t)(r - MMAIN) * D) + c; f32x4 hv = *(f32x4*)p; *(f32x4*)p = hv + v;
    } else if constexpr (MODE == 1) {
        *(f32x4*)((float*)g_o0 + (size_t)r * ldo + c) = v;
    } else if constexpr (MODE == 2) {
        *(f32x4*)((float*)g_o0 + (size_t)r * ldo + c) = v;
        u32x2 wv; wv.x = cvt_pk_bf16(v[0], v[1]); wv.y = cvt_pk_bf16(v[2], v[3]);
        *(u32x2*)((bf16_t*)g_o1 + (size_t)r * ldo + c) = wv;
    } else if constexpr (MODE == 5) {
        f32x4 o;
#pragma unroll
        for (int e = 0; e < 4; ++e) { const float x = -(bv[e] + v[e]); const float sp = fmaxf(x, 0.f) + __logf(1.0f + __expf(-fabsf(x))); const float wl = -sp - 0.5f; o[e] = __expf(-__expf(wl)); }
        *(f32x4*)((float*)g_o0 + (size_t)r * ldo + c) = o;
    } else if constexpr (MODE == 7) {
        float* vp = (float*)g_o0 + (size_t)r * ldo + c; const f32x4 vv = *(f32x4*)vp;
        const u32x2 vf = *(const u32x2*)((const bf16_t*)g_o1 + (size_t)r * ldo + c);
        const float f0 = bf_lo(vf.x), f1 = bf_hi(vf.x), f2 = bf_lo(vf.y), f3 = bf_hi(vf.y);
        f32x4 o;
        o[0] = vv[0] + (f0 - vv[0]) * sigmoidf_(bv[0] + v[0]); o[1] = vv[1] + (f1 - vv[1]) * sigmoidf_(bv[1] + v[1]);
        o[2] = vv[2] + (f2 - vv[2]) * sigmoidf_(bv[2] + v[2]); o[3] = vv[3] + (f3 - vv[3]) * sigmoidf_(bv[3] + v[3]);
        *(f32x4*)vp = o;
    } else {
        if constexpr (MODE == 3) {
#pragma unroll
            for (int e = 0; e < 4; ++e) { const float ax = fminf(fabsf(v[e]), 15.0f); const float t = 1.0f - 2.0f / (__expf(2.0f * ax) + 1.0f); v[e] = v[e] < 0.f ? -t : t; } }
        else if constexpr (MODE == 4) { v[0] = sigmoidf_(v[0]); v[1] = sigmoidf_(v[1]); v[2] = sigmoidf_(v[2]); v[3] = sigmoidf_(v[3]); }
        else if constexpr (MODE == 6) { v[0] = sigmoidf_(bv[0] + v[0]); v[1] = sigmoidf_(bv[1] + v[1]); v[2] = sigmoidf_(bv[2] + v[2]); v[3] = sigmoidf_(bv[3] + v[3]); }
        u32x2 wv; wv.x = cvt_pk_bf16(v[0], v[1]); wv.y = cvt_pk_bf16(v[2], v[3]);
        *(u32x2*)((bf16_t*)g_o0 + (size_t)r * ldo + c) = wv;
    }
}
__device__ __forceinline__ void epi_swiglu(const int r, const int oc, const f32x4 g, const f32x4 up, void* g_o0, const int ldo) {
    float o[4];
#pragma unroll
    for (int e = 0; e < 4; ++e) o[e] = g[e] * __builtin_amdgcn_rcpf(1.0f + __expf(-g[e])) * up[e];
    u32x2 wv; wv.x = cvt_pk_bf16(o[0], o[1]); wv.y = cvt_pk_bf16(o[2], o[3]);
    *(u32x2*)((bf16_t*)g_o0 + (size_t)r * ldo + oc) = wv;
}
template <int MODE>
__device__ __forceinline__ void epi_t(const f32x4 (&acc)[2][2][4][2], void* g_o0, void* g_o1, const float* g_bias, const int ldo, const int u_pm, const int u_pn, int wr, int wc, int fr, int fq, float* outp, float* htp) {
    const int row0 = u_pm * BM + wr * 64 + fr, col0 = u_pn * BM + wc * 32 + 4 * fq;
    f32x4 bvv[2][2];
#pragma unroll
    for (int bj = 0; bj < 2; ++bj)
#pragma unroll
        for (int n = 0; n < 2; ++n) bvv[bj][n] = (MODE == 5 || MODE == 6 || MODE == 7) ? *(const f32x4*)(g_bias + col0 + bj * HALF + n * 16) : (f32x4){0.f, 0.f, 0.f, 0.f};
    if constexpr (MODE == 7) {
#pragma unroll
        for (int ai = 0; ai < 2; ++ai) {
#pragma unroll
            for (int mh = 0; mh < 2; ++mh) {
                f32x4 vv[2][2][2]; u32x2 vf[2][2][2];
#pragma unroll
                for (int ml = 0; ml < 2; ++ml) { const size_t o = (size_t)(row0 + ai * HALF + (2 * mh + ml) * 16) * ldo + col0;
#pragma unroll
                    for (int bj = 0; bj < 2; ++bj)
#pragma unroll
                        for (int n = 0; n < 2; ++n) { vv[ml][bj][n] = *(const f32x4*)((const float*)g_o0 + o + bj * HALF + n * 16); vf[ml][bj][n] = *(const u32x2*)((const bf16_t*)g_o1 + o + bj * HALF + n * 16); } }
#pragma unroll
                for (int ml = 0; ml < 2; ++ml) { const size_t o = (size_t)(row0 + ai * HALF + (2 * mh + ml) * 16) * ldo + col0;
#pragma unroll
                    for (int bj = 0; bj < 2; ++bj)
#pragma unroll
                        for (int n = 0; n < 2; ++n) { const f32x4 a = acc[ai][bj][2 * mh + ml][n], x = vv[ml][bj][n], bb = bvv[bj][n]; const u32x2 f = vf[ml][bj][n];
                            f32x4 ov;
                            ov[0] = x[0] + (bf_lo(f.x) - x[0]) * sigmoidf_(bb[0] + a[0]); ov[1] = x[1] + (bf_hi(f.x) - x[1]) * sigmoidf_(bb[1] + a[1]);
                            ov[2] = x[2] + (bf_lo(f.y) - x[2]) * sigmoidf_(bb[2] + a[2]); ov[3] = x[3] + (bf_hi(f.y) - x[3]) * sigmoidf_(bb[3] + a[3]);
                            *(f32x4*)((float*)g_o0 + o + bj * HALF + n * 16) = ov; } }
            }
        }
        return;
    }
    if constexpr (MODE == 8) {
#pragma unroll
        for (int ai = 0; ai < 2; ++ai) {
            f32x4 hv[4][2][2];
#pragma unroll
            for (int m = 0; m < 4; ++m) { const int r = row0 + ai * HALF + m * 16; float* p = (r < MMAIN ? outp + (size_t)r * D : htp + (size_t)(r - MMAIN) * D) + col0;
#pragma unroll
                for (int bj = 0; bj < 2; ++bj)
#pragma unroll
                    for (int n = 0; n < 2; ++n) hv[m][bj][n] = *(const f32x4*)(p + bj * HALF + n * 16); }
#pragma unroll
            for (int m = 0; m < 4; ++m) { const int r = row0 + ai * HALF + m * 16; float* p = (r < MMAIN ? outp + (size_t)r * D : htp + (size_t)(r - MMAIN) * D) + col0;
#pragma unroll
                for (int bj = 0; bj < 2; ++bj)
#pragma unroll
                    for (int n = 0; n < 2; ++n) *(f32x4*)(p + bj * HALF + n * 16) = hv[m][bj][n] + acc[ai][bj][m][n]; }
        }
        return;
    }
#pragma unroll
    for (int ai = 0; ai < 2; ++ai) {
#pragma unroll
        for (int m = 0; m < 4; ++m) {
            const int r = row0 + ai * HALF + m * 16;
            if constexpr (MODE == 9) {
#pragma unroll
                for (int bj = 0; bj < 2; ++bj)
                    epi_swiglu(r, 16 * (u_pn * 8 + bj * 4 + wc) + 4 * fq, acc[ai][bj][m][0], acc[ai][bj][m][1], g_o0, ldo);
            } else if constexpr (MODE == 8 || MODE == 7) {
            } else {
#pragma unroll
                for (int bj = 0; bj < 2; ++bj) {
#pragma unroll
                    for (int n = 0; n < 2; ++n)
                        epi_elem<MODE>(r, col0 + bj * HALF + n * 16, acc[ai][bj][m][n], g_o0, g_o1, bvv[bj][n], ldo, outp, htp);
                }
            }
        }
    }
}
#define EPI_CALL(MD) epi_t<MD>(acc, g_o0, g_o1, g_bias, ldo, u_pm, u_pn, wr, wc, fr, fq, outp, htp)
__device__ __forceinline__ void epilogue(const f32x4 (&acc)[2][2][4][2], const int mode, void* g_o0, void* g_o1, const float* g_bias, const int ldo, const int u_pm, const int u_pn, int wr, int wc, int fr, int fq, float* outp, float* htp) {
    switch (mode) {
        case 0: EPI_CALL(0); break;
        case 1: EPI_CALL(1); break;
        case 2: EPI_CALL(2); break;
        case 3: EPI_CALL(3); break;
        case 4: EPI_CALL(4); break;
        case 5: EPI_CALL(5); break;
        case 6: EPI_CALL(6); break;
        case 7: EPI_CALL(7); break;
        case 8: EPI_CALL(8); break;
        default: EPI_CALL(9); break;
    }
}

__device__ __forceinline__ void gemm_phase(LAS unsigned char* lds, const PE* pe, const Params& P) {
    const int tid = threadIdx.x, wid = __builtin_amdgcn_readfirstlane(tid >> 6), lane = tid & 63, wr = wid >> 2, wc = wid & 3, fr = lane & 15, fq = lane >> 4;
    const int K = pe->K, nt = K / BK;
    const int sG = (int)gridDim.x, sC = (int)blockIdx.x, s_ng = pe->ng;
    const int sc1 = NMT * (pe->g[0].N / BM);
    const int sc2 = sc1 + (s_ng > 1 ? NMT * (pe->g[1].N / BM) : 0);
    const int sc3 = sc2 + (s_ng > 2 ? NMT * (pe->g[2].N / BM) : 0);
    const int sc4 = sc3 + (s_ng > 3 ? NMT * (pe->g[3].N / BM) : 0);
    unsigned char* const ws = P.ws;
    unsigned voff[2];
#pragma unroll
    for (int i = 0; i < 2; ++i) { int R, C; stage_rc(tid * 16 + i * 8192, R, C); voff[i] = (unsigned)(R * K + C) * 2u; }
    const size_t kstep = (size_t)(BK * 2);
    const size_t hstep = (size_t)HALF * K * 2;
    const size_t tstep = 2 * hstep;
    const unsigned ldsw = (unsigned)wid * 1024u;
    const int aoff = lds_byte(wr * 64 + fr, fq * 8), boff = lds_byte(wc * 32 + fr, fq * 8);
#define PG8_SA(b, h) (((b) * 2 + (h)) * HTB)
#define PG8_SB(b, h) ((4 + (b) * 2 + (h)) * HTB)
#define PG8_STAGE(bufoff, gbase) do { _Pragma("unroll") for (int _i = 0; _i < 2; ++_i) \
        __builtin_amdgcn_global_load_lds((const unsigned*)((const char*)(gbase) + voff[_i]), (LAS unsigned*)(lds + (bufoff) + ldsw + _i * 8192), 16, 0, 0); } while (0)
#define PG8_LDA(dst, b, h) do { _Pragma("unroll") for (int m = 0; m < 4; ++m) _Pragma("unroll") for (int k = 0; k < 2; ++k) dst[m][k] = *(const LAS bf16x8*)(lds + PG8_SA(b, h) + aoff + m * 2048 + k * 1024); } while (0)
#define PG8_LDB(dst, b, h) do { _Pragma("unroll") for (int n = 0; n < 2; ++n) _Pragma("unroll") for (int k = 0; k < 2; ++k) dst[n][k] = *(const LAS bf16x8*)(lds + PG8_SB(b, h) + boff + n * 2048 + k * 1024); } while (0)
#define PG8_MMA(ai, bj, At, Bt) do { __builtin_amdgcn_s_setprio(1); _Pragma("unroll") for (int m = 0; m < 4; ++m) _Pragma("unroll") for (int n = 0; n < 2; ++n) _Pragma("unroll") for (int k = 0; k < 2; ++k) \
        acc[ai][bj][m][n] = __builtin_amdgcn_mfma_f32_16x16x32_bf16(Bt[n][k], At[m][k], acc[ai][bj][m][n], 0, 0, 0); __builtin_amdgcn_s_setprio(0); } while (0)
#define PG8_WAIT_V(n) asm volatile("s_waitcnt vmcnt(" #n ")" ::: "memory")
#define PG8_WAIT_L(n) asm volatile("s_waitcnt lgkmcnt(" #n ")" ::: "memory")
#define PG8_BAR __builtin_amdgcn_s_barrier()
#define PG8_SCHED __builtin_amdgcn_sched_barrier(0)
    Unit cur, nxt; int ui = 0;
    if (!sched_next(sC, sc1, sc2, sc3, sc4, cur)) return;
    f32x4 acc[2][2][4][2];
#pragma unroll
    for (int a = 0; a < 2; ++a)
#pragma unroll
        for (int b = 0; b < 2; ++b)
#pragma unroll
            for (int m = 0; m < 4; ++m)
#pragma unroll
                for (int n = 0; n < 2; ++n) acc[a][b][m][n] = (f32x4){0.f, 0.f, 0.f, 0.f};
    bf16x8 At[4][2], B0[2][2], B1[2][2];
    const char* cA = (const char*)ws + pe->g[cur.gi].A + (size_t)cur.pm * tstep; const char* cB = (const char*)ws + pe->g[cur.gi].Bt + (size_t)cur.pn * tstep;
    PG8_STAGE(PG8_SB(0, 0), cB); PG8_STAGE(PG8_SA(0, 0), cA); PG8_STAGE(PG8_SB(0, 1), cB + hstep); PG8_STAGE(PG8_SA(0, 1), cA + hstep);
    if (wr == 1) PG8_BAR;
    PG8_WAIT_V(4); PG8_BAR;
    PG8_STAGE(PG8_SB(1, 0), cB + kstep); PG8_STAGE(PG8_SA(1, 0), cA + kstep); PG8_STAGE(PG8_SB(1, 1), cB + hstep + kstep);
    PG8_WAIT_V(6); PG8_BAR;
    for (;;) {
        const bool has_next = sched_next((ui + 1) * sG + sC, sc1, sc2, sc3, sc4, nxt);
        const char* nA = cA; const char* nB = cB;
        if (has_next) { nA = (const char*)ws + pe->g[nxt.gi].A + (size_t)nxt.pm * tstep; nB = (const char*)ws + pe->g[nxt.gi].Bt + (size_t)nxt.pn * tstep; }
        for (int t = 0; t < nt; t += 2) {
            const bool last = (t == nt - 2);
            const char* a1 = cA + (size_t)(t + 1) * kstep;
            const char* a2 = last ? nA : cA + (size_t)(t + 2) * kstep; const char* b2 = last ? nB : cB + (size_t)(t + 2) * kstep;
            const char* a3 = a2 + kstep; const char* b3 = b2 + kstep;
            PG8_LDB(B0, 0, 0); PG8_SCHED; PG8_LDA(At, 0, 0); PG8_STAGE(PG8_SA(1, 1), a1 + hstep);
            PG8_WAIT_L(8); PG8_BAR; PG8_WAIT_L(0); PG8_MMA(0, 0, At, B0); PG8_BAR; PG8_SCHED;
            PG8_LDB(B1, 0, 1); PG8_STAGE(PG8_SB(0, 0), b2);
            PG8_BAR; PG8_WAIT_L(0); PG8_MMA(0, 1, At, B1); PG8_BAR;
            PG8_LDA(At, 0, 1); PG8_STAGE(PG8_SA(0, 0), a2);
            PG8_BAR; PG8_WAIT_L(0); PG8_MMA(1, 0, At, B0); PG8_BAR; PG8_SCHED;
            PG8_STAGE(PG8_SB(0, 1), b2 + hstep);
            PG8_WAIT_V(6); PG8_BAR; PG8_MMA(1, 1, At, B1); PG8_BAR;
            PG8_LDB(B0, 1, 0); PG8_SCHED; PG8_LDA(At, 1, 0); PG8_STAGE(PG8_SA(0, 1), a2 + hstep);
            PG8_WAIT_L(8); PG8_BAR; PG8_WAIT_L(0); PG8_MMA(0, 0, At, B0); PG8_BAR; PG8_SCHED;
            PG8_LDB(B1, 1, 1); PG8_STAGE(PG8_SB(1, 0), b3);
            PG8_BAR; PG8_WAIT_L(0); PG8_MMA(0, 1, At, B1); PG8_BAR;
            PG8_LDA(At, 1, 1); PG8_STAGE(PG8_SA(1, 0), a3);
            PG8_BAR; PG8_WAIT_L(0); PG8_MMA(1, 0, At, B0); PG8_BAR; PG8_SCHED;
            PG8_STAGE(PG8_SB(1, 1), b3 + hstep);
            PG8_WAIT_V(6); PG8_BAR; PG8_MMA(1, 1, At, B1); PG8_BAR;
        }
        { const GD* gd = &pe->g[cur.gi];
          epilogue(acc, gd->mode, ws + gd->o0, ws + gd->o1, P.in[gd->bin] + gd->boff, gd->ldo, cur.pm, cur.pn, wr, wc, fr, fq, P.out, (float*)(ws + OFF_HT)); }
        if (!has_next) break;
#pragma unroll
        for (int a = 0; a < 2; ++a)
#pragma unroll
            for (int b = 0; b < 2; ++b)
#pragma unroll
                for (int m = 0; m < 4; ++m)
#pragma unroll
                    for (int n = 0; n < 2; ++n) acc[a][b][m][n] = (f32x4){0.f, 0.f, 0.f, 0.f};
        cur = nxt; cA = nA; cB = nB; ++ui;
    }
    PG8_WAIT_V(0);
    if (wr == 0) PG8_BAR;
    PG8_BAR;
#undef PG8_SA
#undef PG8_SB
#undef PG8_STAGE
#undef PG8_LDA
#undef PG8_LDB
#undef PG8_MMA
#undef PG8_WAIT_V
#undef PG8_WAIT_L
#undef PG8_BAR
#undef PG8_SCHED
}

#define TE_CALL(MD) epi_elem<MD>(r, c, v, o0, o1, bvt, ldo, P.out, (float*)(ws + OFF_HT))
__device__ void tail_gemm(LAS unsigned char* lds, const PE* pe, const Params& P) {
    const int tid = otid(), w = tid >> 6, lane = tid & 63, fr = lane & 15, fq = lane >> 4;
    unsigned char* const ws = P.ws;
    const int K = pe->K, ks = K >> 3, nstep = ks >> 5, ng = pe->ng;
    const int t1 = pe->g[0].N >> 4;
    const int t2 = t1 + (ng > 1 ? pe->g[1].N >> 4 : 0);
    const int t3 = t2 + (ng > 2 ? pe->g[2].N >> 4 : 0);
    const int t4 = t3 + (ng > 3 ? pe->g[3].N >> 4 : 0);
    LAS f32x4* part = (LAS f32x4*)lds;
    const int bid_ = obid();
    const int rank_ = (bid_ & 1) ? (bid_ >> 1) : ((int)(gridDim.x >> 1) + (bid_ >> 1));
    for (int item = rank_; item < t4; item += gridDim.x) {
        int gi = 0, base = 0;
        if (item >= t1) { gi = 1; base = t1; }
        if (item >= t2) { gi = 2; base = t2; }
        if (item >= t3) { gi = 3; base = t3; }
        const int cb = (item - base) >> 1, mh = (item - base) & 1;
        const GD* gd = &pe->g[gi];
        const bf16_t* A = (const bf16_t*)(ws + gd->A) + (size_t)(MMAIN + 32 * mh + fr) * K + (size_t)w * ks + 8 * fq;
        const bf16_t* Bt = (const bf16_t*)(ws + gd->Bt) + (size_t)(32 * cb + fr) * K + (size_t)w * ks + 8 * fq;
        const size_t r16 = (size_t)16 * K;
        f32x4 acc[2][2];
#pragma unroll
        for (int m = 0; m < 2; ++m) { acc[m][0] = (f32x4){0.f, 0.f, 0.f, 0.f}; acc[m][1] = acc[m][0]; }
        for (int s0 = 0; s0 < nstep; s0 += 8) {
            bf16x8 af[8][2], bfr[8][2];
#pragma unroll
            for (int s = 0; s < 8; ++s) if (s0 + s < nstep) {
                const int k0 = (s0 + s) * 32;
                af[s][0] = *(const bf16x8*)(A + k0); af[s][1] = *(const bf16x8*)(A + r16 + k0);
                bfr[s][0] = *(const bf16x8*)(Bt + k0); bfr[s][1] = *(const bf16x8*)(Bt + r16 + k0);
            }
#pragma unroll
            for (int s = 0; s < 8; ++s) if (s0 + s < nstep) {
#pragma unroll
                for (int m = 0; m < 2; ++m)
#pragma unroll
                    for (int nb = 0; nb < 2; ++nb) acc[m][nb] = __builtin_amdgcn_mfma_f32_16x16x32_bf16(bfr[s][nb], af[s][m], acc[m][nb], 0, 0, 0);
            }
        }
        __syncthreads();
#pragma unroll
        for (int m = 0; m < 2; ++m)
#pragma unroll
            for (int nb = 0; nb < 2; ++nb) part[(w * 4 + m * 2 + nb) * 64 + lane] = acc[m][nb];
        __syncthreads();
        if (tid < 256) {
            const int ml = tid >> 7, nb2 = (tid >> 6) & 1;
            f32x4 v = part[(ml * 2 + nb2) * 64 + lane];
#pragma unroll
            for (int x = 1; x < 8; ++x) v += part[(x * 4 + ml * 2 + nb2) * 64 + lane];
            const int r = MMAIN + 32 * mh + 16 * ml + fr, c = 32 * cb + 16 * nb2 + 4 * fq;
            const int mode = gd->mode, ldo = gd->ldo;
            void* o0 = ws + gd->o0; void* o1 = ws + gd->o1; const float* bias = P.in[gd->bin] + gd->boff;
            const f32x4 bvt = (mode == 5 || mode == 6 || mode == 7) ? *(const f32x4*)(bias + c) : (f32x4){0.f, 0.f, 0.f, 0.f};
            if (mode == 9) {
                if (nb2 == 0) { f32x4 up = part[(ml * 2 + 1) * 64 + lane];
#pragma unroll
                    for (int x = 1; x < 8; ++x) up += part[(x * 4 + ml * 2 + 1) * 64 + lane];
                    epi_swiglu(r, 16 * cb + 4 * fq, v, up, o0, ldo); }
            } else {
                switch (mode) {
                    case 0: TE_CALL(0); break;
                    case 1: TE_CALL(1); break;
                    case 2: TE_CALL(2); break;
                    case 3: TE_CALL(3); break;
                    case 4: TE_CALL(4); break;
                    case 5: TE_CALL(5); break;
                    case 6: TE_CALL(6); break;
                    case 7: TE_CALL(7); break;
                    default: TE_CALL(8); break;
                }
            }
        }
    }
}

__device__ void conv_T(const float* src, const float* src2, int ldsrc, bf16_t* dst, int K, int N, int Kpad, int Npad, int mode, LAS float* tile) {
    const int tid = otid();
    const int tk = Kpad / 256, tn = Npad / 64, ntile = tk * tn;
    for (int ti = obid(); ti < ntile; ti += gridDim.x) {
        const int R0 = (ti / tk) * 64, k0 = (ti % tk) * 256;
        f32x4 v[4][2];
#pragma unroll
        for (int sub = 0; sub < 4; ++sub)
#pragma unroll
            for (int pass = 0; pass < 2; ++pass) {
                const int kr = (tid >> 4) + pass * 32, c4 = (tid & 15) * 4;
                const int k = k0 + sub * 64 + kr, R = R0 + c4;
                v[sub][pass] = (f32x4){0.f, 0.f, 0.f, 0.f};
                if (k < K && R < N) {
                    const float* s; int col;
                    if (mode == 1) { const int g = R >> 5, wi = R & 31; s = wi < 16 ? src : src2; col = 16 * g + (wi & 15); }
                    else { s = src; col = R; }
                    v[sub][pass] = *(const f32x4*)(s + (size_t)k * ldsrc + col);
                }
            }
        __syncthreads();
#pragma unroll
        for (int sub = 0; sub < 4; ++sub)
#pragma unroll
            for (int pass = 0; pass < 2; ++pass) {
                const int kr = (tid >> 4) + pass * 32, c4 = (tid & 15) * 4;
                LAS float* t = tile + sub * (64 * 65) + kr * 65 + c4;
                t[0] = v[sub][pass][0]; t[1] = v[sub][pass][1]; t[2] = v[sub][pass][2]; t[3] = v[sub][pass][3];
            }
        __syncthreads();
        const int Rr = tid >> 3, k8 = (tid & 7) * 8;
#pragma unroll
        for (int sub = 0; sub < 4; ++sub) {
            float e[8];
#pragma unroll
            for (int i = 0; i < 8; ++i) e[i] = tile[sub * (64 * 65) + (k8 + i) * 65 + Rr];
            u32x4 o; o.x = cvt_pk_bf16(e[0], e[1]); o.y = cvt_pk_bf16(e[2], e[3]); o.z = cvt_pk_bf16(e[4], e[5]); o.w = cvt_pk_bf16(e[6], e[7]);
            *(u32x4*)(dst + (size_t)(R0 + Rr) * Kpad + k0 + sub * 64 + k8) = o;
        }
    }
}

struct CJ { int in0, in1, ldsrc, K, N, Kpad, Npad, mode; unsigned long long soff, doff; };
struct CJTab { CJ j[4][14]; int n[4]; };
constexpr CJ mkcj(int in0, int in1, unsigned long long soff, int ldsrc, unsigned long long doff, int K, int N, int Kpad, int Npad, int mode) {
    CJ c{}; c.in0 = in0; c.in1 = in1; c.ldsrc = ldsrc; c.K = K; c.N = N; c.Kpad = Kpad; c.Npad = Npad; c.mode = mode; c.soff = soff; c.doff = doff; return c;
}
constexpr CJTab make_cjtab() {
    CJTab t{};
    const unsigned long long DD = (unsigned long long)D * D, DF = (unsigned long long)D * FF;
    for (int layer = 0; layer < 4; ++layer) {
        int n = 0;
        if (layer < 2) {
            const unsigned long long i = layer;
            t.j[layer][n++] = mkcj(8, 8, i * DD, D, OFF_WA + WA_W0, D, D, D, D, 0);
            t.j[layer][n++] = mkcj(9, 9, i * DD, D, OFF_WA + WA_W1, D, D, D, D, 0);
            t.j[layer][n++] = mkcj(10, 10, i * DD, D, OFF_WA + WA_W2, D, D, D, D, 0);
            t.j[layer][n++] = mkcj(13, 13, i * D * 96, 96, OFF_WA + WA_L1 + 0 * WSLOT, D, 96, D, 256, 0);
            t.j[layer][n++] = mkcj(16, 16, i * D * 96, 96, OFF_WA + WA_L1 + 1 * WSLOT, D, 96, D, 256, 0);
            t.j[layer][n++] = mkcj(18, 18, i * D * 256, 256, OFF_WA + WA_L1 + 2 * WSLOT, D, 256, D, 256, 0);
            t.j[layer][n++] = mkcj(14, 14, i * 96 * D, D, OFF_WA + WA_L2 + 0 * WSLOT, 96, D, 256, D, 0);
            t.j[layer][n++] = mkcj(17, 17, i * 96 * D, D, OFF_WA + WA_L2 + 1 * WSLOT, 96, D, 256, D, 0);
            t.j[layer][n++] = mkcj(19, 19, i * 256 * D, D, OFF_WA + WA_L2 + 2 * WSLOT, 256, D, 256, D, 0);
            if (layer >= 1) {
                t.j[layer][n++] = mkcj(26, 26, (i - 1) * D * 64, 64, OFF_WA + WA_L1 + 3 * WSLOT, D, 64, D, 256, 0);
                t.j[layer][n++] = mkcj(27, 27, (i - 1) * 64 * D, D, OFF_WA + WA_L2 + 3 * WSLOT, 64, D, 256, D, 0);
            }
            t.j[layer][n++] = mkcj(11, 11, i * DD, D, OFF_WB + WB_WO, D, D, D, D, 0);
        } else {
            const unsigned long long jj = layer - 2;
            t.j[layer][n++] = mkcj(32, 32, jj * DD, D, OFF_WA + WA_W0, D, D, D, D, 0);
            if (layer == 2) {
                t.j[layer][n++] = mkcj(29, 29, 0, D, OFF_WA + WA_W1, D, D, D, D, 0);
                t.j[layer][n++] = mkcj(30, 30, 0, D, OFF_WA + WA_W2, D, D, D, D, 0);
            }
            t.j[layer][n++] = mkcj(34, 34, jj * DD, D, OFF_WB + WB_WO, D, D, D, D, 0);
        }
        t.j[layer][n++] = mkcj(4, 5, (unsigned long long)layer * DF, FF, OFF_WB + WB_F1, D, 2 * FF, D, 2 * FF, 1);
        t.j[layer][n++] = mkcj(6, 6, (unsigned long long)layer * DF, D, OFF_WB + WB_F2, FF, D, FF, D, 0);
        t.n[layer] = n;
    }
    return t;
}
__constant__ const CJTab CJT = make_cjtab();

__device__ void convert_layer(const Params& P, int layer, LAS unsigned char* lds) {
    LAS float* tile = (LAS float*)lds;
    const int nj = CJT.n[layer];
    for (int q = 0; q < nj; ++q) {
        const CJ* c = &CJT.j[layer][q];
        conv_T(P.in[c->in0] + c->soff, P.in[c->in1] + c->soff, c->ldsrc, (bf16_t*)(P.ws + c->doff), c->K, c->N, c->Kpad, c->Npad, c->mode, tile);
    }
}

__device__ void init_phase(const Params& P) {
    const f32x4* x = (const f32x4*)P.in[0]; f32x4* o = (f32x4*)P.out;
    const size_t n4 = (size_t)MMAIN * D / 4;
    for (size_t i = (size_t)obid() * NTHR + otid(); i < n4; i += (size_t)gridDim.x * NTHR) o[i] = x[i];
    const f32x4* mt = (const f32x4*)P.in[1]; f32x4* ht = (f32x4*)(P.ws + OFF_HT);
    const int m4 = NBATCH * NMETA * D / 4, per = NMETA * D / 4;
    for (int i = obid() * NTHR + otid(); i < m4; i += gridDim.x * NTHR) ht[i] = mt[i % per];
}

__device__ void mixprep_phase(const Params& P, int i) {
    const int tid_ = otid(); const int w = tid_ >> 6, lane = tid_ & 63;
    const float* g = P.in[2] + (size_t)i * D;
    const float* mu = P.in[7] + (size_t)i * 6 * D;
    bf16_t* const ob[6] = {(bf16_t*)(P.ws + OFF_MIX), (bf16_t*)(P.ws + OFF_DEC), (bf16_t*)(P.ws + OFF_MIX + SZB), (bf16_t*)(P.ws + OFF_MIX + 2 * SZB),
                           (bf16_t*)(P.ws + OFF_DEC + SZB), (bf16_t*)(P.ws + OFF_KF)};
    for (int idx = obid() * 8 + w; idx < M; idx += gridDim.x * 8) {
        const int b = idx / L, t = idx % L;
        const int r = rowof(b, t), rprev = rowof(b, t > 0 ? t - 1 : 0);
        const float* hc; const float* hp;
        if (i == 0) {
            hc = r < MMAIN ? P.in[0] + (size_t)r * D : P.in[1] + (size_t)((r - MMAIN) & 15) * D;
            hp = rprev < MMAIN ? P.in[0] + (size_t)rprev * D : P.in[1] + (size_t)((rprev - MMAIN) & 15) * D;
        } else { hc = hrow(P, r); hp = hrow(P, rprev); }
        float* hw = hrow(P, r);
        f32x4 c[8], p[8]; float sc = 0.f, sp = 0.f;
#pragma unroll
        for (int q = 0; q < 8; ++q) { c[q] = *(const f32x4*)(hc + 256 * q + 4 * lane); p[q] = *(const f32x4*)(hp + 256 * q + 4 * lane);
            sc += c[q][0] * c[q][0] + c[q][1] * c[q][1] + c[q][2] * c[q][2] + c[q][3] * c[q][3];
            sp += p[q][0] * p[q][0] + p[q][1] * p[q][1] + p[q][2] * p[q][2] + p[q][3] * p[q][3]; }
        if (i == 0) {
#pragma unroll
            for (int q = 0; q < 8; ++q) *(f32x4*)(hw + 256 * q + 4 * lane) = c[q];
        }
        sc = wavesum(sc); sp = wavesum(sp);
        const float rc = rsqrtf(sc * (1.0f / D) + 1e-6f);
        const float rp = t > 0 ? rsqrtf(sp * (1.0f / D) + 1e-6f) : 0.f;
#pragma unroll
        for (int q = 0; q < 8; ++q) {
            const int col = 256 * q + 4 * lane;
            const f32x4 gv = *(const f32x4*)(g + col);
            f32x4 hn, xx;
#pragma unroll
            for (int e = 0; e < 4; ++e) { hn[e] = c[q][e] * rc * gv[e]; xx[e] = p[q][e] * rp * gv[e] - hn[e]; }
#pragma unroll
            for (int j = 0; j < 6; ++j) {
                const f32x4 m = *(const f32x4*)(mu + j * D + col);
                u32x2 a; a.x = cvt_pk_bf16(hn[0] + xx[0] * m[0], hn[1] + xx[1] * m[1]); a.y = cvt_pk_bf16(hn[2] + xx[2] * m[2], hn[3] + xx[3] * m[3]);
                *(u32x2*)(ob[j] + (size_t)r * D + col) = a;
            }
        }
    }
}

__device__ void norm_phase(const Params& P, const float* g1, bf16_t* o1, const float* g2, bf16_t* o2) {
    const int tid_ = otid(); const int w = tid_ >> 6, lane = tid_ & 63;
    for (int r = obid() * 8 + w; r < M; r += gridDim.x * 8) {
        const float* hc = hrow(P, r);
        f32x4 c[8]; float sc = 0.f;
#pragma unroll
        for (int q = 0; q < 8; ++q) { c[q] = *(const f32x4*)(hc + 256 * q + 4 * lane); sc += c[q][0] * c[q][0] + c[q][1] * c[q][1] + c[q][2] * c[q][2] + c[q][3] * c[q][3]; }
        sc = wavesum(sc);
        const float rc = rsqrtf(sc * (1.0f / D) + 1e-6f);
#pragma unroll
        for (int q = 0; q < 8; ++q) {
            const int col = 256 * q + 4 * lane;
            const f32x4 gv = *(const f32x4*)(g1 + col);
            u32x2 a; a.x = cvt_pk_bf16(c[q][0] * rc * gv[0], c[q][1] * rc * gv[1]); a.y = cvt_pk_bf16(c[q][2] * rc * gv[2], c[q][3] * rc * gv[3]);
            *(u32x2*)(o1 + (size_t)r * D + col) = a;
            if (g2) { const f32x4 g2v = *(const f32x4*)(g2 + col);
                u32x2 bq; bq.x = cvt_pk_bf16(c[q][0] * rc * g2v[0], c[q][1] * rc * g2v[1]); bq.y = cvt_pk_bf16(c[q][2] * rc * g2v[2], c[q][3] * rc * g2v[3]);
                *(u32x2*)(o2 + (size_t)r * D + col) = bq; }
        }
    }
}

__device__ void scan_phase(const Params& P, int i, LAS unsigned char* lds) {
    const int tid = otid(), w = tid >> 6, lane = tid & 63;
    const bf16_t* RB = (const bf16_t*)(P.ws + OFF_RB); const float* KF = (const float*)(P.ws + OFF_KF);
    const float* VF = (const float*)(P.ws + OFF_VF); const float* DEC = (const float*)(P.ws + OFF_DEC);
    const bf16_t* AB = (const bf16_t*)(P.ws + OFF_MIX); bf16_t* YB = (bf16_t*)(P.ws + OFF_MIX + 2 * SZB);
    const float* k_k = P.in[20] + (size_t)i * D; const float* k_a = P.in[21] + (size_t)i * D;
    LAS float* fl = (LAS float*)lds;
    constexpr int STG = 11264;
    LAS float* ybuf = fl + 2 * STG;
    typedef float f32x2 __attribute__((ext_vector_type(2)));
    const int wu = __builtin_amdgcn_readfirstlane(w);
    const int kg = lane & 15, rp = 4 * (wu & 3) + (lane >> 4);
    const int lt = tid & 255;
    const int lc = (lt & 15) * 4, vt = lt >> 3, vc = (lt & 7) * 4;
    constexpr int NCH = (L + 31) / 32;
    for (int u = obid(); u < 256; u += gridDim.x) {
        const int bh = u >> 1, rh = u & 1, b = bh >> 5, h = bh & 31;
        f32x4 kkp = (f32x4){0.f, 0.f, 0.f, 0.f}, kap = kkp;
        f32x4 gk[2], gd[2], gv; u32x2 gr[2], ga[2];
        __syncthreads();
#define SCAN_LOAD(cc) do { _Pragma("unroll") for (int q_ = 0; q_ < 2; ++q_) { const int t_ = 32 * (cc) + (lt >> 4) + 16 * q_; \
              gk[q_] = (f32x4){0.f, 0.f, 0.f, 0.f}; gd[q_] = gk[q_]; gr[q_] = (u32x2){0u, 0u}; ga[q_] = gr[q_]; \
              if (t_ < L) { const size_t o_ = (size_t)rowof(b, t_) * D + 64 * h + lc; gk[q_] = *(const f32x4*)(KF + o_); gd[q_] = *(const f32x4*)(DEC + o_); gr[q_] = *(const u32x2*)(RB + o_); ga[q_] = *(const u32x2*)(AB + o_); } } \
            { const int tv_ = 32 * (cc) + vt; gv = (f32x4){0.f, 0.f, 0.f, 0.f}; if (tv_ < L) gv = *(const f32x4*)(VF + (size_t)rowof(b, tv_) * D + 64 * h + 32 * rh + vc); } } while (0)
#define SCAN_STORE(st) do { LAS float* s_ = fl + (st) * STG; _Pragma("unroll") for (int q_ = 0; q_ < 2; ++q_) { const int o_ = ((lt >> 4) + 16 * q_) * 64 + lc; \
              f32x4 kr_ = gk[q_] * kkp; float ss_ = kr_[0] * kr_[0] + kr_[1] * kr_[1] + kr_[2] * kr_[2] + kr_[3] * kr_[3]; ss_ = rowsum16(ss_); \
              const float inv_ = rsqrtf(fmaxf(ss_, 1e-24f)); \
              f32x4 av_; av_[0] = bf_lo(ga[q_].x); av_[1] = bf_hi(ga[q_].x); av_[2] = bf_lo(ga[q_].y); av_[3] = bf_hi(ga[q_].y); \
              f32x4 rv_; rv_[0] = bf_lo(gr[q_].x); rv_[1] = bf_hi(gr[q_].x); rv_[2] = bf_lo(gr[q_].y); rv_[3] = bf_hi(gr[q_].y); \
              const f32x4 kk_ = kr_ * inv_; f32x4 kp_; \
              for (int e_ = 0; e_ < 4; ++e_) kp_[e_] = gk[q_][e_] * (1.0f + (av_[e_] - 1.0f) * kap[e_]); \
              *(LAS f32x4*)(s_ + o_) = rv_; *(LAS f32x4*)(s_ + 2048 + o_) = gd[q_]; *(LAS f32x4*)(s_ + 4096 + o_) = kp_; \
              *(LAS f32x4*)(s_ + 6144 + o_) = kk_; *(LAS f32x4*)(s_ + 8192 + o_) = kk_ * av_; } \
            *(LAS f32x4*)(s_ + 10240 + vt * 32 + vc) = gv; } while (0)
#define SCAN_FLUSH(cc) do { const LAS float* yb_ = ybuf + ((cc) & 1) * 1024; _Pragma("unroll") for (int q_ = 0; q_ < 2; ++q_) { const int ft_ = (lt >> 4) + 16 * q_, fv_ = (lt & 15) * 2; const int tt_ = 32 * (cc) + ft_; \
              if (tt_ < L) { const unsigned pk_ = cvt_pk_bf16(yb_[ft_ * 32 + fv_], yb_[ft_ * 32 + fv_ + 1]); *(unsigned*)(YB + (size_t)rowof(b, tt_) * D + 64 * h + 32 * rh + fv_) = pk_; } } } while (0)
        if (wu >= 4) {
            kkp = *(const f32x4*)(k_k + 64 * h + lc); kap = *(const f32x4*)(k_a + 64 * h + lc);
            SCAN_LOAD(0); SCAN_STORE(0);
            SCAN_LOAD(1);
        }
        __syncthreads();
        f32x2 SA01 = {0.f, 0.f}, SA23 = SA01, SB01 = SA01, SB23 = SA01;
        for (int c = 0; c < NCH; ++c) {
            if (wu < 4) {
                const LAS float* s = fl + (c & 1) * STG;
                LAS float* yb = ybuf + (c & 1) * 1024;
                const int ns = (L - 32 * c) < 32 ? (L - 32 * c) : 32;
                for (int tb = 0; tb < ns; tb += 16) {
                    float ykA = 0.f, ykB = 0.f;
#pragma unroll
                    for (int j = 0; j < 16; ++j) {
                        const int t = tb + j;
                        const int o = t * 64 + 4 * kg;
                        const f32x4 r4 = *(const LAS f32x4*)(s + o), d4 = *(const LAS f32x4*)(s + 2048 + o), kp4 = *(const LAS f32x4*)(s + 4096 + o);
                        const f32x4 kk4 = *(const LAS f32x4*)(s + 6144 + o), ka4 = *(const LAS f32x4*)(s + 8192 + o);
                        const f32x2 vv = *(const LAS f32x2*)(s + 10240 + t * 32 + 2 * rp);
                        const f32x2 kk01 = {kk4[0], kk4[1]}, kk23 = {kk4[2], kk4[3]}, ka01 = {ka4[0], ka4[1]}, ka23 = {ka4[2], ka4[3]};
                        const f32x2 kp01 = {kp4[0], kp4[1]}, kp23 = {kp4[2], kp4[3]}, d01 = {d4[0], d4[1]}, d23 = {d4[2], d4[3]}, r01 = {r4[0], r4[1]}, r23 = {r4[2], r4[3]};
                        f32x2 pA = SA01 * kk01; pA = SA23 * kk23 + pA;
                        f32x2 pB = SB01 * kk01; pB = SB23 * kk23 + pB;
                        const float saA = -rowsum16(pA.x + pA.y), saB = -rowsum16(pB.x + pB.y);
                        f32x2 tA01 = kp01 * vv.x, tA23 = kp23 * vv.x, tB01 = kp01 * vv.y, tB23 = kp23 * vv.y;
                        tA01 = ka01 * saA + tA01; tA23 = ka23 * saA + tA23; tB01 = ka01 * saB + tB01; tB23 = ka23 * saB + tB23;
                        SA01 = SA01 * d01 + tA01; SA23 = SA23 * d23 + tA23; SB01 = SB01 * d01 + tB01; SB23 = SB23 * d23 + tB23;
                        f32x2 qA = SA01 * r01; qA = SA23 * r23 + qA;
                        f32x2 qB = SB01 * r01; qB = SB23 * r23 + qB;
                        const float yA = rowsum16(qA.x + qA.y), yB = rowsum16(qB.x + qB.y);
                        ykA = (kg == j) ? yA : ykA; ykB = (kg == j) ? yB : ykB;
                    }
                    { f32x2 yy = {ykA, ykB}; *(LAS f32x2*)(yb + (tb + kg) * 32 + 2 * rp) = yy; }
                }
            } else {
                if (c + 1 < NCH) SCAN_STORE((c + 1) & 1);
                if (c + 2 < NCH) SCAN_LOAD(c + 2);
                if (c >= 1) SCAN_FLUSH(c - 1);
            }
            __syncthreads();
        }
        if (wu >= 4) SCAN_FLUSH(NCH - 1);
#undef SCAN_LOAD
#undef SCAN_STORE
#undef SCAN_FLUSH
    }
}

__device__ void post_phase(const Params& P, int i) {
    const int tid_ = otid(); const int w = tid_ >> 6, lane = tid_ & 63;
    const bf16_t* RB = (const bf16_t*)(P.ws + OFF_RB); const float* KF = (const float*)(P.ws + OFF_KF); const float* VF = (const float*)(P.ws + OFF_VF);
    const bf16_t* AB = (const bf16_t*)(P.ws + OFF_MIX); const bf16_t* GB = (const bf16_t*)(P.ws + OFF_MIX + SZB); bf16_t* YB = (bf16_t*)(P.ws + OFF_MIX + 2 * SZB);
    const float* k_a = P.in[21] + (size_t)i * D; const float* r_k = P.in[22] + (size_t)i * D;
    const float* gn_w = P.in[23] + (size_t)i * D; const float* gn_b = P.in[24] + (size_t)i * D;
    for (int r = obid() * 8 + w; r < M; r += gridDim.x * 8) {
#pragma unroll
        for (int q = 0; q < 8; ++q) {
            const int col = 256 * q + 4 * lane; const size_t o = (size_t)r * D + col;
            const u32x2 yv = *(const u32x2*)(YB + o), rv = *(const u32x2*)(RB + o), av = *(const u32x2*)(AB + o), gv = *(const u32x2*)(GB + o);
            const f32x4 kv = *(const f32x4*)(KF + o), vv = *(const f32x4*)(VF + o);
            const f32x4 ka = *(const f32x4*)(k_a + col), rk = *(const f32x4*)(r_k + col), gw = *(const f32x4*)(gn_w + col), gb = *(const f32x4*)(gn_b + col);
            float y[4] = {bf_lo(yv.x), bf_hi(yv.x), bf_lo(yv.y), bf_hi(yv.y)};
            const float rr[4] = {bf_lo(rv.x), bf_hi(rv.x), bf_lo(rv.y), bf_hi(rv.y)};
            const float aa[4] = {bf_lo(av.x), bf_hi(av.x), bf_lo(av.y), bf_hi(av.y)};
            const float gg[4] = {bf_lo(gv.x), bf_hi(gv.x), bf_lo(gv.y), bf_hi(gv.y)};
            float sy = 0.f, sb = 0.f;
#pragma unroll
            for (int e = 0; e < 4; ++e) { sy += y[e]; const float kp = kv[e] * (1.0f + (aa[e] - 1.0f) * ka[e]); sb += rr[e] * kp * rk[e]; }
            sy = rowsum16(sy); sb = rowsum16(sb);
            const float mean = sy * (1.0f / 64.0f);
            float sv = 0.f;
#pragma unroll
            for (int e = 0; e < 4; ++e) { y[e] -= mean; sv += y[e] * y[e]; }
            sv = rowsum16(sv);
            const float rstd = rsqrtf(sv * (1.0f / 64.0f) + 64e-5f);
            float z[4];
#pragma unroll
            for (int e = 0; e < 4; ++e) z[e] = (y[e] * rstd * gw[e] + gb[e] + sb * vv[e]) * gg[e];
            u32x2 zo; zo.x = cvt_pk_bf16(z[0], z[1]); zo.y = cvt_pk_bf16(z[2], z[3]);
            *(u32x2*)(YB + o) = zo;
        }
    }
}

__device__ void headnorm_phase(const Params& P, LAS unsigned char* lds) {
    const int tid = otid(), w = tid >> 6, lane = tid & 63;
    const float* KR = (const float*)(P.ws + OFF_KF); const float* VR = (const float*)(P.ws + OFF_VF);
    bf16_t* KN = (bf16_t*)(P.ws + OFF_MIX + 2 * SZB); bf16_t* VT = (bf16_t*)(P.ws + OFF_DEC);
    const float* kg = P.in[31];
    for (int r = obid() * 8 + w; r < M; r += gridDim.x * 8) {
#pragma unroll
        for (int q = 0; q < 8; ++q) {
            const int col = 256 * q + 4 * lane; const size_t o = (size_t)r * D + col;
            const f32x4 kv = *(const f32x4*)(KR + o);
            float ss = kv[0] * kv[0] + kv[1] * kv[1] + kv[2] * kv[2] + kv[3] * kv[3];
            ss = rowsum16(ss); ss += __shfl_xor(ss, 16);
            const float rs = rsqrtf(ss * (1.0f / 128.0f) + 1e-6f);
            const f32x4 gv = *(const f32x4*)(kg + (col & 127));
            u32x2 a; a.x = cvt_pk_bf16(kv[0] * rs * gv[0], kv[1] * rs * gv[1]); a.y = cvt_pk_bf16(kv[2] * rs * gv[2], kv[3] * rs * gv[3]);
            *(u32x2*)(KN + o) = a;
        }
    }
    LAS float* tile = (LAS float*)lds;
    for (int it = obid(); it < NBATCH * 66 * 16; it += gridDim.x) {
        const int h = it & 15, pt = (it >> 4) % 66, b = it / (16 * 66);
        __syncthreads();
#pragma unroll
        for (int pass = 0; pass < 4; ++pass) {
            const int key = (tid >> 5) + pass * 16, c4 = (tid & 31) * 4;
            const int t = 64 * pt + key - PPAD;
            f32x4 v = (f32x4){0.f, 0.f, 0.f, 0.f};
            if (t >= 0) v = *(const f32x4*)(VR + (size_t)rowof(b, t) * D + 128 * h + c4);
            tile[key * 129 + c4] = v[0]; tile[key * 129 + c4 + 1] = v[1]; tile[key * 129 + c4 + 2] = v[2]; tile[key * 129 + c4 + 3] = v[3];
        }
        __syncthreads();
        const int d = tid >> 2, k16 = (tid & 3) * 16;
        float e[16];
#pragma unroll
        for (int x = 0; x < 16; ++x) e[x] = tile[(k16 + x) * 129 + d];
        u32x4 o0, o1;
        o0.x = cvt_pk_bf16(e[0], e[1]); o0.y = cvt_pk_bf16(e[2], e[3]); o0.z = cvt_pk_bf16(e[4], e[5]); o0.w = cvt_pk_bf16(e[6], e[7]);
        o1.x = cvt_pk_bf16(e[8], e[9]); o1.y = cvt_pk_bf16(e[10], e[11]); o1.z = cvt_pk_bf16(e[12], e[13]); o1.w = cvt_pk_bf16(e[14], e[15]);
        bf16_t* dst = VT + ((size_t)((b * 16 + h) * 128 + d)) * PLEN + 64 * pt + k16;
        *(u32x4*)dst = o0; *(u32x4*)(dst + 8) = o1;
    }
}

__device__ void attn_phase(const Params& P, int j, LAS unsigned char* lds) {
    const int tid = otid(), w = tid >> 6, lane = tid & 63, fr = lane & 15, fq = lane >> 4;
    const float* QF = (const float*)(P.ws + OFF_RB);
    const bf16_t* KN = (const bf16_t*)(P.ws + OFF_MIX + 2 * SZB);
    const bf16_t* VT = (const bf16_t*)(P.ws + OFF_DEC);
    bf16_t* OB = (bf16_t*)(P.ws + OFF_MIX);
    const float* qg = P.in[33] + j * 128;
    constexpr int KSTR = 272, VSTR = 144, KBYTES = 64 * KSTR, VBYTES = 128 * VSTR, STGB = KBYTES + VBYTES;
    for (int u = obid(); u < 64 * 33; u += gridDim.x) {
        const int qb = 32 - u / 64, bh = u % 64, b = bh >> 4, h = bh & 15;
        const int pq = 128 * qb + 16 * w + fr, tq = pq - PPAD;
        const int qrow = rowof(b, tq > 0 ? tq : 0);
        bf16x8 qf[4];
        {
            const float* qp = QF + (size_t)qrow * D + 128 * h + 8 * fq;
            f32x4 qa[4], qc[4]; float ss = 0.f;
#pragma unroll
            for (int s = 0; s < 4; ++s) { qa[s] = *(const f32x4*)(qp + 32 * s); qc[s] = *(const f32x4*)(qp + 32 * s + 4);
                ss += qa[s][0] * qa[s][0] + qa[s][1] * qa[s][1] + qa[s][2] * qa[s][2] + qa[s][3] * qa[s][3] + qc[s][0] * qc[s][0] + qc[s][1] * qc[s][1] + qc[s][2] * qc[s][2] + qc[s][3] * qc[s][3]; }
            ss += __shfl_xor(ss, 16); ss += __shfl_xor(ss, 32);
            const float rs = rsqrtf(ss * (1.0f / 128.0f) + 1e-6f) * 0.08838834764831845f;
#pragma unroll
            for (int s = 0; s < 4; ++s) {
                const f32x4 g0 = *(const f32x4*)(qg + 32 * s + 8 * fq), g1 = *(const f32x4*)(qg + 32 * s + 8 * fq + 4);
                u32x4 pk; pk.x = cvt_pk_bf16(qa[s][0] * rs * g0[0], qa[s][1] * rs * g0[1]); pk.y = cvt_pk_bf16(qa[s][2] * rs * g0[2], qa[s][3] * rs * g0[3]);
                pk.z = cvt_pk_bf16(qc[s][0] * rs * g1[0], qc[s][1] * rs * g1[1]); pk.w = cvt_pk_bf16(qc[s][2] * rs * g1[2], qc[s][3] * rs * g1[3]);
                qf[s] = __builtin_bit_cast(bf16x8, pk);
            }
        }
        f32x4 oacc[8];
#pragma unroll
        for (int x = 0; x < 8; ++x) oacc[x] = (f32x4){0.f, 0.f, 0.f, 0.f};
        float carry = 1.0f;
        u32x4 kr[2], vr[2];
#define ATT_LOAD(kt_) do { _Pragma("unroll") for (int i_ = 0; i_ < 2; ++i_) { const int id_ = tid + 512 * i_; \
            { const int row_ = id_ >> 4, c_ = id_ & 15; const int tk_ = 64 * (kt_) + row_ - PPAD; \
              kr[i_] = *(const u32x4*)(KN + (size_t)rowof(b, tk_ > 0 ? tk_ : 0) * D + 128 * h + 8 * c_); } \
            { const int d_ = id_ >> 3, c_ = id_ & 7; vr[i_] = *(const u32x4*)(VT + ((size_t)(bh * 128 + d_)) * PLEN + 64 * (kt_) + 8 * c_); } } } while (0)
#define ATT_WRITE(st_) do { _Pragma("unroll") for (int i_ = 0; i_ < 2; ++i_) { const int id_ = tid + 512 * i_; \
            *(LAS u32x4*)(lds + (st_) * STGB + (id_ >> 4) * KSTR + 16 * (id_ & 15)) = kr[i_]; \
            *(LAS u32x4*)(lds + (st_) * STGB + KBYTES + (id_ >> 3) * VSTR + 16 * (id_ & 7)) = vr[i_]; } } while (0)
        const int nti = 2 * qb + 1;
        __syncthreads();
        ATT_LOAD(nti); ATT_WRITE(0);
        __syncthreads();
        for (int it = 0; it < nti; ++it) {
            const int kt = nti - it;
            if (it + 1 < nti) ATT_LOAD(kt - 1);
            const LAS unsigned char* Ks = lds + (it & 1) * STGB; const LAS unsigned char* Vs = Ks + KBYTES;
            f32x4 st[4];
#pragma unroll
            for (int n = 0; n < 4; ++n) { st[n] = (f32x4){0.f, 0.f, 0.f, 0.f};
#pragma unroll
                for (int s = 0; s < 4; ++s) { const bf16x8 a = *(const LAS bf16x8*)(Ks + (16 * n + fr) * KSTR + 64 * s + 16 * fq);
                    st[n] = __builtin_amdgcn_mfma_f32_16x16x32_bf16(a, qf[s], st[n], 0, 0, 0); } }
            const bool need_mask = (kt >= 2 * qb) || (kt == 1);
            float kp[4][4], sg[4][4];
#pragma unroll
            for (int n = 0; n < 4; ++n)
#pragma unroll
                for (int e = 0; e < 4; ++e) { const float z = st[n][e]; const float ex = __expf(-fabsf(z)); const float r = __builtin_amdgcn_rcpf(1.0f + ex);
                    const bool pos = z >= 0.f; sg[n][e] = (pos ? 1.0f : ex) * r; kp[n][e] = (pos ? ex : 1.0f) * r; }
            if (need_mask) {
#pragma unroll
                for (int n = 0; n < 4; ++n)
#pragma unroll
                    for (int e = 0; e < 4; ++e) { const int pk = 64 * kt + 16 * n + 4 * fq + e; const bool valid = (pk < pq) && (pk >= PPAD);
                        if (!valid) { kp[n][e] = 1.0f; sg[n][e] = 0.f; } }
            }
            float X[4], Bt[4];
            {
                LAS f32x4* xch = (LAS f32x4*)(lds + 2 * STGB) + w * 64;
                f32x4 Tv;
#pragma unroll
                for (int n = 0; n < 4; ++n) Tv[n] = (kp[n][0] * kp[n][1]) * (kp[n][2] * kp[n][3]);
                xch[lane] = Tv;
                const f32x4 t0 = xch[fr], t1 = xch[fr + 16], t2 = xch[fr + 32], t3 = xch[fr + 48];
#pragma unroll
                for (int n = 0; n < 4; ++n) {
                    X[n] = (fq < 1 ? t1[n] : 1.0f) * (fq < 2 ? t2[n] : 1.0f) * (fq < 3 ? t3[n] : 1.0f);
                    Bt[n] = (t0[n] * t1[n]) * (t2[n] * t3[n]);
                }
            }
            float wgt[4][4]; float run = carry;
#pragma unroll
            for (int n = 3; n >= 0; --n) { const float s3 = run * X[n]; const float s2 = s3 * kp[n][3]; const float s1 = s2 * kp[n][2]; const float s0 = s1 * kp[n][1];
                wgt[n][3] = sg[n][3] * s3; wgt[n][2] = sg[n][2] * s2; wgt[n][1] = sg[n][1] * s1; wgt[n][0] = sg[n][0] * s0;
                run *= Bt[n]; }
            carry = run;
#pragma unroll
            for (int s2 = 0; s2 < 2; ++s2) {
                u32x4 pk; pk.x = cvt_pk_bf16(wgt[2 * s2][0], wgt[2 * s2][1]); pk.y = cvt_pk_bf16(wgt[2 * s2][2], wgt[2 * s2][3]);
                pk.z = cvt_pk_bf16(wgt[2 * s2 + 1][0], wgt[2 * s2 + 1][1]); pk.w = cvt_pk_bf16(wgt[2 * s2 + 1][2], wgt[2 * s2 + 1][3]);
                const bf16x8 pf = __builtin_bit_cast(bf16x8, pk);
#pragma unroll
                for (int db = 0; db < 8; ++db) {
                    const LAS unsigned char* vp = Vs + (16 * db + fr) * VSTR + 64 * s2 + 8 * fq;
                    const u32x2 v0 = *(const LAS u32x2*)vp, v1 = *(const LAS u32x2*)(vp + 32);
                    u32x4 vv; vv.x = v0.x; vv.y = v0.y; vv.z = v1.x; vv.w = v1.y;
                    oacc[db] = __builtin_amdgcn_mfma_f32_16x16x32_bf16(__builtin_bit_cast(bf16x8, vv), pf, oacc[db], 0, 0, 0);
                }
            }
            if (it + 1 < nti) ATT_WRITE((it + 1) & 1);
#ifndef NO_EARLY_EXIT
            LAS int* flg = (LAS int*)(lds + 2 * STGB + 8192) + (it & 1) * 8;
            { const int dead = __all(carry == 0.f); if (lane == 0) flg[w] = dead; }
            __syncthreads();
            { int alld = 1;
#pragma unroll
              for (int x = 0; x < 8; ++x) alld &= flg[x];
              if (alld) break; }
#else
            __syncthreads();
#endif
        }
#undef ATT_LOAD
#undef ATT_WRITE
        if (tq >= 0) {
#pragma unroll
            for (int db = 0; db < 8; ++db) { u32x2 o; o.x = cvt_pk_bf16(oacc[db][0], oacc[db][1]); o.y = cvt_pk_bf16(oacc[db][2], oacc[db][3]);
                *(u32x2*)(OB + (size_t)qrow * D + 128 * h + 16 * db + 4 * fq) = o; }
        }
    }
}

__device__ __forceinline__ void grid_barrier(unsigned* ctr, unsigned target) {
    asm volatile("s_waitcnt vmcnt(0) lgkmcnt(0)" ::: "memory");
    __syncthreads();
    if (threadIdx.x == 0) {
        __builtin_amdgcn_fence(__ATOMIC_RELEASE, "agent");
        asm volatile("s_waitcnt vmcnt(0)" ::: "memory");
        __hip_atomic_fetch_add(ctr, 1u, __ATOMIC_RELAXED, __HIP_MEMORY_SCOPE_AGENT);
        while (__hip_atomic_load(ctr, __ATOMIC_RELAXED, __HIP_MEMORY_SCOPE_AGENT) < target) __builtin_amdgcn_s_sleep(2);
        __builtin_amdgcn_fence(__ATOMIC_ACQUIRE, "agent");
        asm volatile("s_waitcnt vmcnt(0)" ::: "memory");
    }
    __syncthreads();
}

#ifndef DUP_ATTN
#define DUP_ATTN 0
#endif
#ifndef DUP_FFN1
#define DUP_FFN1 0
#endif
#ifndef DUP_SCAN
#define DUP_SCAN 0
#endif
constexpr int NPHASE = 35 + 2 * DUP_ATTN + 4 * DUP_FFN1 + 2 * DUP_SCAN;
enum { K_INIT = 0, K_MIXPREP, K_GEMM, K_SCAN, K_POST, K_NORMF, K_NORMSB, K_HEADNORM, K_ATTN };
struct Tab { PE e[NPHASE]; };
constexpr GD mkgd(size_t A, size_t Bt, int N, int mode, size_t o0, size_t o1, int bin, int boff, int ldo) {
    GD g{}; g.A = A; g.Bt = Bt; g.o0 = o0; g.o1 = o1; g.N = N; g.mode = mode; g.bin = bin; g.boff = boff; g.ldo = ldo; g.pad = 0; return g;
}
constexpr PE mkgemm(int layer, int sub) {
    PE p{}; p.kind = K_GEMM; p.layer = layer; p.sub = sub; p.ng = 1; p.K = D; p.pad = 0;
    const int i = layer;
    for (int q = 0; q < 4; ++q) p.g[q] = mkgd(0, 0, 256, 0, 0, 0, 0, 0, D);
    if (sub == 0) {
        p.g[0] = mkgd(OFF_MIX, OFF_WA + WA_W0, D, 0, OFF_RB, 0, 0, 0, D);
        p.g[1] = mkgd(OFF_MIX + SZB, OFF_WA + WA_W1, D, 1, OFF_KF, 0, 0, 0, D);
        p.g[2] = mkgd(OFF_MIX + 2 * SZB, OFF_WA + WA_W2, D, i == 0 ? 2 : 1, OFF_VF, OFF_VFIRST, 0, 0, D);
        p.ng = 3;
    } else if (sub == 1) {
        p.g[0] = mkgd(OFF_DEC, OFF_WA + WA_L1 + 0 * WSLOT, 256, 3, OFF_LORA + 0 * SZLORA, 0, 0, 0, 256);
        p.g[1] = mkgd(OFF_DEC + SZB, OFF_WA + WA_L1 + 1 * WSLOT, 256, 0, OFF_LORA + 1 * SZLORA, 0, 0, 0, 256);
        p.g[2] = mkgd(OFF_KF, OFF_WA + WA_L1 + 2 * WSLOT, 256, 4, OFF_LORA + 2 * SZLORA, 0, 0, 0, 256);
        p.ng = 3;
        if (i >= 1) { p.g[3] = mkgd(OFF_MIX + 2 * SZB, OFF_WA + WA_L1 + 3 * WSLOT, 256, 0, OFF_LORA + 3 * SZLORA, 0, 0, 0, 256); p.ng = 4; }
    } else if (sub == 2) {
        p.K = 256;
        p.g[0] = mkgd(OFF_LORA + 0 * SZLORA, OFF_WA + WA_L2 + 0 * WSLOT, D, 5, OFF_DEC, 0, 12, i * D, D);
        p.g[1] = mkgd(OFF_LORA + 1 * SZLORA, OFF_WA + WA_L2 + 1 * WSLOT, D, 6, OFF_MIX, 0, 15, i * D, D);
        p.g[2] = mkgd(OFF_LORA + 2 * SZLORA, OFF_WA + WA_L2 + 2 * WSLOT, D, 0, OFF_MIX + SZB, 0, 0, 0, D);
        p.ng = 3;
        if (i >= 1) { p.g[3] = mkgd(OFF_LORA + 3 * SZLORA, OFF_WA + WA_L2 + 3 * WSLOT, D, 7, OFF_VF, OFF_VFIRST, 25, (i - 1) * D, D); p.ng = 4; }
    } else if (sub == 3) {
        p.g[0] = mkgd(OFF_MIX + 2 * SZB, OFF_WB + WB_WO, D, 8, 0, 0, 0, 0, D);
    } else if (sub == 4) {
        p.g[0] = mkgd(OFF_HN2, OFF_WB + WB_F1, 2 * FF, 9, OFF_ACT, 0, 0, 0, FF);
    } else if (sub == 5) {
        p.K = FF;
        p.g[0] = mkgd(OFF_ACT, OFF_WB + WB_F2, D, 8, 0, 0, 0, 0, D);
    } else if (sub == 6) {
        p.g[0] = mkgd(OFF_MIX, OFF_WA + WA_W0, D, 1, OFF_RB, 0, 0, 0, D);
        if (layer == 2) {
            p.g[1] = mkgd(OFF_MIX + SZB, OFF_WA + WA_W1, D, 1, OFF_KF, 0, 0, 0, D);
            p.g[2] = mkgd(OFF_MIX + SZB, OFF_WA + WA_W2, D, 1, OFF_VF, 0, 0, 0, D);
            p.ng = 3;
        }
    } else {
        p.g[0] = mkgd(OFF_MIX, OFF_WB + WB_WO, D, 8, 0, 0, 0, 0, D);
    }
    return p;
}
constexpr PE mkother(int kind, int layer, int sub) { PE p{}; p.kind = kind; p.layer = layer; p.sub = sub; p.ng = 0; p.K = D; p.pad = 0; for (int q = 0; q < 4; ++q) p.g[q] = mkgd(0, 0, 256, 0, 0, 0, 0, 0, D); return p; }
constexpr Tab make_tab() {
    Tab t{};
    int n = 0;
    for (int i = 0; i < 2; ++i) {
        t.e[n++] = mkother(K_MIXPREP, i, 0);
        t.e[n++] = mkgemm(i, 1);
        t.e[n++] = mkgemm(i, 0);
        t.e[n++] = mkgemm(i, 2);
        t.e[n++] = mkother(K_SCAN, i, 0);
        if (DUP_SCAN) t.e[n++] = mkother(K_SCAN, i, 0);
        t.e[n++] = mkother(K_POST, i, 0);
        t.e[n++] = mkgemm(i, 3);
        t.e[n++] = mkother(K_NORMF, i, 0);
        t.e[n++] = mkgemm(i, 4);
        if (DUP_FFN1) t.e[n++] = mkgemm(i, 4);
        t.e[n++] = mkgemm(i, 5);
    }
    for (int j = 0; j < 2; ++j) {
        const int layer = 2 + j;
        t.e[n++] = mkother(K_NORMSB, layer, 0);
        t.e[n++] = mkgemm(layer, 6);
        if (j == 0) t.e[n++] = mkother(K_HEADNORM, layer, 0);
        t.e[n++] = mkother(K_ATTN, layer, 0);
        if (DUP_ATTN) t.e[n++] = mkother(K_ATTN, layer, 0);
        t.e[n++] = mkgemm(layer, 7);
        t.e[n++] = mkother(K_NORMF, layer, 0);
        t.e[n++] = mkgemm(layer, 4);
        if (DUP_FFN1) t.e[n++] = mkgemm(layer, 4);
        t.e[n++] = mkgemm(layer, 5);
    }
    return t;
}
__constant__ const Tab TAB = make_tab();

#ifndef ONLY
#define ONLY -1
#endif
#define EN(k) (ONLY < 0 || ONLY == (k))

__global__ void __launch_bounds__(512, 2) mk_forward(Params P, int ph_lo, int ph_hi) {
    extern __shared__ __attribute__((aligned(16))) unsigned char shm[];
    LAS unsigned char* lds = (LAS unsigned char*)shm;
    cg::grid_group grid = cg::this_grid();
    for (int ph = ph_lo; ph < ph_hi; ++ph) {
        const PE* pe = &TAB.e[ph];
        const int kind = pe->kind, layer = pe->layer, sub = pe->sub;
        if (kind == K_GEMM) { if (EN(K_GEMM)) {
            const bool tail_first = (blockIdx.x & 1) != 0;
            if (tail_first) { tail_gemm(lds, pe, P); __syncthreads(); }
            gemm_phase(lds, pe, P);
            if (!tail_first) tail_gemm(lds, pe, P); } }
        else if (!EN(kind)) {}
        else if (kind == K_MIXPREP) { mixprep_phase(P, layer); convert_layer(P, layer, lds); }
        else if (kind == K_SCAN) scan_phase(P, layer, lds);
        else if (kind == K_POST) post_phase(P, layer);
        else if (kind == K_NORMF) norm_phase(P, P.in[3] + (size_t)layer * D, (bf16_t*)(P.ws + OFF_HN2), nullptr, nullptr);
        else if (kind == K_NORMSB) {
            norm_phase(P, P.in[2] + (size_t)layer * D, (bf16_t*)(P.ws + OFF_MIX), layer == 2 ? P.in[28] : nullptr, (bf16_t*)(P.ws + OFF_MIX + SZB));
            convert_layer(P, layer, lds);
        }
        else if (kind == K_HEADNORM) { if (layer == 2) headnorm_phase(P, lds); }
        else if (kind == K_ATTN) attn_phase(P, layer - 2, lds);
        if (ph + 1 < ph_hi) {
#ifdef USE_CG_SYNC
            grid.sync();
#else
            if (ph == ph_lo) {
                if (blockIdx.x == 0 && threadIdx.x == 0) __hip_atomic_store((unsigned*)(P.ws + WS_END), 0u, __ATOMIC_RELAXED, __HIP_MEMORY_SCOPE_AGENT);
                grid.sync();
            }
            else grid_barrier((unsigned*)(P.ws + WS_END), (unsigned)(ph - ph_lo) * gridDim.x);
#endif
        }
    }
}

__global__ void dbg_copy(Params P, size_t off_bf16a, size_t off_bf16b, size_t off_f32) {
    const size_t n = (size_t)MMAIN * D;
    for (size_t i = (size_t)blockIdx.x * blockDim.x + threadIdx.x; i < n; i += (size_t)gridDim.x * blockDim.x) {
        float v = 0.f;
        if (off_bf16a) v += __uint_as_float(((unsigned)((const bf16_t*)(P.ws + off_bf16a))[i]) << 16);
        if (off_bf16b) v += __uint_as_float(((unsigned)((const bf16_t*)(P.ws + off_bf16b))[i]) << 16);
        if (off_f32) v += ((const float*)(P.ws + off_f32))[i];
        P.out[i] = v;
    }
}
extern "C" void kernel_launch(void* const* d_in, const int* in_sizes, int n_in, void* d_out, int out_size, void* d_ws, size_t ws_size, hipStream_t stream) {
    constexpr size_t kDynLds = 131072;
    static int grid_blocks = 0;
    if (!grid_blocks) {
        hipFuncSetAttribute((const void*)mk_forward, hipFuncAttributeMaxDynamicSharedMemorySize, (int)kDynLds);
        int dev = 0, cus = 0, per_cu = 0;
        hipGetDevice(&dev);
        hipDeviceGetAttribute(&cus, hipDeviceAttributeMultiprocessorCount, dev);
        hipOccupancyMaxActiveBlocksPerMultiprocessor(&per_cu, mk_forward, NTHR, kDynLds);
        if (per_cu < 1) per_cu = 1;
        grid_blocks = cus * per_cu;
        if (ws_size < WS_END) fprintf(stderr, "workspace too small: %zu < %zu\n", ws_size, (size_t)WS_END);
    }
    Params p{};
    for (int i = 0; i < 35; ++i) p.in[i] = (const float*)d_in[i];
    p.out = (float*)d_out; p.ws = (unsigned char*)d_ws;
#ifdef MULTI_LAUNCH
    for (int ph = 0; ph < NPHASE; ++ph) hipLaunchKernelGGL(mk_forward, dim3(grid_blocks), dim3(NTHR), kDynLds, stream, p, ph, ph + 1);
#ifdef DBG_A
    hipLaunchKernelGGL(dbg_copy, dim3(2048), dim3(256), 0, stream, p, (size_t)DBG_A, (size_t)DBG_B, (size_t)DBG_F);
#endif
#else
    int lo = 0, hi = NPHASE;
    void* args[] = {&p, &lo, &hi};
    hipError_t e = hipLaunchCooperativeKernel((void*)mk_forward, dim3(grid_blocks), dim3(NTHR), args, kDynLds, stream);
    if (e != hipSuccess) fprintf(stderr, "cooperative launch failed: %s (grid %d)\n", hipGetErrorString(e), grid_blocks);
#endif
}
```

```cpp
#include <hip/hip_runtime.h>
#include <hip/hip_cooperative_groups.h>
#include <cstdio>
namespace cg = cooperative_groups;

#define LAS __attribute__((address_space(3)))
typedef unsigned short bf16_t;
typedef short bf16x8 __attribute__((ext_vector_type(8)));
typedef float f32x4 __attribute__((ext_vector_type(4)));
typedef unsigned u32x2 __attribute__((ext_vector_type(2)));
typedef unsigned u32x4 __attribute__((ext_vector_type(4)));

constexpr int D = 2048, FF = 5632, NBATCH = 4, SEQ = 4096, NMETA = 16, L = SEQ + NMETA;
constexpr int M = NBATCH * L;
constexpr int MMAIN = NBATCH * SEQ;
constexpr int MP = 16640;
constexpr int NTHR = 512;
constexpr int PPAD = 112, PLEN = 4224;

constexpr size_t SZB = (size_t)MP * D * 2, SZF = 2 * SZB;
constexpr size_t OFF_WA = 0;
constexpr size_t OFF_WB = 37748736;
constexpr size_t OFF_HT = OFF_WB + 83886080;
constexpr size_t OFF_RB = OFF_HT + 1048576;
constexpr size_t OFF_VFIRST = OFF_RB + SZB;
constexpr size_t OFF_KF = OFF_VFIRST + SZB;
constexpr size_t OFF_VF = OFF_KF + SZF;
constexpr size_t OFF_DEC = OFF_VF + SZF;
constexpr size_t OFF_MIX = OFF_DEC + SZF;
constexpr size_t OFF_LORA = OFF_MIX + 3 * SZB;
constexpr size_t SZLORA = (size_t)MP * 256 * 2;
constexpr size_t WS_END = OFF_LORA + 4 * SZLORA;
constexpr size_t OFF_HN2 = OFF_KF, OFF_ACT = OFF_KF + SZB;
constexpr size_t WA_W0 = 0, WA_W1 = 8388608, WA_W2 = 16777216, WA_L1 = 25165824, WA_L2 = 29360128, WSLOT = 1048576;
constexpr size_t WB_WO = 0, WB_F1 = 8388608, WB_F2 = WB_F1 + (size_t)2 * FF * D * 2;

struct Params {
    const float* in[35];
    float* out;
    unsigned char* ws;
};

__device__ __forceinline__ int rowof(int b, int t) { return t < NMETA ? MMAIN + b * NMETA + t : b * SEQ + (t - NMETA); }
__device__ __forceinline__ float* hrow(const Params& P, int r) {
    return r < MMAIN ? P.out + (size_t)r * D : (float*)(P.ws + OFF_HT) + (size_t)(r - MMAIN) * D;
}
__device__ __forceinline__ unsigned cvt_pk_bf16(float lo, float hi) { unsigned r; asm volatile("v_cvt_pk_bf16_f32 %0, %1, %2" : "=v"(r) : "v"(lo), "v"(hi)); return r; }
__device__ __forceinline__ float bf_lo(unsigned x) { return __uint_as_float(x << 16); }
__device__ __forceinline__ float bf_hi(unsigned x) { return __uint_as_float(x & 0xffff0000u); }
template <int CTRL> __device__ __forceinline__ float dpp_mov(float x) {
    return __int_as_float(__builtin_amdgcn_update_dpp(0, __float_as_int(x), CTRL, 0xF, 0xF, true));
}
__device__ __forceinline__ float rowsum16(float x) {
    x += dpp_mov<0x128>(x); x += dpp_mov<0x124>(x); x += dpp_mov<0x122>(x); x += dpp_mov<0x121>(x); return x;
}
__device__ __forceinline__ float wavesum(float x) { x = rowsum16(x); x += __shfl_xor(x, 16); x += __shfl_xor(x, 32); return x; }
__device__ __forceinline__ int otid() { int t = threadIdx.x; asm volatile("" : "+v"(t)); return t; }
__device__ __forceinline__ int obid() { int t = blockIdx.x; asm volatile("" : "+s"(t)); return t; }
__device__ __forceinline__ float sigmoidf_(float x) { return 1.0f / (1.0f + __expf(-x)); }

constexpr int BM = 256, BK = 64, HALF = 128, HTB = HALF * BK * 2, NXCD = 8, WGM = 8, NMT = MMAIN / BM;
__device__ __forceinline__ int lds_byte(int r, int c) { const int st = (r >> 4) * 2 + (c >> 5), rr = r & 15, cc = c & 31, ob = rr * 64 + cc * 2; return st * 1024 + (ob ^ (((ob >> 9) & 1) << 5)); }
__device__ __forceinline__ void stage_rc(int b, int& R, int& C) { const int st = b / 1024, sb = b % 1024, swz = sb ^ (((sb >> 9) & 1) << 5); R = (st >> 1) * 16 + swz / 64; C = (st & 1) * 32 + (swz % 64) / 2; }

struct GD { unsigned long long A, Bt, o0, o1; int N, mode, bin, boff, ldo, pad; };
struct PE { int kind, layer, sub, ng, K, pad; GD g[4]; };
struct Unit { int pm, pn, gi; };

__device__ __forceinline__ bool sched_next(const int Lx, const int c1, const int c2, const int c3, const int c4, Unit& u) {
    if (Lx >= c4) return false;
    int gi = 0, base = 0, top = c1;
    if (Lx >= c1) { gi = 1; base = c1; top = c2; }
    if (Lx >= c2) { gi = 2; base = c2; top = c3; }
    if (Lx >= c3) { gi = 3; base = c3; top = c4; }
    const int nM = NMT, nwg = top - base, nN = nwg / NMT;
    int wgid = Lx - base; { const int q = nwg / NXCD, r = nwg % NXCD, xcd = wgid % NXCD, off = wgid / NXCD; wgid = (xcd < r ? xcd * (q + 1) : r * (q + 1) + (xcd - r) * q) + off; }
    const int nig = WGM * nN, gid = wgid / nig, fm = gid * WGM, gsz = (nM - fm) < WGM ? (nM - fm) : WGM;
    u.pm = fm + ((wgid % nig) % gsz); u.pn = (wgid % nig) / gsz; u.gi = gi; return true;
}

template <int MODE>
__device__ __forceinline__ void epi_elem(const int r, const int c, f32x4 v, void* g_o0, void* g_o1, const f32x4 bv, const int ldo, float* outp, float* htp) {
    if constexpr (MODE == 8) {
        float* p = (r < MMAIN ? outp + (size_t)r * D : htp + (size_t)(r - MMAIN) * D) + c; f32x4 hv = *(f32x4*)p; *(f32x4*)p = hv + v;
    } else if constexpr (MODE == 1) {
        *(f32x4*)((float*)g_o0 + (size_t)r * ldo + c) = v;
    } else if constexpr (MODE == 2) {
        *(f32x4*)((float*)g_o0 + (size_t)r * ldo + c) = v;
        u32x2 wv; wv.x = cvt_pk_bf16(v[0], v[1]); wv.y = cvt_pk_bf16(v[2], v[3]);
        *(u32x2*)((bf16_t*)g_o1 + (size_t)r * ldo + c) = wv;
    } else if constexpr (MODE == 5) {
        f32x4 o;
#pragma unroll
        for (int e = 0; e < 4; ++e) { const float x = -(bv[e] + v[e]); const float sp = fmaxf(x, 0.f) + __logf(1.0f + __expf(-fabsf(x))); const float wl = -sp - 0.5f; o[e] = __expf(-__expf(wl)); }
        *(f32x4*)((float*)g_o0 + (size_t)r * ldo + c) = o;
    } else if constexpr (MODE == 7) {
        float* vp = (float*)g_o0 + (size_t)r * ldo + c; const f32x4 vv = *(f32x4*)vp;
        const u32x2 vf = *(const u32x2*)((const bf16_t*)g_o1 + (size_t)r * ldo + c);
        const float f0 = bf_lo(vf.x), f1 = bf_hi(vf.x), f2 = bf_lo(vf.y), f3 = bf_hi(vf.y);
        f32x4 o;
        o[0] = vv[0] + (f0 - vv[0]) * sigmoidf_(bv[0] + v[0]); o[1] = vv[1] + (f1 - vv[1]) * sigmoidf_(bv[1] + v[1]);
        o[2] = vv[2] + (f2 - vv[2]) * sigmoidf_(bv[2] + v[2]); o[3] = vv[3] + (f3 - vv[3]) * sigmoidf_(bv[3] + v[3]);
        *(f32x4*)vp = o;
    } else {
        if constexpr (MODE == 3) {
#pragma unroll
            for (int e = 0; e < 4; ++e) { const float ax = fminf(fabsf(v[e]), 15.0f); const float t = 1.0f - 2.0f / (__expf(2.0f * ax) + 1.0f); v[e] = v[e] < 0.f ? -t : t; } }
        else if constexpr (MODE == 4) { v[0] = sigmoidf_(v[0]); v[1] = sigmoidf_(v[1]); v[2] = sigmoidf_(v[2]); v[3] = sigmoidf_(v[3]); }
        else if constexpr (MODE == 6) { v[0] = sigmoidf_(bv[0] + v[0]); v[1] = sigmoidf_(bv[1] + v[1]); v[2] = sigmoidf_(bv[2] + v[2]); v[3] = sigmoidf_(bv[3] + v[3]); }
        u32x2 wv; wv.x = cvt_pk_bf16(v[0], v[1]); wv.y = cvt_pk_bf16(v[2], v[3]);
        *(u32x2*)((bf16_t*)g_o0 + (size_t)r * ldo + c) = wv;
    }
}
__device__ __forceinline__ void epi_swiglu(const int r, const int oc, const f32x4 g, const f32x4 up, void* g_o0, const int ldo) {
    float o[4];
#pragma unroll
    for (int e = 0; e < 4; ++e) o[e] = g[e] * __builtin_amdgcn_rcpf(1.0f + __expf(-g[e])) * up[e];
    u32x2 wv; wv.x = cvt_pk_bf16(o[0], o[1]); wv.y = cvt_pk_bf16(o[2], o[3]);
    *(u32x2*)((bf16_t*)g_o0 + (size_t)r * ldo + oc) = wv;
}
template <int MODE>
__device__ __forceinline__ void epi_t(const f32x4 (&acc)[2][2][4][2], void* g_o0, void* g_o1, const float* g_bias, const int ldo, const int u_pm, const int u_pn, int wr, int wc, int fr, int fq, float* outp, float* htp) {
    const int row0 = u_pm * BM + wr * 64 + fr, col0 = u_pn * BM + wc * 32 + 4 * fq;
    f32x4 bvv[2][2];
#pragma unroll
    for (int bj = 0; bj < 2; ++bj)
#pragma unroll
        for (int n = 0; n < 2; ++n) bvv[bj][n] = (MODE == 5 || MODE == 6 || MODE == 7) ? *(const f32x4*)(g_bias + col0 + bj * HALF + n * 16) : (f32x4){0.f, 0.f, 0.f, 0.f};
    if constexpr (MODE == 7) {
#pragma unroll
        for (int ai = 0; ai < 2; ++ai) {
#pragma unroll
            for (int mh = 0; mh < 2; ++mh) {
                f32x4 vv[2][2][2]; u32x2 vf[2][2][2];
#pragma unroll
                for (int ml = 0; ml < 2; ++ml) { const size_t o = (size_t)(row0 + ai * HALF + (2 * mh + ml) * 16) * ldo + col0;
#pragma unroll
                    for (int bj = 0; bj < 2; ++bj)
#pragma unroll
                        for (int n = 0; n < 2; ++n) { vv[ml][bj][n] = *(const f32x4*)((const float*)g_o0 + o + bj * HALF + n * 16); vf[ml][bj][n] = *(const u32x2*)((const bf16_t*)g_o1 + o + bj * HALF + n * 16); } }
#pragma unroll
                for (int ml = 0; ml < 2; ++ml) { const size_t o = (size_t)(row0 + ai * HALF + (2 * mh + ml) * 16) * ldo + col0;
#pragma unroll
                    for (int bj = 0; bj < 2; ++bj)
#pragma unroll
                        for (int n = 0; n < 2; ++n) { const f32x4 a = acc[ai][bj][2 * mh + ml][n], x = vv[ml][bj][n], bb = bvv[bj][n]; const u32x2 f = vf[ml][bj][n];
                            f32x4 ov;
                            ov[0] = x[0] + (bf_lo(f.x) - x[0]) * sigmoidf_(bb[0] + a[0]); ov[1] = x[1] + (bf_hi(f.x) - x[1]) * sigmoidf_(bb[1] + a[1]);
                            ov[2] = x[2] + (bf_lo(f.y) - x[2]) * sigmoidf_(bb[2] + a[2]); ov[3] = x[3] + (bf_hi(f.y) - x[3]) * sigmoidf_(bb[3] + a[3]);
                            *(f32x4*)((float*)g_o0 + o + bj * HALF + n * 16) = ov; } }
            }
        }
        return;
    }
    if constexpr (MODE == 8) {
#pragma unroll
        for (int ai = 0; ai < 2; ++ai) {
            f32x4 hv[4][2][2];
#pragma unroll
            for (int m = 0; m < 4; ++m) { const int r = row0 + ai * HALF + m * 16; float* p = (r < MMAIN ? outp + (size_t)r * D : htp + (size_t)(r - MMAIN) * D) + col0;
#pragma unroll
                for (int bj = 0; bj < 2; ++bj)
#pragma unroll
                    for (int n = 0; n < 2; ++n) hv[m][bj][n] = *(const f32x4*)(p + bj * HALF + n * 16); }
#pragma unroll
            for (int m = 0; m < 4; ++m) { const int r = row0 + ai * HALF + m * 16; float* p = (r < MMAIN ? outp + (size_t)r * D : htp + (size_t)(r - MMAIN) * D) + col0;
#pragma unroll
                for (int bj = 0; bj < 2; ++bj)
#pragma unroll
                    for (int n = 0; n < 2; ++n) *(f32x4*)(p + bj * HALF + n * 16) = hv[m][bj][n] + acc[ai][bj][m][n]; }
        }
        return;
    }
#pragma unroll
    for (int ai = 0; ai < 2; ++ai) {
#pragma unroll
        for (int m = 0; m < 4; ++m) {
            const int r = row0 + ai * HALF + m * 16;
            if constexpr (MODE == 9) {
#pragma unroll
                for (int bj = 0; bj < 2; ++bj)
                    epi_swiglu(r, 16 * (u_pn * 8 + bj * 4 + wc) + 4 * fq, acc[ai][bj][m][0], acc[ai][bj][m][1], g_o0, ldo);
            } else if constexpr (MODE == 8 || MODE == 7) {
            } else {
#pragma unroll
                for (int bj = 0; bj < 2; ++bj) {
#pragma unroll
                    for (int n = 0; n < 2; ++n)
                        epi_elem<MODE>(r, col0 + bj * HALF + n * 16, acc[ai][bj][m][n], g_o0, g_o1, bvv[bj][n], ldo, outp, htp);
                }
            }
        }
    }
}
#define EPI_CALL(MD) epi_t<MD>(acc, g_o0, g_o1, g_bias, ldo, u_pm, u_pn, wr, wc, fr, fq, outp, htp)
__device__ __forceinline__ void epilogue(const f32x4 (&acc)[2][2][4][2], const int mode, void* g_o0, void* g_o1, const float* g_bias, const int ldo, const int u_pm, const int u_pn, int wr, int wc, int fr, int fq, float* outp, float* htp) {
    switch (mode) {
        case 0: EPI_CALL(0); break;
        case 1: EPI_CALL(1); break;
        case 2: EPI_CALL(2); break;
        case 3: EPI_CALL(3); break;
        case 4: EPI_CALL(4); break;
        case 5: EPI_CALL(5); break;
        case 6: EPI_CALL(6); break;
        case 7: EPI_CALL(7); break;
        case 8: EPI_CALL(8); break;
        default: EPI_CALL(9); break;
    }
}

__device__ __forceinline__ void gemm_phase(LAS unsigned char* lds, const PE* pe, const Params& P) {
    const int tid = threadIdx.x, wid = __builtin_amdgcn_readfirstlane(tid >> 6), lane = tid & 63, wr = wid >> 2, wc = wid & 3, fr = lane & 15, fq = lane >> 4;
    const int K = pe->K, nt = K / BK;
    const int sG = (int)gridDim.x, sC = (int)blockIdx.x, s_ng = pe->ng;
    const int sc1 = NMT * (pe->g[0].N / BM);
    const int sc2 = sc1 + (s_ng > 1 ? NMT * (pe->g[1].N / BM) : 0);
    const int sc3 = sc2 + (s_ng > 2 ? NMT * (pe->g[2].N / BM) : 0);
    const int sc4 = sc3 + (s_ng > 3 ? NMT * (pe->g[3].N / BM) : 0);
    unsigned char* const ws = P.ws;
    unsigned voff[2];
#pragma unroll
    for (int i = 0; i < 2; ++i) { int R, C; stage_rc(tid * 16 + i * 8192, R, C); voff[i] = (unsigned)(R * K + C) * 2u; }
    const size_t kstep = (size_t)(BK * 2);
    const size_t hstep = (size_t)HALF * K * 2;
    const size_t tstep = 2 * hstep;
    const unsigned ldsw = (unsigned)wid * 1024u;
    const int aoff = lds_byte(wr * 64 + fr, fq * 8), boff = lds_byte(wc * 32 + fr, fq * 8);
#define PG8_SA(b, h) (((b) * 2 + (h)) * HTB)
#define PG8_SB(b, h) ((4 + (b) * 2 + (h)) * HTB)
#define PG8_STAGE(bufoff, gbase) do { _Pragma("unroll") for (int _i = 0; _i < 2; ++_i) \
        __builtin_amdgcn_global_load_lds((const unsigned*)((const char*)(gbase) + voff[_i]), (LAS unsigned*)(lds + (bufoff) + ldsw + _i * 8192), 16, 0, 0); } while (0)
#define PG8_LDA(dst, b, h) do { _Pragma("unroll") for (int m = 0; m < 4; ++m) _Pragma("unroll") for (int k = 0; k < 2; ++k) dst[m][k] = *(const LAS bf16x8*)(lds + PG8_SA(b, h) + aoff + m * 2048 + k * 1024); } while (0)
#define PG8_LDB(dst, b, h) do { _Pragma("unroll") for (int n = 0; n < 2; ++n) _Pragma("unroll") for (int k = 0; k < 2; ++k) dst[n][k] = *(const LAS bf16x8*)(lds + PG8_SB(b, h) + boff + n * 2048 + k * 1024); } while (0)
#define PG8_MMA(ai, bj, At, Bt) do { __builtin_amdgcn_s_setprio(1); _Pragma("unroll") for (int m = 0; m < 4; ++m) _Pragma("unroll") for (int n = 0; n < 2; ++n) _Pragma("unroll") for (int k = 0; k < 2; ++k) \
        acc[ai][bj][m][n] = __builtin_amdgcn_mfma_f32_16x16x32_bf16(Bt[n][k], At[m][k], acc[ai][bj][m][n], 0, 0, 0); __builtin_amdgcn_s_setprio(0); } while (0)
#define PG8_WAIT_V(n) asm volatile("s_waitcnt vmcnt(" #n ")" ::: "memory")
#define PG8_WAIT_L(n) asm volatile("s_waitcnt lgkmcnt(" #n ")" ::: "memory")
#define PG8_BAR __builtin_amdgcn_s_barrier()
#define PG8_SCHED __builtin_amdgcn_sched_barrier(0)
    Unit cur, nxt; int ui = 0;
    if (!sched_next(sC, sc1, sc2, sc3, sc4, cur)) return;
    f32x4 acc[2][2][4][2];
#pragma unroll
    for (int a = 0; a < 2; ++a)
#pragma unroll
        for (int b = 0; b < 2; ++b)
#pragma unroll
            for (int m = 0; m < 4; ++m)
#pragma unroll
                for (int n = 0; n < 2; ++n) acc[a][b][m][n] = (f32x4){0.f, 0.f, 0.f, 0.f};
    bf16x8 At[4][2], B0[2][2], B1[2][2];
    const char* cA = (const char*)ws + pe->g[cur.gi].A + (size_t)cur.pm * tstep; const char* cB = (const char*)ws + pe->g[cur.gi].Bt + (size_t)cur.pn * tstep;
    PG8_STAGE(PG8_SB(0, 0), cB); PG8_STAGE(PG8_SA(0, 0), cA); PG8_STAGE(PG8_SB(0, 1), cB + hstep); PG8_STAGE(PG8_SA(0, 1), cA + hstep);
    if (wr == 1) PG8_BAR;
    PG8_WAIT_V(4); PG8_BAR;
    PG8_STAGE(PG8_SB(1, 0), cB + kstep); PG8_STAGE(PG8_SA(1, 0), cA + kstep); PG8_STAGE(PG8_SB(1, 1), cB + hstep + kstep);
    PG8_WAIT_V(6); PG8_BAR;
    for (;;) {
        const bool has_next = sched_next((ui + 1) * sG + sC, sc1, sc2, sc3, sc4, nxt);
        const char* nA = cA; const char* nB = cB;
        if (has_next) { nA = (const char*)ws + pe->g[nxt.gi].A + (size_t)nxt.pm * tstep; nB = (const char*)ws + pe->g[nxt.gi].Bt + (size_t)nxt.pn * tstep; }
        for (int t = 0; t < nt; t += 2) {
            const bool last = (t == nt - 2);
            const char* a1 = cA + (size_t)(t + 1) * kstep;
            const char* a2 = last ? nA : cA + (size_t)(t + 2) * kstep; const char* b2 = last ? nB : cB + (size_t)(t + 2) * kstep;
            const char* a3 = a2 + kstep; const char* b3 = b2 + kstep;
            PG8_LDB(B0, 0, 0); PG8_SCHED; PG8_LDA(At, 0, 0); PG8_STAGE(PG8_SA(1, 1), a1 + hstep);
            PG8_WAIT_L(8); PG8_BAR; PG8_WAIT_L(0); PG8_MMA(0, 0, At, B0); PG8_BAR; PG8_SCHED;
            PG8_LDB(B1, 0, 1); PG8_STAGE(PG8_SB(0, 0), b2);
            PG8_BAR; PG8_WAIT_L(0); PG8_MMA(0, 1, At, B1); PG8_BAR;
            PG8_LDA(At, 0, 1); PG8_STAGE(PG8_SA(0, 0), a2);
            PG8_BAR; PG8_WAIT_L(0); PG8_MMA(1, 0, At, B0); PG8_BAR; PG8_SCHED;
            PG8_STAGE(PG8_SB(0, 1), b2 + hstep);
            PG8_WAIT_V(6); PG8_BAR; PG8_MMA(1, 1, At, B1); PG8_BAR;
            PG8_LDB(B0, 1, 0); PG8_SCHED; PG8_LDA(At, 1, 0); PG8_STAGE(PG8_SA(0, 1), a2 + hstep);
            PG8_WAIT_L(8); PG8_BAR; PG8_WAIT_L(0); PG8_MMA(0, 0, At, B0); PG8_BAR; PG8_SCHED;
            PG8_LDB(B1, 1, 1); PG8_STAGE(PG8_SB(1, 0), b3);
            PG8_BAR; PG8_WAIT_L(0); PG8_MMA(0, 1, At, B1); PG8_BAR;
            PG8_LDA(At, 1, 1); PG8_STAGE(PG8_SA(1, 0), a3);
            PG8_BAR; PG8_WAIT_L(0); PG8_MMA(1, 0, At, B0); PG8_BAR; PG8_SCHED;
            PG8_STAGE(PG8_SB(1, 1), b3 + hstep);
            PG8_WAIT_V(6); PG8_BAR; PG8_MMA(1, 1, At, B1); PG8_BAR;
        }
        { const GD* gd = &pe->g[cur.gi];
          epilogue(acc, gd->mode, ws + gd->o0, ws + gd->o1, P.in[gd->bin] + gd->boff, gd->ldo, cur.pm, cur.pn, wr, wc, fr, fq, P.out, (float*)(ws + OFF_HT)); }
        if (!has_next) break;
#pragma unroll
        for (int a = 0; a < 2; ++a)
#pragma unroll
            for (int b = 0; b < 2; ++b)
#pragma unroll
                for (int m = 0; m < 4; ++m)
#pragma unroll
                    for (int n = 0; n < 2; ++n) acc[a][b][m][n] = (f32x4){0.f, 0.f, 0.f, 0.f};
        cur = nxt; cA = nA; cB = nB; ++ui;
    }
    PG8_WAIT_V(0);
    if (wr == 0) PG8_BAR;
    PG8_BAR;
#undef PG8_SA
#undef PG8_SB
#undef PG8_STAGE
#undef PG8_LDA
#undef PG8_LDB
#undef PG8_MMA
#undef PG8_WAIT_V
#undef PG8_WAIT_L
#undef PG8_BAR
#undef PG8_SCHED
}

#define TE_CALL(MD) epi_elem<MD>(r, c, v, o0, o1, bvt, ldo, P.out, (float*)(ws + OFF_HT))
__device__ void tail_gemm(LAS unsigned char* lds, const PE* pe, const Params& P) {
    const int tid = otid(), w = tid >> 6, lane = tid & 63, fr = lane & 15, fq = lane >> 4;
    unsigned char* const ws = P.ws;
    const int K = pe->K, ks = K >> 3, nstep = ks >> 5, ng = pe->ng;
    const int t1 = pe->g[0].N >> 4;
    const int t2 = t1 + (ng > 1 ? pe->g[1].N >> 4 : 0);
    const int t3 = t2 + (ng > 2 ? pe->g[2].N >> 4 : 0);
    const int t4 = t3 + (ng > 3 ? pe->g[3].N >> 4 : 0);
    LAS f32x4* part = (LAS f32x4*)lds;
    const int bid_ = obid();
    const int rank_ = (bid_ & 1) ? (bid_ >> 1) : ((int)(gridDim.x >> 1) + (bid_ >> 1));
    for (int item = rank_; item < t4; item += gridDim.x) {
        int gi = 0, base = 0;
        if (item >= t1) { gi = 1; base = t1; }
        if (item >= t2) { gi = 2; base = t2; }
        if (item >= t3) { gi = 3; base = t3; }
        const int cb = (item - base) >> 1, mh = (item - base) & 1;
        const GD* gd = &pe->g[gi];
        const bf16_t* A = (const bf16_t*)(ws + gd->A) + (size_t)(MMAIN + 32 * mh + fr) * K + (size_t)w * ks + 8 * fq;
        const bf16_t* Bt = (const bf16_t*)(ws + gd->Bt) + (size_t)(32 * cb + fr) * K + (size_t)w * ks + 8 * fq;
        const size_t r16 = (size_t)16 * K;
        f32x4 acc[2][2];
#pragma unroll
        for (int m = 0; m < 2; ++m) { acc[m][0] = (f32x4){0.f, 0.f, 0.f, 0.f}; acc[m][1] = acc[m][0]; }
        for (int s0 = 0; s0 < nstep; s0 += 8) {
            bf16x8 af[8][2], bfr[8][2];
#pragma unroll
            for (int s = 0; s < 8; ++s) if (s0 + s < nstep) {
                const int k0 = (s0 + s) * 32;
                af[s][0] = *(const bf16x8*)(A + k0); af[s][1] = *(const bf16x8*)(A + r16 + k0);
                bfr[s][0] = *(const bf16x8*)(Bt + k0); bfr[s][1] = *(const bf16x8*)(Bt + r16 + k0);
            }
#pragma unroll
            for (int s = 0; s < 8; ++s) if (s0 + s < nstep) {
#pragma unroll
                for (int m = 0; m < 2; ++m)
#pragma unroll
                    for (int nb = 0; nb < 2; ++nb) acc[m][nb] = __builtin_amdgcn_mfma_f32_16x16x32_bf16(bfr[s][nb], af[s][m], acc[m][nb], 0, 0, 0);
            }
        }
        __syncthreads();
#pragma unroll
        for (int m = 0; m < 2; ++m)
#pragma unroll
            for (int nb = 0; nb < 2; ++nb) part[(w * 4 + m * 2 + nb) * 64 + lane] = acc[m][nb];
        __syncthreads();
        if (tid < 256) {
            const int ml = tid >> 7, nb2 = (tid >> 6) & 1;
            f32x4 v = part[(ml * 2 + nb2) * 64 + lane];
#pragma unroll
            for (int x = 1; x < 8; ++x) v += part[(x * 4 + ml * 2 + nb2) * 64 + lane];
            const int r = MMAIN + 32 * mh + 16 * ml + fr, c = 32 * cb + 16 * nb2 + 4 * fq;
            const int mode = gd->mode, ldo = gd->ldo;
            void* o0 = ws + gd->o0; void* o1 = ws + gd->o1; const float* bias = P.in[gd->bin] + gd->boff;
            const f32x4 bvt = (mode == 5 || mode == 6 || mode == 7) ? *(const f32x4*)(bias + c) : (f32x4){0.f, 0.f, 0.f, 0.f};
            if (mode == 9) {
                if (nb2 == 0) { f32x4 up = part[(ml * 2 + 1) * 64 + lane];
#pragma unroll
                    for (int x = 1; x < 8; ++x) up += part[(x * 4 + ml * 2 + 1) * 64 + lane];
                    epi_swiglu(r, 16 * cb + 4 * fq, v, up, o0, ldo); }
            } else {
                switch (mode) {
                    case 0: TE_CALL(0); break;
                    case 1: TE_CALL(1); break;
                    case 2: TE_CALL(2); break;
                    case 3: TE_CALL(3); break;
                    case 4: TE_CALL(4); break;
                    case 5: TE_CALL(5); break;
                    case 6: TE_CALL(6); break;
                    case 7: TE_CALL(7); break;
                    default: TE_CALL(8); break;
                }
            }
        }
    }
}

__device__ void conv_T(const float* src, const float* src2, int ldsrc, bf16_t* dst, int K, int N, int Kpad, int Npad, int mode, LAS float* tile) {
    const int tid = otid();
    const int tk = Kpad / 256, tn = Npad / 64, ntile = tk * tn;
    for (int ti = obid(); ti < ntile; ti += gridDim.x) {
        const int R0 = (ti / tk) * 64, k0 = (ti % tk) * 256;
        f32x4 v[4][2];
#pragma unroll
        for (int sub = 0; sub < 4; ++sub)
#pragma unroll
            for (int pass = 0; pass < 2; ++pass) {
                const int kr = (tid >> 4) + pass * 32, c4 = (tid & 15) * 4;
                const int k = k0 + sub * 64 + kr, R = R0 + c4;
                v[sub][pass] = (f32x4){0.f, 0.f, 0.f, 0.f};
                if (k < K && R < N) {
                    const float* s; int col;
                    if (mode == 1) { const int g = R >> 5, wi = R & 31; s = wi < 16 ? src : src2; col = 16 * g + (wi & 15); }
                    else { s = src; col = R; }
                    v[sub][pass] = *(const f32x4*)(s + (size_t)k * ldsrc + col);
                }
            }
        __syncthreads();
#pragma unroll
        for (int sub = 0; sub < 4; ++sub)
#pragma unroll
            for (int pass = 0; pass < 2; ++pass) {
                const int kr = (tid >> 4) + pass * 32, c4 = (tid & 15) * 4;
                LAS float* t = tile + sub * (64 * 65) + kr * 65 + c4;
                t[0] = v[sub][pass][0]; t[1] = v[sub][pass][1]; t[2] = v[sub][pass][2]; t[3] = v[sub][pass][3];
            }
        __syncthreads();
        const int Rr = tid >> 3, k8 = (tid & 7) * 8;
#pragma unroll
        for (int sub = 0; sub < 4; ++sub) {
            float e[8];
#pragma unroll
            for (int i = 0; i < 8; ++i) e[i] = tile[sub * (64 * 65) + (k8 + i) * 65 + Rr];
            u32x4 o; o.x = cvt_pk_bf16(e[0], e[1]); o.y = cvt_pk_bf16(e[2], e[3]); o.z = cvt_pk_bf16(e[4], e[5]); o.w = cvt_pk_bf16(e[6], e[7]);
            *(u32x4*)(dst + (size_t)(R0 + Rr) * Kpad + k0 + sub * 64 + k8) = o;
        }
    }
}

struct CJ { int in0, in1, ldsrc, K, N, Kpad, Npad, mode; unsigned long long soff, doff; };
struct CJTab { CJ j[4][14]; int n[4]; };
constexpr CJ mkcj(int in0, int in1, unsigned long long soff, int ldsrc, unsigned long long doff, int K, int N, int Kpad, int Npad, int mode) {
    CJ c{}; c.in0 = in0; c.in1 = in1; c.ldsrc = ldsrc; c.K = K; c.N = N; c.Kpad = Kpad; c.Npad = Npad; c.mode = mode; c.soff = soff; c.doff = doff; return c;
}
constexpr CJTab make_cjtab() {
    CJTab t{};
    const unsigned long long DD = (unsigned long long)D * D, DF = (unsigned long long)D * FF;
    for (int layer = 0; layer < 4; ++layer) {
        int n = 0;
        if (layer < 2) {
            const unsigned long long i = layer;
            t.j[layer][n++] = mkcj(8, 8, i * DD, D, OFF_WA + WA_W0, D, D, D, D, 0);
            t.j[layer][n++] = mkcj(9, 9, i * DD, D, OFF_WA + WA_W1, D, D, D, D, 0);
            t.j[layer][n++] = mkcj(10, 10, i * DD, D, OFF_WA + WA_W2, D, D, D, D, 0);
            t.j[layer][n++] = mkcj(13, 13, i * D * 96, 96, OFF_WA + WA_L1 + 0 * WSLOT, D, 96, D, 256, 0);
            t.j[layer][n++] = mkcj(16, 16, i * D * 96, 96, OFF_WA + WA_L1 + 1 * WSLOT, D, 96, D, 256, 0);
            t.j[layer][n++] = mkcj(18, 18, i * D * 256, 256, OFF_WA + WA_L1 + 2 * WSLOT, D, 256, D, 256, 0);
            t.j[layer][n++] = mkcj(14, 14, i * 96 * D, D, OFF_WA + WA_L2 + 0 * WSLOT, 96, D, 256, D, 0);
            t.j[layer][n++] = mkcj(17, 17, i * 96 * D, D, OFF_WA + WA_L2 + 1 * WSLOT, 96, D, 256, D, 0);
            t.j[layer][n++] = mkcj(19, 19, i * 256 * D, D, OFF_WA + WA_L2 + 2 * WSLOT, 256, D, 256, D, 0);
            if (layer >= 1) {
                t.j[layer][n++] = mkcj(26, 26, (i - 1) * D * 64, 64, OFF_WA + WA_L1 + 3 * WSLOT, D, 64, D, 256, 0);
                t.j[layer][n++] = mkcj(27, 27, (i - 1) * 64 * D, D, OFF_WA + WA_L2 + 3 * WSLOT, 64, D, 256, D, 0);
            }
            t.j[layer][n++] = mkcj(11, 11, i * DD, D, OFF_WB + WB_WO, D, D, D, D, 0);
        } else {
            const unsigned long long jj = layer - 2;
            t.j[layer][n++] = mkcj(32, 32, jj * DD, D, OFF_WA + WA_W0, D, D, D, D, 0);
            if (layer == 2) {
                t.j[layer][n++] = mkcj(29, 29, 0, D, OFF_WA + WA_W1, D, D, D, D, 0);
                t.j[layer][n++] = mkcj(30, 30, 0, D, OFF_WA + WA_W2, D, D, D, D, 0);
            }
            t.j[layer][n++] = mkcj(34, 34, jj * DD, D, OFF_WB + WB_WO, D, D, D, D, 0);
        }
        t.j[layer][n++] = mkcj(4, 5, (unsigned long long)layer * DF, FF, OFF_WB + WB_F1, D, 2 * FF, D, 2 * FF, 1);
        t.j[layer][n++] = mkcj(6, 6, (unsigned long long)layer * DF, D, OFF_WB + WB_F2, FF, D, FF, D, 0);
        t.n[layer] = n;
    }
    return t;
}
__constant__ const CJTab CJT = make_cjtab();

__device__ void convert_layer(const Params& P, int layer, LAS unsigned char* lds) {
    LAS float* tile = (LAS float*)lds;
    const int nj = CJT.n[layer];
    for (int q = 0; q < nj; ++q) {
        const CJ* c = &CJT.j[layer][q];
        conv_T(P.in[c->in0] + c->soff, P.in[c->in1] + c->soff, c->ldsrc, (bf16_t*)(P.ws + c->doff), c->K, c->N, c->Kpad, c->Npad, c->mode, tile);
    }
}

__device__ void init_phase(const Params& P) {
    const f32x4* x = (const f32x4*)P.in[0]; f32x4* o = (f32x4*)P.out;
    const size_t n4 = (size_t)MMAIN * D / 4;
    for (size_t i = (size_t)obid() * NTHR + otid(); i < n4; i += (size_t)gridDim.x * NTHR) o[i] = x[i];
    const f32x4* mt = (const f32x4*)P.in[1]; f32x4* ht = (f32x4*)(P.ws + OFF_HT);
    const int m4 = NBATCH * NMETA * D / 4, per = NMETA * D / 4;
    for (int i = obid() * NTHR + otid(); i < m4; i += gridDim.x * NTHR) ht[i] = mt[i % per];
}

__device__ void mixprep_phase(const Params& P, int i) {
    const int tid_ = otid(); const int w = tid_ >> 6, lane = tid_ & 63;
    const float* g = P.in[2] + (size_t)i * D;
    const float* mu = P.in[7] + (size_t)i * 6 * D;
    bf16_t* const ob[6] = {(bf16_t*)(P.ws + OFF_MIX), (bf16_t*)(P.ws + OFF_DEC), (bf16_t*)(P.ws + OFF_MIX + SZB), (bf16_t*)(P.ws + OFF_MIX + 2 * SZB),
                           (bf16_t*)(P.ws + OFF_DEC + SZB), (bf16_t*)(P.ws + OFF_KF)};
    for (int idx = obid() * 8 + w; idx < M; idx += gridDim.x * 8) {
        const int b = idx / L, t = idx % L;
        const int r = rowof(b, t), rprev = rowof(b, t > 0 ? t - 1 : 0);
        const float* hc; const float* hp;
        if (i == 0) {
            hc = r < MMAIN ? P.in[0] + (size_t)r * D : P.in[1] + (size_t)((r - MMAIN) & 15) * D;
            hp = rprev < MMAIN ? P.in[0] + (size_t)rprev * D : P.in[1] + (size_t)((rprev - MMAIN) & 15) * D;
        } else { hc = hrow(P, r); hp = hrow(P, rprev); }
        float* hw = hrow(P, r);
        f32x4 c[8], p[8]; float sc = 0.f, sp = 0.f;
#pragma unroll
        for (int q = 0; q < 8; ++q) { c[q] = *(const f32x4*)(hc + 256 * q + 4 * lane); p[q] = *(const f32x4*)(hp + 256 * q + 4 * lane);
            sc += c[q][0] * c[q][0] + c[q][1] * c[q][1] + c[q][2] * c[q][2] + c[q][3] * c[q][3];
            sp += p[q][0] * p[q][0] + p[q][1] * p[q][1] + p[q][2] * p[q][2] + p[q][3] * p[q][3]; }
        if (i == 0) {
#pragma unroll
            for (int q = 0; q < 8; ++q) *(f32x4*)(hw + 256 * q + 4 * lane) = c[q];
        }
        sc = wavesum(sc); sp = wavesum(sp);
        const float rc = rsqrtf(sc * (1.0f / D) + 1e-6f);
        const float rp = t > 0 ? rsqrtf(sp * (1.0f / D) + 1e-6f) : 0.f;
#pragma unroll
        for (int q = 0; q < 8; ++q) {
            const int col = 256 * q + 4 * lane;
            const f32x4 gv = *(const f32x4*)(g + col);
            f32x4 hn, xx;
#pragma unroll
            for (int e = 0; e < 4; ++e) { hn[e] = c[q][e] * rc * gv[e]; xx[e] = p[q][e] * rp * gv[e] - hn[e]; }
#pragma unroll
            for (int j = 0; j < 6; ++j) {
                const f32x4 m = *(const f32x4*)(mu + j * D + col);
                u32x2 a; a.x = cvt_pk_bf16(hn[0] + xx[0] * m[0], hn[1] + xx[1] * m[1]); a.y = cvt_pk_bf16(hn[2] + xx[2] * m[2], hn[3] + xx[3] * m[3]);
                *(u32x2*)(ob[j] + (size_t)r * D + col) = a;
            }
        }
    }
}

__device__ void norm_phase(const Params& P, const float* g1, bf16_t* o1, const float* g2, bf16_t* o2) {
    const int tid_ = otid(); const int w = tid_ >> 6, lane = tid_ & 63;
    for (int r = obid() * 8 + w; r < M; r += gridDim.x * 8) {
        const float* hc = hrow(P, r);
        f32x4 c[8]; float sc = 0.f;
#pragma unroll
        for (int q = 0; q < 8; ++q) { c[q] = *(const f32x4*)(hc + 256 * q + 4 * lane); sc += c[q][0] * c[q][0] + c[q][1] * c[q][1] + c[q][2] * c[q][2] + c[q][3] * c[q][3]; }
        sc = wavesum(sc);
        const float rc = rsqrtf(sc * (1.0f / D) + 1e-6f);
#pragma unroll
        for (int q = 0; q < 8; ++q) {
            const int col = 256 * q + 4 * lane;
            const f32x4 gv = *(const f32x4*)(g1 + col);
            u32x2 a; a.x = cvt_pk_bf16(c[q][0] * rc * gv[0], c[q][1] * rc * gv[1]); a.y = cvt_pk_bf16(c[q][2] * rc * gv[2], c[q][3] * rc * gv[3]);
            *(u32x2*)(o1 + (size_t)r * D + col) = a;
            if (g2) { const f32x4 g2v = *(const f32x4*)(g2 + col);
                u32x2 bq; bq.x = cvt_pk_bf16(c[q][0] * rc * g2v[0], c[q][1] * rc * g2v[1]); bq.y = cvt_pk_bf16(c[q][2] * rc * g2v[2], c[q][3] * rc * g2v[3]);
                *(u32x2*)(o2 + (size_t)r * D + col) = bq; }
        }
    }
}

__device__ void scan_phase(const Params& P, int i, LAS unsigned char* lds) {
    const int tid = otid(), w = tid >> 6, lane = tid & 63;
    const bf16_t* RB = (const bf16_t*)(P.ws + OFF_RB); const float* KF = (const float*)(P.ws + OFF_KF);
    const float* VF = (const float*)(P.ws + OFF_VF); const float* DEC = (const float*)(P.ws + OFF_DEC);
    const bf16_t* AB = (const bf16_t*)(P.ws + OFF_MIX); bf16_t* YB = (bf16_t*)(P.ws + OFF_MIX + 2 * SZB);
    const float* k_k = P.in[20] + (size_t)i * D; const float* k_a = P.in[21] + (size_t)i * D; const float* r_k = P.in[22] + (size_t)i * D;
    float* SBON = (float*)(P.ws + OFF_LORA);
    LAS float* fl = (LAS float*)lds;
    constexpr int STG = 11264;
    LAS float* ybuf = fl + 2 * STG;
    typedef float f32x2 __attribute__((ext_vector_type(2)));
    const int wu = __builtin_amdgcn_readfirstlane(w);
    const int kg = lane & 15, rp = 4 * (wu & 3) + (lane >> 4);
    const int lt = tid & 255;
    const int lc = (lt & 15) * 4, vt = lt >> 3, vc = (lt & 7) * 4;
    constexpr int NCH = (L + 31) / 32;
    for (int u = obid(); u < 256; u += gridDim.x) {
        const int bh = u >> 1, rh = u & 1, b = bh >> 5, h = bh & 31;
        f32x4 kkp = (f32x4){0.f, 0.f, 0.f, 0.f}, kap = kkp, rkp = kkp;
        f32x4 gk[2], gd[2], gv; u32x2 gr[2], ga[2];
        __syncthreads();
#define SCAN_LOAD(cc) do { _Pragma("unroll") for (int q_ = 0; q_ < 2; ++q_) { const int t_ = 32 * (cc) + (lt >> 4) + 16 * q_; \
              gk[q_] = (f32x4){0.f, 0.f, 0.f, 0.f}; gd[q_] = gk[q_]; gr[q_] = (u32x2){0u, 0u}; ga[q_] = gr[q_]; \
              if (t_ < L) { const size_t o_ = (size_t)rowof(b, t_) * D + 64 * h + lc; gk[q_] = *(const f32x4*)(KF + o_); gd[q_] = *(const f32x4*)(DEC + o_); gr[q_] = *(const u32x2*)(RB + o_); ga[q_] = *(const u32x2*)(AB + o_); } } \
            { const int tv_ = 32 * (cc) + vt; gv = (f32x4){0.f, 0.f, 0.f, 0.f}; if (tv_ < L) gv = *(const f32x4*)(VF + (size_t)rowof(b, tv_) * D + 64 * h + 32 * rh + vc); } } while (0)
#define SCAN_STORE(st, cc) do { LAS float* s_ = fl + (st) * STG; _Pragma("unroll") for (int q_ = 0; q_ < 2; ++q_) { const int o_ = ((lt >> 4) + 16 * q_) * 64 + lc; \
              f32x4 kr_ = gk[q_] * kkp; float ss_ = kr_[0] * kr_[0] + kr_[1] * kr_[1] + kr_[2] * kr_[2] + kr_[3] * kr_[3]; ss_ = rowsum16(ss_); \
              const float inv_ = rsqrtf(fmaxf(ss_, 1e-24f)); \
              f32x4 av_; av_[0] = bf_lo(ga[q_].x); av_[1] = bf_hi(ga[q_].x); av_[2] = bf_lo(ga[q_].y); av_[3] = bf_hi(ga[q_].y); \
              f32x4 rv_; rv_[0] = bf_lo(gr[q_].x); rv_[1] = bf_hi(gr[q_].x); rv_[2] = bf_lo(gr[q_].y); rv_[3] = bf_hi(gr[q_].y); \
              const f32x4 kk_ = kr_ * inv_; f32x4 kp_; \
              for (int e_ = 0; e_ < 4; ++e_) kp_[e_] = gk[q_][e_] * (1.0f + (av_[e_] - 1.0f) * kap[e_]); \
              *(LAS f32x4*)(s_ + o_) = rv_; *(LAS f32x4*)(s_ + 2048 + o_) = gd[q_]; *(LAS f32x4*)(s_ + 4096 + o_) = kp_; \
              *(LAS f32x4*)(s_ + 6144 + o_) = kk_; *(LAS f32x4*)(s_ + 8192 + o_) = kk_ * av_; \
              float sb_ = rv_[0] * kp_[0] * rkp[0] + rv_[1] * kp_[1] * rkp[1] + rv_[2] * kp_[2] * rkp[2] + rv_[3] * kp_[3] * rkp[3]; sb_ = rowsum16(sb_); \
              { const int tb_ = 32 * (cc) + (lt >> 4) + 16 * q_; if (rh == 0 && (lt & 15) == 0 && tb_ < L) SBON[(size_t)rowof(b, tb_) * 32 + h] = sb_; } } \
            *(LAS f32x4*)(s_ + 10240 + vt * 32 + vc) = gv; } while (0)
#define SCAN_FLUSH(cc) do { const LAS float* yb_ = ybuf + ((cc) & 1) * 1024; _Pragma("unroll") for (int q_ = 0; q_ < 2; ++q_) { const int ft_ = (lt >> 4) + 16 * q_, fv_ = (lt & 15) * 2; const int tt_ = 32 * (cc) + ft_; \
              if (tt_ < L) { const unsigned pk_ = cvt_pk_bf16(yb_[ft_ * 32 + fv_], yb_[ft_ * 32 + fv_ + 1]); *(unsigned*)(YB + (size_t)rowof(b, tt_) * D + 64 * h + 32 * rh + fv_) = pk_; } } } while (0)
        if (wu >= 4) {
            kkp = *(const f32x4*)(k_k + 64 * h + lc); kap = *(const f32x4*)(k_a + 64 * h + lc); rkp = *(const f32x4*)(r_k + 64 * h + lc);
            SCAN_LOAD(0); SCAN_STORE(0, 0);
            SCAN_LOAD(1);
        }
        __syncthreads();
        f32x2 SA01 = {0.f, 0.f}, SA23 = SA01, SB01 = SA01, SB23 = SA01;
        for (int c = 0; c < NCH; ++c) {
            if (wu < 4) {
                const LAS float* s = fl + (c & 1) * STG;
                LAS float* yb = ybuf + (c & 1) * 1024;
                const int ns = (L - 32 * c) < 32 ? (L - 32 * c) : 32;
                for (int tb = 0; tb < ns; tb += 16) {
                    float ykA = 0.f, ykB = 0.f;
#pragma unroll
                    for (int j = 0; j < 16; ++j) {
                        const int t = tb + j;
                        const int o = t * 64 + 4 * kg;
                        const f32x4 r4 = *(const LAS f32x4*)(s + o), d4 = *(const LAS f32x4*)(s + 2048 + o), kp4 = *(const LAS f32x4*)(s + 4096 + o);
                        const f32x4 kk4 = *(const LAS f32x4*)(s + 6144 + o), ka4 = *(const LAS f32x4*)(s + 8192 + o);
                        const f32x2 vv = *(const LAS f32x2*)(s + 10240 + t * 32 + 2 * rp);
                        const f32x2 kk01 = {kk4[0], kk4[1]}, kk23 = {kk4[2], kk4[3]}, ka01 = {ka4[0], ka4[1]}, ka23 = {ka4[2], ka4[3]};
                        const f32x2 kp01 = {kp4[0], kp4[1]}, kp23 = {kp4[2], kp4[3]}, d01 = {d4[0], d4[1]}, d23 = {d4[2], d4[3]}, r01 = {r4[0], r4[1]}, r23 = {r4[2], r4[3]};
                        f32x2 pA = SA01 * kk01; pA = SA23 * kk23 + pA;
                        f32x2 pB = SB01 * kk01; pB = SB23 * kk23 + pB;
                        const float saA = -rowsum16(pA.x + pA.y), saB = -rowsum16(pB.x + pB.y);
                        f32x2 tA01 = kp01 * vv.x, tA23 = kp23 * vv.x, tB01 = kp01 * vv.y, tB23 = kp23 * vv.y;
                        tA01 = ka01 * saA + tA01; tA23 = ka23 * saA + tA23; tB01 = ka01 * saB + tB01; tB23 = ka23 * saB + tB23;
                        SA01 = SA01 * d01 + tA01; SA23 = SA23 * d23 + tA23; SB01 = SB01 * d01 + tB01; SB23 = SB23 * d23 + tB23;
                        f32x2 qA = SA01 * r01; qA = SA23 * r23 + qA;
                        f32x2 qB = SB01 * r01; qB = SB23 * r23 + qB;
                        const float yA = rowsum16(qA.x + qA.y), yB = rowsum16(qB.x + qB.y);
                        ykA = (kg == j) ? yA : ykA; ykB = (kg == j) ? yB : ykB;
                    }
                    { f32x2 yy = {ykA, ykB}; *(LAS f32x2*)(yb + (tb + kg) * 32 + 2 * rp) = yy; }
                }
            } else {
                if (c + 1 < NCH) SCAN_STORE((c + 1) & 1, c + 1);
                if (c + 2 < NCH) SCAN_LOAD(c + 2);
                if (c >= 1) SCAN_FLUSH(c - 1);
            }
            __syncthreads();
        }
        if (wu >= 4) SCAN_FLUSH(NCH - 1);
#undef SCAN_LOAD
#undef SCAN_STORE
#undef SCAN_FLUSH
    }
}

__device__ void post_phase(const Params& P, int i) {
    const int tid_ = otid(); const int w = tid_ >> 6, lane = tid_ & 63;
    const float* VF = (const float*)(P.ws + OFF_VF); const float* SBON = (const float*)(P.ws + OFF_LORA);
    const bf16_t* GB = (const bf16_t*)(P.ws + OFF_MIX + SZB); bf16_t* YB = (bf16_t*)(P.ws + OFF_MIX + 2 * SZB);
    const float* gn_w = P.in[23] + (size_t)i * D; const float* gn_b = P.in[24] + (size_t)i * D;
    for (int r = obid() * 8 + w; r < M; r += gridDim.x * 8) {
#pragma unroll
        for (int q = 0; q < 8; ++q) {
            const int col = 256 * q + 4 * lane; const size_t o = (size_t)r * D + col;
            const u32x2 yv = *(const u32x2*)(YB + o), gv = *(const u32x2*)(GB + o);
            const f32x4 vv = *(const f32x4*)(VF + o);
            const float sb = SBON[(size_t)r * 32 + 4 * q + (lane >> 4)];
            const f32x4 gw = *(const f32x4*)(gn_w + col), gb = *(const f32x4*)(gn_b + col);
            float y[4] = {bf_lo(yv.x), bf_hi(yv.x), bf_lo(yv.y), bf_hi(yv.y)};
            const float gg[4] = {bf_lo(gv.x), bf_hi(gv.x), bf_lo(gv.y), bf_hi(gv.y)};
            float sy = (y[0] + y[1]) + (y[2] + y[3]);
            sy = rowsum16(sy);
            const float mean = sy * (1.0f / 64.0f);
            float sv = 0.f;
#pragma unroll
            for (int e = 0; e < 4; ++e) { y[e] -= mean; sv += y[e] * y[e]; }
            sv = rowsum16(sv);
            const float rstd = rsqrtf(sv * (1.0f / 64.0f) + 64e-5f);
            float z[4];
#pragma unroll
            for (int e = 0; e < 4; ++e) z[e] = (y[e] * rstd * gw[e] + gb[e] + sb * vv[e]) * gg[e];
            u32x2 zo; zo.x = cvt_pk_bf16(z[0], z[1]); zo.y = cvt_pk_bf16(z[2], z[3]);
            *(u32x2*)(YB + o) = zo;
        }
    }
}

__device__ void headnorm_phase(const Params& P, LAS unsigned char* lds) {
    const int tid = otid(), w = tid >> 6, lane = tid & 63;
    const float* KR = (const float*)(P.ws + OFF_KF); const float* VR = (const float*)(P.ws + OFF_VF);
    bf16_t* KN = (bf16_t*)(P.ws + OFF_MIX + 2 * SZB); bf16_t* VT = (bf16_t*)(P.ws + OFF_DEC);
    const float* kg = P.in[31];
    for (int r = obid() * 8 + w; r < M; r += gridDim.x * 8) {
#pragma unroll
        for (int q = 0; q < 8; ++q) {
            const int col = 256 * q + 4 * lane; const size_t o = (size_t)r * D + col;
            const f32x4 kv = *(const f32x4*)(KR + o);
            float ss = kv[0] * kv[0] + kv[1] * kv[1] + kv[2] * kv[2] + kv[3] * kv[3];
            ss = rowsum16(ss); ss += __shfl_xor(ss, 16);
            const float rs = rsqrtf(ss * (1.0f / 128.0f) + 1e-6f);
            const f32x4 gv = *(const f32x4*)(kg + (col & 127));
            u32x2 a; a.x = cvt_pk_bf16(kv[0] * rs * gv[0], kv[1] * rs * gv[1]); a.y = cvt_pk_bf16(kv[2] * rs * gv[2], kv[3] * rs * gv[3]);
            *(u32x2*)(KN + o) = a;
        }
    }
    LAS float* tile = (LAS float*)lds;
    for (int it = obid(); it < NBATCH * 66 * 16; it += gridDim.x) {
        const int h = it & 15, pt = (it >> 4) % 66, b = it / (16 * 66);
        __syncthreads();
#pragma unroll
        for (int pass = 0; pass < 4; ++pass) {
            const int key = (tid >> 5) + pass * 16, c4 = (tid & 31) * 4;
            const int t = 64 * pt + key - PPAD;
            f32x4 v = (f32x4){0.f, 0.f, 0.f, 0.f};
            if (t >= 0) v = *(const f32x4*)(VR + (size_t)rowof(b, t) * D + 128 * h + c4);
            tile[key * 129 + c4] = v[0]; tile[key * 129 + c4 + 1] = v[1]; tile[key * 129 + c4 + 2] = v[2]; tile[key * 129 + c4 + 3] = v[3];
        }
        __syncthreads();
        const int d = tid >> 2, k16 = (tid & 3) * 16;
        float e[16];
#pragma unroll
        for (int x = 0; x < 16; ++x) e[x] = tile[(k16 + x) * 129 + d];
        u32x4 o0, o1;
        o0.x = cvt_pk_bf16(e[0], e[1]); o0.y = cvt_pk_bf16(e[2], e[3]); o0.z = cvt_pk_bf16(e[4], e[5]); o0.w = cvt_pk_bf16(e[6], e[7]);
        o1.x = cvt_pk_bf16(e[8], e[9]); o1.y = cvt_pk_bf16(e[10], e[11]); o1.z = cvt_pk_bf16(e[12], e[13]); o1.w = cvt_pk_bf16(e[14], e[15]);
        bf16_t* dst = VT + ((size_t)((b * 16 + h) * 128 + d)) * PLEN + 64 * pt + k16;
        *(u32x4*)dst = o0; *(u32x4*)(dst + 8) = o1;
    }
}

__device__ void attn_phase(const Params& P, int j, LAS unsigned char* lds) {
    const int tid = otid(), w = tid >> 6, lane = tid & 63, fr = lane & 15, fq = lane >> 4;
    const float* QF = (const float*)(P.ws + OFF_RB);
    const bf16_t* KN = (const bf16_t*)(P.ws + OFF_MIX + 2 * SZB);
    const bf16_t* VT = (const bf16_t*)(P.ws + OFF_DEC);
    bf16_t* OB = (bf16_t*)(P.ws + OFF_MIX);
    const float* qg = P.in[33] + j * 128;
    constexpr int KSTR = 272, VSTR = 144, KBYTES = 64 * KSTR, VBYTES = 128 * VSTR, STGB = KBYTES + VBYTES;
    for (int u = obid(); u < 64 * 33; u += gridDim.x) {
        const int qb = 32 - u / 64, bh = u % 64, b = bh >> 4, h = bh & 15;
        const int pq = 128 * qb + 16 * w + fr, tq = pq - PPAD;
        const int qrow = rowof(b, tq > 0 ? tq : 0);
        bf16x8 qf[4];
        {
            const float* qp = QF + (size_t)qrow * D + 128 * h + 8 * fq;
            f32x4 qa[4], qc[4]; float ss = 0.f;
#pragma unroll
            for (int s = 0; s < 4; ++s) { qa[s] = *(const f32x4*)(qp + 32 * s); qc[s] = *(const f32x4*)(qp + 32 * s + 4);
                ss += qa[s][0] * qa[s][0] + qa[s][1] * qa[s][1] + qa[s][2] * qa[s][2] + qa[s][3] * qa[s][3] + qc[s][0] * qc[s][0] + qc[s][1] * qc[s][1] + qc[s][2] * qc[s][2] + qc[s][3] * qc[s][3]; }
            ss += __shfl_xor(ss, 16); ss += __shfl_xor(ss, 32);
            const float rs = rsqrtf(ss * (1.0f / 128.0f) + 1e-6f) * 0.08838834764831845f;
#pragma unroll
            for (int s = 0; s < 4; ++s) {
                const f32x4 g0 = *(const f32x4*)(qg + 32 * s + 8 * fq), g1 = *(const f32x4*)(qg + 32 * s + 8 * fq + 4);
                u32x4 pk; pk.x = cvt_pk_bf16(qa[s][0] * rs * g0[0], qa[s][1] * rs * g0[1]); pk.y = cvt_pk_bf16(qa[s][2] * rs * g0[2], qa[s][3] * rs * g0[3]);
                pk.z = cvt_pk_bf16(qc[s][0] * rs * g1[0], qc[s][1] * rs * g1[1]); pk.w = cvt_pk_bf16(qc[s][2] * rs * g1[2], qc[s][3] * rs * g1[3]);
                qf[s] = __builtin_bit_cast(bf16x8, pk);
            }
        }
        f32x4 oacc[8];
#pragma unroll
        for (int x = 0; x < 8; ++x) oacc[x] = (f32x4){0.f, 0.f, 0.f, 0.f};
        float carry = 1.0f;
        u32x4 kr[2], vr[2];
#define ATT_LOAD(kt_) do { _Pragma("unroll") for (int i_ = 0; i_ < 2; ++i_) { const int id_ = tid + 512 * i_; \
            { const int row_ = id_ >> 4, c_ = id_ & 15; const int tk_ = 64 * (kt_) + row_ - PPAD; \
              kr[i_] = *(const u32x4*)(KN + (size_t)rowof(b, tk_ > 0 ? tk_ : 0) * D + 128 * h + 8 * c_); } \
            { const int d_ = id_ >> 3, c_ = id_ & 7; vr[i_] = *(const u32x4*)(VT + ((size_t)(bh * 128 + d_)) * PLEN + 64 * (kt_) + 8 * c_); } } } while (0)
#define ATT_WRITE(st_) do { _Pragma("unroll") for (int i_ = 0; i_ < 2; ++i_) { const int id_ = tid + 512 * i_; \
            *(LAS u32x4*)(lds + (st_) * STGB + (id_ >> 4) * KSTR + 16 * (id_ & 15)) = kr[i_]; \
            *(LAS u32x4*)(lds + (st_) * STGB + KBYTES + (id_ >> 3) * VSTR + 16 * (id_ & 7)) = vr[i_]; } } while (0)
        const int nti = 2 * qb + 1;
        __syncthreads();
        ATT_LOAD(nti); ATT_WRITE(0);
        __syncthreads();
        for (int it = 0; it < nti; ++it) {
            const int kt = nti - it;
            if (it + 1 < nti) ATT_LOAD(kt - 1);
            const LAS unsigned char* Ks = lds + (it & 1) * STGB; const LAS unsigned char* Vs = Ks + KBYTES;
            f32x4 st[4];
#pragma unroll
            for (int n = 0; n < 4; ++n) { st[n] = (f32x4){0.f, 0.f, 0.f, 0.f};
#pragma unroll
                for (int s = 0; s < 4; ++s) { const bf16x8 a = *(const LAS bf16x8*)(Ks + (16 * n + fr) * KSTR + 64 * s + 16 * fq);
                    st[n] = __builtin_amdgcn_mfma_f32_16x16x32_bf16(a, qf[s], st[n], 0, 0, 0); } }
            const bool need_mask = (kt >= 2 * qb) || (kt == 1);
            float kp[4][4], sg[4][4];
#pragma unroll
            for (int n = 0; n < 4; ++n)
#pragma unroll
                for (int e = 0; e < 4; ++e) { const float z = st[n][e]; const float ex = __expf(-fabsf(z)); const float r = __builtin_amdgcn_rcpf(1.0f + ex);
                    const bool pos = z >= 0.f; sg[n][e] = (pos ? 1.0f : ex) * r; kp[n][e] = (pos ? ex : 1.0f) * r; }
            if (need_mask) {
#pragma unroll
                for (int n = 0; n < 4; ++n)
#pragma unroll
                    for (int e = 0; e < 4; ++e) { const int pk = 64 * kt + 16 * n + 4 * fq + e; const bool valid = (pk < pq) && (pk >= PPAD);
                        if (!valid) { kp[n][e] = 1.0f; sg[n][e] = 0.f; } }
            }
            float X[4], Bt[4];
            {
                LAS f32x4* xch = (LAS f32x4*)(lds + 2 * STGB) + w * 64;
                f32x4 Tv;
#pragma unroll
                for (int n = 0; n < 4; ++n) Tv[n] = (kp[n][0] * kp[n][1]) * (kp[n][2] * kp[n][3]);
                xch[lane] = Tv;
                const f32x4 t0 = xch[fr], t1 = xch[fr + 16], t2 = xch[fr + 32], t3 = xch[fr + 48];
#pragma unroll
                for (int n = 0; n < 4; ++n) {
                    X[n] = (fq < 1 ? t1[n] : 1.0f) * (fq < 2 ? t2[n] : 1.0f) * (fq < 3 ? t3[n] : 1.0f);
                    Bt[n] = (t0[n] * t1[n]) * (t2[n] * t3[n]);
                }
            }
            float wgt[4][4]; float run = carry;
#pragma unroll
            for (int n = 3; n >= 0; --n) { const float s3 = run * X[n]; const float s2 = s3 * kp[n][3]; const float s1 = s2 * kp[n][2]; const float s0 = s1 * kp[n][1];
                wgt[n][3] = sg[n][3] * s3; wgt[n][2] = sg[n][2] * s2; wgt[n][1] = sg[n][1] * s1; wgt[n][0] = sg[n][0] * s0;
                run *= Bt[n]; }
            carry = run;
#pragma unroll
            for (int s2 = 0; s2 < 2; ++s2) {
                u32x4 pk; pk.x = cvt_pk_bf16(wgt[2 * s2][0], wgt[2 * s2][1]); pk.y = cvt_pk_bf16(wgt[2 * s2][2], wgt[2 * s2][3]);
                pk.z = cvt_pk_bf16(wgt[2 * s2 + 1][0], wgt[2 * s2 + 1][1]); pk.w = cvt_pk_bf16(wgt[2 * s2 + 1][2], wgt[2 * s2 + 1][3]);
                const bf16x8 pf = __builtin_bit_cast(bf16x8, pk);
#pragma unroll
                for (int db = 0; db < 8; ++db) {
                    const LAS unsigned char* vp = Vs + (16 * db + fr) * VSTR + 64 * s2 + 8 * fq;
                    const u32x2 v0 = *(const LAS u32x2*)vp, v1 = *(const LAS u32x2*)(vp + 32);
                    u32x4 vv; vv.x = v0.x; vv.y = v0.y; vv.z = v1.x; vv.w = v1.y;
                    oacc[db] = __builtin_amdgcn_mfma_f32_16x16x32_bf16(__builtin_bit_cast(bf16x8, vv), pf, oacc[db], 0, 0, 0);
                }
            }
            if (it + 1 < nti) ATT_WRITE((it + 1) & 1);
#ifndef NO_EARLY_EXIT
            LAS int* flg = (LAS int*)(lds + 2 * STGB + 8192) + (it & 1) * 8;
            { const int dead = __all(carry == 0.f); if (lane == 0) flg[w] = dead; }
            __syncthreads();
            { int alld = 1;
#pragma unroll
              for (int x = 0; x < 8; ++x) alld &= flg[x];
              if (alld) break; }
#else
            __syncthreads();
#endif
        }
#undef ATT_LOAD
#undef ATT_WRITE
        if (tq >= 0) {
#pragma unroll
            for (int db = 0; db < 8; ++db) { u32x2 o; o.x = cvt_pk_bf16(oacc[db][0], oacc[db][1]); o.y = cvt_pk_bf16(oacc[db][2], oacc[db][3]);
                *(u32x2*)(OB + (size_t)qrow * D + 128 * h + 16 * db + 4 * fq) = o; }
        }
    }
}

__device__ __forceinline__ void grid_barrier(unsigned* ctr, unsigned target) {
    asm volatile("s_waitcnt vmcnt(0) lgkmcnt(0)" ::: "memory");
    __syncthreads();
    if (threadIdx.x == 0) {
        __builtin_amdgcn_fence(__ATOMIC_RELEASE, "agent");
        asm volatile("s_waitcnt vmcnt(0)" ::: "memory");
        __hip_atomic_fetch_add(ctr, 1u, __ATOMIC_RELAXED, __HIP_MEMORY_SCOPE_AGENT);
        while (__hip_atomic_load(ctr, __ATOMIC_RELAXED, __HIP_MEMORY_SCOPE_AGENT) < target) __builtin_amdgcn_s_sleep(2);
        __builtin_amdgcn_fence(__ATOMIC_ACQUIRE, "agent");
        asm volatile("s_waitcnt vmcnt(0)" ::: "memory");
    }
    __syncthreads();
}

#ifndef DUP_ATTN
#define DUP_ATTN 0
#endif
#ifndef DUP_FFN1
#define DUP_FFN1 0
#endif
#ifndef DUP_SCAN
#define DUP_SCAN 0
#endif
constexpr int NPHASE = 35 + 2 * DUP_ATTN + 4 * DUP_FFN1 + 2 * DUP_SCAN;
enum { K_INIT = 0, K_MIXPREP, K_GEMM, K_SCAN, K_POST, K_NORMF, K_NORMSB, K_HEADNORM, K_ATTN };
struct Tab { PE e[NPHASE]; };
constexpr GD mkgd(size_t A, size_t Bt, int N, int mode, size_t o0, size_t o1, int bin, int boff, int ldo) {
    GD g{}; g.A = A; g.Bt = Bt; g.o0 = o0; g.o1 = o1; g.N = N; g.mode = mode; g.bin = bin; g.boff = boff; g.ldo = ldo; g.pad = 0; return g;
}
constexpr PE mkgemm(int layer, int sub) {
    PE p{}; p.kind = K_GEMM; p.layer = layer; p.sub = sub; p.ng = 1; p.K = D; p.pad = 0;
    const int i = layer;
    for (int q = 0; q < 4; ++q) p.g[q] = mkgd(0, 0, 256, 0, 0, 0, 0, 0, D);
    if (sub == 0) {
        p.g[0] = mkgd(OFF_MIX, OFF_WA + WA_W0, D, 0, OFF_RB, 0, 0, 0, D);
        p.g[1] = mkgd(OFF_MIX + SZB, OFF_WA + WA_W1, D, 1, OFF_KF, 0, 0, 0, D);
        p.g[2] = mkgd(OFF_MIX + 2 * SZB, OFF_WA + WA_W2, D, i == 0 ? 2 : 1, OFF_VF, OFF_VFIRST, 0, 0, D);
        p.ng = 3;
    } else if (sub == 1) {
        p.g[0] = mkgd(OFF_DEC, OFF_WA + WA_L1 + 0 * WSLOT, 256, 3, OFF_LORA + 0 * SZLORA, 0, 0, 0, 256);
        p.g[1] = mkgd(OFF_DEC + SZB, OFF_WA + WA_L1 + 1 * WSLOT, 256, 0, OFF_LORA + 1 * SZLORA, 0, 0, 0, 256);
        p.g[2] = mkgd(OFF_KF, OFF_WA + WA_L1 + 2 * WSLOT, 256, 4, OFF_LORA + 2 * SZLORA, 0, 0, 0, 256);
        p.ng = 3;
        if (i >= 1) { p.g[3] = mkgd(OFF_MIX + 2 * SZB, OFF_WA + WA_L1 + 3 * WSLOT, 256, 0, OFF_LORA + 3 * SZLORA, 0, 0, 0, 256); p.ng = 4; }
    } else if (sub == 2) {
        p.K = 256;
        p.g[0] = mkgd(OFF_LORA + 0 * SZLORA, OFF_WA + WA_L2 + 0 * WSLOT, D, 5, OFF_DEC, 0, 12, i * D, D);
        p.g[1] = mkgd(OFF_LORA + 1 * SZLORA, OFF_WA + WA_L2 + 1 * WSLOT, D, 6, OFF_MIX, 0, 15, i * D, D);
        p.g[2] = mkgd(OFF_LORA + 2 * SZLORA, OFF_WA + WA_L2 + 2 * WSLOT, D, 0, OFF_MIX + SZB, 0, 0, 0, D);
        p.ng = 3;
        if (i >= 1) { p.g[3] = mkgd(OFF_LORA + 3 * SZLORA, OFF_WA + WA_L2 + 3 * WSLOT, D, 7, OFF_VF, OFF_VFIRST, 25, (i - 1) * D, D); p.ng = 4; }
    } else if (sub == 3) {
        p.g[0] = mkgd(OFF_MIX + 2 * SZB, OFF_WB + WB_WO, D, 8, 0, 0, 0, 0, D);
    } else if (sub == 4) {
        p.g[0] = mkgd(OFF_HN2, OFF_WB + WB_F1, 2 * FF, 9, OFF_ACT, 0, 0, 0, FF);
    } else if (sub == 5) {
        p.K = FF;
        p.g[0] = mkgd(OFF_ACT, OFF_WB + WB_F2, D, 8, 0, 0, 0, 0, D);
    } else if (sub == 6) {
        p.g[0] = mkgd(OFF_MIX, OFF_WA + WA_W0, D, 1, OFF_RB, 0, 0, 0, D);
        if (layer == 2) {
            p.g[1] = mkgd(OFF_MIX + SZB, OFF_WA + WA_W1, D, 1, OFF_KF, 0, 0, 0, D);
            p.g[2] = mkgd(OFF_MIX + SZB, OFF_WA + WA_W2, D, 1, OFF_VF, 0, 0, 0, D);
            p.ng = 3;
        }
    } else {
        p.g[0] = mkgd(OFF_MIX, OFF_WB + WB_WO, D, 8, 0, 0, 0, 0, D);
    }
    return p;
}
constexpr PE mkother(int kind, int layer, int sub) { PE p{}; p.kind = kind; p.layer = layer; p.sub = sub; p.ng = 0; p.K = D; p.pad = 0; for (int q = 0; q < 4; ++q) p.g[q] = mkgd(0, 0, 256, 0, 0, 0, 0, 0, D); return p; }
constexpr Tab make_tab() {
    Tab t{};
    int n = 0;
    for (int i = 0; i < 2; ++i) {
        t.e[n++] = mkother(K_MIXPREP, i, 0);
        t.e[n++] = mkgemm(i, 1);
        t.e[n++] = mkgemm(i, 0);
        t.e[n++] = mkgemm(i, 2);
        t.e[n++] = mkother(K_SCAN, i, 0);
        if (DUP_SCAN) t.e[n++] = mkother(K_SCAN, i, 0);
        t.e[n++] = mkother(K_POST, i, 0);
        t.e[n++] = mkgemm(i, 3);
        t.e[n++] = mkother(K_NORMF, i, 0);
        t.e[n++] = mkgemm(i, 4);
        if (DUP_FFN1) t.e[n++] = mkgemm(i, 4);
        t.e[n++] = mkgemm(i, 5);
    }
    for (int j = 0; j < 2; ++j) {
        const int layer = 2 + j;
        t.e[n++] = mkother(K_NORMSB, layer, 0);
        t.e[n++] = mkgemm(layer, 6);
        if (j == 0) t.e[n++] = mkother(K_HEADNORM, layer, 0);
        t.e[n++] = mkother(K_ATTN, layer, 0);
        if (DUP_ATTN) t.e[n++] = mkother(K_ATTN, layer, 0);
        t.e[n++] = mkgemm(layer, 7);
        t.e[n++] = mkother(K_NORMF, layer, 0);
        t.e[n++] = mkgemm(layer, 4);
        if (DUP_FFN1) t.e[n++] = mkgemm(layer, 4);
        t.e[n++] = mkgemm(layer, 5);
    }
    return t;
}
__constant__ const Tab TAB = make_tab();

#ifndef ONLY
#define ONLY -1
#endif
#define EN(k) (ONLY < 0 || ONLY == (k))

__global__ void __launch_bounds__(512, 2) mk_forward(Params P, int ph_lo, int ph_hi) {
    extern __shared__ __attribute__((aligned(16))) unsigned char shm[];
    LAS unsigned char* lds = (LAS unsigned char*)shm;
    cg::grid_group grid = cg::this_grid();
    for (int ph = ph_lo; ph < ph_hi; ++ph) {
        const PE* pe = &TAB.e[ph];
        const int kind = pe->kind, layer = pe->layer, sub = pe->sub;
        if (kind == K_GEMM) { if (EN(K_GEMM)) {
            const bool tail_first = (blockIdx.x & 1) != 0;
            if (tail_first) { tail_gemm(lds, pe, P); __syncthreads(); }
            gemm_phase(lds, pe, P);
            if (!tail_first) tail_gemm(lds, pe, P); } }
        else if (!EN(kind)) {}
        else if (kind == K_MIXPREP) { mixprep_phase(P, layer); convert_layer(P, layer, lds); }
        else if (kind == K_SCAN) scan_phase(P, layer, lds);
        else if (kind == K_POST) post_phase(P, layer);
        else if (kind == K_NORMF) norm_phase(P, P.in[3] + (size_t)layer * D, (bf16_t*)(P.ws + OFF_HN2), nullptr, nullptr);
        else if (kind == K_NORMSB) {
            norm_phase(P, P.in[2] + (size_t)layer * D, (bf16_t*)(P.ws + OFF_MIX), layer == 2 ? P.in[28] : nullptr, (bf16_t*)(P.ws + OFF_MIX + SZB));
            convert_layer(P, layer, lds);
        }
        else if (kind == K_HEADNORM) { if (layer == 2) headnorm_phase(P, lds); }
        else if (kind == K_ATTN) attn_phase(P, layer - 2, lds);
        if (ph + 1 < ph_hi) {
#ifdef USE_CG_SYNC
            grid.sync();
#else
            if (ph == ph_lo) {
                if (blockIdx.x == 0 && threadIdx.x == 0) __hip_atomic_store((unsigned*)(P.ws + WS_END), 0u, __ATOMIC_RELAXED, __HIP_MEMORY_SCOPE_AGENT);
                grid.sync();
            }
            else grid_barrier((unsigned*)(P.ws + WS_END), (unsigned)(ph - ph_lo) * gridDim.x);
#endif
        }
    }
}

__global__ void dbg_copy(Params P, size_t off_bf16a, size_t off_bf16b, size_t off_f32) {
    const size_t n = (size_t)MMAIN * D;
    for (size_t i = (size_t)blockIdx.x * blockDim.x + threadIdx.x; i < n; i += (size_t)gridDim.x * blockDim.x) {
        float v = 0.f;
        if (off_bf16a) v += __uint_as_float(((unsigned)((const bf16_t*)(P.ws + off_bf16a))[i]) << 16);
        if (off_bf16b) v += __uint_as_float(((unsigned)((const bf16_t*)(P.ws + off_bf16b))[i]) << 16);
        if (off_f32) v += ((const float*)(P.ws + off_f32))[i];
        P.out[i] = v;
    }
}
extern "C" void kernel_launch(void* const* d_in, const int* in_sizes, int n_in, void* d_out, int out_size, void* d_ws, size_t ws_size, hipStream_t stream) {
    constexpr size_t kDynLds = 131072;
    static int grid_blocks = 0;
    if (!grid_blocks) {
        hipFuncSetAttribute((const void*)mk_forward, hipFuncAttributeMaxDynamicSharedMemorySize, (int)kDynLds);
        int dev = 0, cus = 0, per_cu = 0;
        hipGetDevice(&dev);
        hipDeviceGetAttribute(&cus, hipDeviceAttributeMultiprocessorCount, dev);
        hipOccupancyMaxActiveBlocksPerMultiprocessor(&per_cu, mk_forward, NTHR, kDynLds);
        if (per_cu < 1) per_cu = 1;
        grid_blocks = cus * per_cu;
        if (ws_size < WS_END) fprintf(stderr, "workspace too small: %zu < %zu\n", ws_size, (size_t)WS_END);
    }
    Params p{};
    for (int i = 0; i < 35; ++i) p.in[i] = (const float*)d_in[i];
    p.out = (float*)d_out; p.ws = (unsigned char*)d_ws;
#ifdef MULTI_LAUNCH
    for (int ph = 0; ph < NPHASE; ++ph) hipLaunchKernelGGL(mk_forward, dim3(grid_blocks), dim3(NTHR), kDynLds, stream, p, ph, ph + 1);
#ifdef DBG_A
    hipLaunchKernelGGL(dbg_copy, dim3(2048), dim3(256), 0, stream, p, (size_t)DBG_A, (size_t)DBG_B, (size_t)DBG_F);
#endif
#else
    int lo = 0, hi = NPHASE;
    void* args[] = {&p, &lo, &hi};
    hipError_t e = hipLaunchCooperativeKernel((void*)mk_forward, dim3(grid_blocks), dim3(NTHR), args, kDynLds, stream);
    if (e != hipSuccess) fprintf(stderr, "cooperative launch failed: %s (grid %d)\n", hipGetErrorString(e), grid_blocks);
#endif
}
```

```cpp
#include <hip/hip_runtime.h>
#include <hip/hip_cooperative_groups.h>
#include <cstdio>
namespace cg = cooperative_groups;

#define LAS __attribute__((address_space(3)))
typedef unsigned short bf16_t;
typedef short bf16x8 __attribute__((ext_vector_type(8)));
typedef float f32x4 __attribute__((ext_vector_type(4)));
typedef unsigned u32x2 __attribute__((ext_vector_type(2)));
typedef unsigned u32x4 __attribute__((ext_vector_type(4)));

constexpr int D = 2048, FF = 5632, NBATCH = 4, SEQ = 4096, NMETA = 16, L = SEQ + NMETA;
constexpr int M = NBATCH * L;
constexpr int MMAIN = NBATCH * SEQ;
constexpr int MP = 16640;
constexpr int NTHR = 512;
constexpr int PPAD = 112, PLEN = 4224;

constexpr size_t SZB = (size_t)MP * D * 2, SZF = 2 * SZB;
constexpr size_t OFF_WA = 0;
constexpr size_t OFF_WB = 37748736;
constexpr size_t OFF_HT = OFF_WB + 83886080;
constexpr size_t OFF_RB = OFF_HT + 1048576;
constexpr size_t OFF_VFIRST = OFF_RB + SZB;
constexpr size_t OFF_KF = OFF_VFIRST + SZB;
constexpr size_t OFF_VF = OFF_KF + SZF;
constexpr size_t OFF_DEC = OFF_VF + SZF;
constexpr size_t OFF_MIX = OFF_DEC + SZF;
constexpr size_t OFF_LORA = OFF_MIX + 3 * SZB;
constexpr size_t SZLORA = (size_t)MP * 256 * 2;
constexpr size_t WS_END = OFF_LORA + 4 * SZLORA;
constexpr size_t OFF_HN2 = OFF_KF, OFF_ACT = OFF_KF + SZB;
constexpr size_t WA_W0 = 0, WA_W1 = 8388608, WA_W2 = 16777216, WA_L1 = 25165824, WA_L2 = 29360128, WSLOT = 1048576;
constexpr size_t WB_WO = 0, WB_F1 = 8388608, WB_F2 = WB_F1 + (size_t)2 * FF * D * 2;

struct Params {
    const float* in[35];
    float* out;
    unsigned char* ws;
};

__device__ __forceinline__ int rowof(int b, int t) { return t < NMETA ? MMAIN + b * NMETA + t : b * SEQ + (t - NMETA); }
__device__ __forceinline__ float* hrow(const Params& P, int r) {
    return r < MMAIN ? P.out + (size_t)r * D : (float*)(P.ws + OFF_HT) + (size_t)(r - MMAIN) * D;
}
__device__ __forceinline__ unsigned cvt_pk_bf16(float lo, float hi) { unsigned r; asm volatile("v_cvt_pk_bf16_f32 %0, %1, %2" : "=v"(r) : "v"(lo), "v"(hi)); return r; }
__device__ __forceinline__ float bf_lo(unsigned x) { return __uint_as_float(x << 16); }
__device__ __forceinline__ float bf_hi(unsigned x) { return __uint_as_float(x & 0xffff0000u); }
template <int CTRL> __device__ __forceinline__ float dpp_mov(float x) {
    return __int_as_float(__builtin_amdgcn_update_dpp(0, __float_as_int(x), CTRL, 0xF, 0xF, true));
}
__device__ __forceinline__ float rowsum16(float x) {
    x += dpp_mov<0x128>(x); x += dpp_mov<0x124>(x); x += dpp_mov<0x122>(x); x += dpp_mov<0x121>(x); return x;
}
__device__ __forceinline__ float wavesum(float x) { x = rowsum16(x); x += __shfl_xor(x, 16); x += __shfl_xor(x, 32); return x; }
__device__ __forceinline__ int otid() { int t = threadIdx.x; asm volatile("" : "+v"(t)); return t; }
__device__ __forceinline__ int obid() { int t = blockIdx.x; asm volatile("" : "+s"(t)); return t; }
__device__ __forceinline__ float sigmoidf_(float x) { return 1.0f / (1.0f + __expf(-x)); }

constexpr int BM = 256, BK = 64, HALF = 128, HTB = HALF * BK * 2, NXCD = 8, WGM = 8, NMT = MMAIN / BM;
__device__ __forceinline__ int lds_byte(int r, int c) { const int st = (r >> 4) * 2 + (c >> 5), rr = r & 15, cc = c & 31, ob = rr * 64 + cc * 2; return st * 1024 + (ob ^ (((ob >> 9) & 1) << 5)); }
__device__ __forceinline__ void stage_rc(int b, int& R, int& C) { const int st = b / 1024, sb = b % 1024, swz = sb ^ (((sb >> 9) & 1) << 5); R = (st >> 1) * 16 + swz / 64; C = (st & 1) * 32 + (swz % 64) / 2; }

struct GD { unsigned long long A, Bt, o0, o1; int N, mode, bin, boff, ldo, pad; };
struct PE { int kind, layer, sub, ng, K, pad; GD g[4]; };
struct Unit { int pm, pn, gi; };

__device__ __forceinline__ bool sched_next(const int Lx, const int c1, const int c2, const int c3, const int c4, Unit& u) {
    if (Lx >= c4) return false;
    int gi = 0, base = 0, top = c1;
    if (Lx >= c1) { gi = 1; base = c1; top = c2; }
    if (Lx >= c2) { gi = 2; base = c2; top = c3; }
    if (Lx >= c3) { gi = 3; base = c3; top = c4; }
    const int nM = NMT, nwg = top - base, nN = nwg / NMT;
    int wgid = Lx - base; { const int q = nwg / NXCD, r = nwg % NXCD, xcd = wgid % NXCD, off = wgid / NXCD; wgid = (xcd < r ? xcd * (q + 1) : r * (q + 1) + (xcd - r) * q) + off; }
    const int nig = WGM * nN, gid = wgid / nig, fm = gid * WGM, gsz = (nM - fm) < WGM ? (nM - fm) : WGM;
    u.pm = fm + ((wgid % nig) % gsz); u.pn = (wgid % nig) / gsz; u.gi = gi; return true;
}

template <int MODE>
__device__ __forceinline__ void epi_elem(const int r, const int c, f32x4 v, void* g_o0, void* g_o1, const f32x4 bv, const int ldo, float* outp, float* htp) {
    if constexpr (MODE == 8) {
        float* p = (r < MMAIN ? outp + (size_t)r * D : htp + (size_t)(r - MMAIN) * D) + c; f32x4 hv = *(f32x4*)p; *(f32x4*)p = hv + v;
    } else if constexpr (MODE == 1) {
        *(f32x4*)((float*)g_o0 + (size_t)r * ldo + c) = v;
    } else if constexpr (MODE == 2) {
        *(f32x4*)((float*)g_o0 + (size_t)r * ldo + c) = v;
        u32x2 wv; wv.x = cvt_pk_bf16(v[0], v[1]); wv.y = cvt_pk_bf16(v[2], v[3]);
        *(u32x2*)((bf16_t*)g_o1 + (size_t)r * ldo + c) = wv;
    } else if constexpr (MODE == 5) {
        f32x4 o;
#pragma unroll
        for (int e = 0; e < 4; ++e) { const float x = -(bv[e] + v[e]); const float sp = fmaxf(x, 0.f) + __logf(1.0f + __expf(-fabsf(x))); const float wl = -sp - 0.5f; o[e] = __expf(-__expf(wl)); }
        *(f32x4*)((float*)g_o0 + (size_t)r * ldo + c) = o;
    } else if constexpr (MODE == 7) {
        float* vp = (float*)g_o0 + (size_t)r * ldo + c; const f32x4 vv = *(f32x4*)vp;
        const u32x2 vf = *(const u32x2*)((const bf16_t*)g_o1 + (size_t)r * ldo + c);
        const float f0 = bf_lo(vf.x), f1 = bf_hi(vf.x), f2 = bf_lo(vf.y), f3 = bf_hi(vf.y);
        f32x4 o;
        o[0] = vv[0] + (f0 - vv[0]) * sigmoidf_(bv[0] + v[0]); o[1] = vv[1] + (f1 - vv[1]) * sigmoidf_(bv[1] + v[1]);
        o[2] = vv[2] + (f2 - vv[2]) * sigmoidf_(bv[2] + v[2]); o[3] = vv[3] + (f3 - vv[3]) * sigmoidf_(bv[3] + v[3]);
        *(f32x4*)vp = o;
    } else {
        if constexpr (MODE == 3) {
#pragma unroll
            for (int e = 0; e < 4; ++e) { const float ax = fminf(fabsf(v[e]), 15.0f); const float t = 1.0f - 2.0f / (__expf(2.0f * ax) + 1.0f); v[e] = v[e] < 0.f ? -t : t; } }
        else if constexpr (MODE == 4) { v[0] = sigmoidf_(v[0]); v[1] = sigmoidf_(v[1]); v[2] = sigmoidf_(v[2]); v[3] = sigmoidf_(v[3]); }
        else if constexpr (MODE == 6) { v[0] = sigmoidf_(bv[0] + v[0]); v[1] = sigmoidf_(bv[1] + v[1]); v[2] = sigmoidf_(bv[2] + v[2]); v[3] = sigmoidf_(bv[3] + v[3]); }
        u32x2 wv; wv.x = cvt_pk_bf16(v[0], v[1]); wv.y = cvt_pk_bf16(v[2], v[3]);
        *(u32x2*)((bf16_t*)g_o0 + (size_t)r * ldo + c) = wv;
    }
}
__device__ __forceinline__ void epi_swiglu(const int r, const int oc, const f32x4 g, const f32x4 up, void* g_o0, const int ldo) {
    float o[4];
#pragma unroll
    for (int e = 0; e < 4; ++e) o[e] = g[e] * __builtin_amdgcn_rcpf(1.0f + __expf(-g[e])) * up[e];
    u32x2 wv; wv.x = cvt_pk_bf16(o[0], o[1]); wv.y = cvt_pk_bf16(o[2], o[3]);
    *(u32x2*)((bf16_t*)g_o0 + (size_t)r * ldo + oc) = wv;
}
template <int MODE>
__device__ __forceinline__ void epi_t(const f32x4 (&acc)[2][2][4][2], void* g_o0, void* g_o1, const float* g_bias, const int ldo, const int u_pm, const int u_pn, int wr, int wc, int fr, int fq, float* outp, float* htp) {
    const int row0 = u_pm * BM + wr * 64 + fr, col0 = u_pn * BM + wc * 32 + 4 * fq;
    f32x4 bvv[2][2];
#pragma unroll
    for (int bj = 0; bj < 2; ++bj)
#pragma unroll
        for (int n = 0; n < 2; ++n) bvv[bj][n] = (MODE == 5 || MODE == 6 || MODE == 7) ? *(const f32x4*)(g_bias + col0 + bj * HALF + n * 16) : (f32x4){0.f, 0.f, 0.f, 0.f};
    if constexpr (MODE == 7) {
#pragma unroll
        for (int ai = 0; ai < 2; ++ai) {
#pragma unroll
            for (int mh = 0; mh < 2; ++mh) {
                f32x4 vv[2][2][2]; u32x2 vf[2][2][2];
#pragma unroll
                for (int ml = 0; ml < 2; ++ml) { const size_t o = (size_t)(row0 + ai * HALF + (2 * mh + ml) * 16) * ldo + col0;
#pragma unroll
                    for (int bj = 0; bj < 2; ++bj)
#pragma unroll
                        for (int n = 0; n < 2; ++n) { vv[ml][bj][n] = *(const f32x4*)((const float*)g_o0 + o + bj * HALF + n * 16); vf[ml][bj][n] = *(const u32x2*)((const bf16_t*)g_o1 + o + bj * HALF + n * 16); } }
#pragma unroll
                for (int ml = 0; ml < 2; ++ml) { const size_t o = (size_t)(row0 + ai * HALF + (2 * mh + ml) * 16) * ldo + col0;
#pragma unroll
                    for (int bj = 0; bj < 2; ++bj)
#pragma unroll
                        for (int n = 0; n < 2; ++n) { const f32x4 a = acc[ai][bj][2 * mh + ml][n], x = vv[ml][bj][n], bb = bvv[bj][n]; const u32x2 f = vf[ml][bj][n];
                            f32x4 ov;
                            ov[0] = x[0] + (bf_lo(f.x) - x[0]) * sigmoidf_(bb[0] + a[0]); ov[1] = x[1] + (bf_hi(f.x) - x[1]) * sigmoidf_(bb[1] + a[1]);
                            ov[2] = x[2] + (bf_lo(f.y) - x[2]) * sigmoidf_(bb[2] + a[2]); ov[3] = x[3] + (bf_hi(f.y) - x[3]) * sigmoidf_(bb[3] + a[3]);
                            *(f32x4*)((float*)g_o0 + o + bj * HALF + n * 16) = ov; } }
            }
        }
        return;
    }
    if constexpr (MODE == 8) {
#pragma unroll
        for (int ai = 0; ai < 2; ++ai) {
            f32x4 hv[4][2][2];
#pragma unroll
            for (int m = 0; m < 4; ++m) { const int r = row0 + ai * HALF + m * 16; float* p = (r < MMAIN ? outp + (size_t)r * D : htp + (size_t)(r - MMAIN) * D) + col0;
#pragma unroll
                for (int bj = 0; bj < 2; ++bj)
#pragma unroll
                    for (int n = 0; n < 2; ++n) hv[m][bj][n] = *(const f32x4*)(p + bj * HALF + n * 16); }
#pragma unroll
            for (int m = 0; m < 4; ++m) { const int r = row0 + ai * HALF + m * 16; float* p = (r < MMAIN ? outp + (size_t)r * D : htp + (size_t)(r - MMAIN) * D) + col0;
#pragma unroll
                for (int bj = 0; bj < 2; ++bj)
#pragma unroll
                    for (int n = 0; n < 2; ++n) *(f32x4*)(p + bj * HALF + n * 16) = hv[m][bj][n] + acc[ai][bj][m][n]; }
        }
        return;
    }
#pragma unroll
    for (int ai = 0; ai < 2; ++ai) {
#pragma unroll
        for (int m = 0; m < 4; ++m) {
            const int r = row0 + ai * HALF + m * 16;
            if constexpr (MODE == 9) {
#pragma unroll
                for (int bj = 0; bj < 2; ++bj)
                    epi_swiglu(r, 16 * (u_pn * 8 + bj * 4 + wc) + 4 * fq, acc[ai][bj][m][0], acc[ai][bj][m][1], g_o0, ldo);
            } else if constexpr (MODE == 8 || MODE == 7) {
            } else {
#pragma unroll
                for (int bj = 0; bj < 2; ++bj) {
#pragma unroll
                    for (int n = 0; n < 2; ++n)
                        epi_elem<MODE>(r, col0 + bj * HALF + n * 16, acc[ai][bj][m][n], g_o0, g_o1, bvv[bj][n], ldo, outp, htp);
                }
            }
        }
    }
}
#define EPI_CALL(MD) epi_t<MD>(acc, g_o0, g_o1, g_bias, ldo, u_pm, u_pn, wr, wc, fr, fq, outp, htp)
__device__ __forceinline__ void epilogue(const f32x4 (&acc)[2][2][4][2], const int mode, void* g_o0, void* g_o1, const float* g_bias, const int ldo, const int u_pm, const int u_pn, int wr, int wc, int fr, int fq, float* outp, float* htp) {
    switch (mode) {
        case 0: EPI_CALL(0); break;
        case 1: EPI_CALL(1); break;
        case 2: EPI_CALL(2); break;
        case 3: EPI_CALL(3); break;
        case 4: EPI_CALL(4); break;
        case 5: EPI_CALL(5); break;
        case 6: EPI_CALL(6); break;
        case 7: EPI_CALL(7); break;
        case 8: EPI_CALL(8); break;
        default: EPI_CALL(9); break;
    }
}

__device__ __forceinline__ void gemm_phase(LAS unsigned char* lds, const PE* pe, const Params& P) {
    const int tid = threadIdx.x, wid = __builtin_amdgcn_readfirstlane(tid >> 6), lane = tid & 63, wr = wid >> 2, wc = wid & 3, fr = lane & 15, fq = lane >> 4;
    const int K = pe->K, nt = K / BK;
    const int sG = (int)gridDim.x, sC = (int)blockIdx.x, s_ng = pe->ng;
    const int sc1 = NMT * (pe->g[0].N / BM);
    const int sc2 = sc1 + (s_ng > 1 ? NMT * (pe->g[1].N / BM) : 0);
    const int sc3 = sc2 + (s_ng > 2 ? NMT * (pe->g[2].N / BM) : 0);
    const int sc4 = sc3 + (s_ng > 3 ? NMT * (pe->g[3].N / BM) : 0);
    unsigned char* const ws = P.ws;
    unsigned voff[2];
#pragma unroll
    for (int i = 0; i < 2; ++i) { int R, C; stage_rc(tid * 16 + i * 8192, R, C); voff[i] = (unsigned)(R * K + C) * 2u; }
    const size_t kstep = (size_t)(BK * 2);
    const size_t hstep = (size_t)HALF * K * 2;
    const size_t tstep = 2 * hstep;
    const unsigned ldsw = (unsigned)wid * 1024u;
    const int aoff = lds_byte(wr * 64 + fr, fq * 8), boff = lds_byte(wc * 32 + fr, fq * 8);
#define PG8_SA(b, h) (((b) * 2 + (h)) * HTB)
#define PG8_SB(b, h) ((4 + (b) * 2 + (h)) * HTB)
#define PG8_STAGE(bufoff, gbase) do { _Pragma("unroll") for (int _i = 0; _i < 2; ++_i) \
        __builtin_amdgcn_global_load_lds((const unsigned*)((const char*)(gbase) + voff[_i]), (LAS unsigned*)(lds + (bufoff) + ldsw + _i * 8192), 16, 0, 0); } while (0)
#define PG8_LDA(dst, b, h) do { _Pragma("unroll") for (int m = 0; m < 4; ++m) _Pragma("unroll") for (int k = 0; k < 2; ++k) dst[m][k] = *(const LAS bf16x8*)(lds + PG8_SA(b, h) + aoff + m * 2048 + k * 1024); } while (0)
#define PG8_LDB(dst, b, h) do { _Pragma("unroll") for (int n = 0; n < 2; ++n) _Pragma("unroll") for (int k = 0; k < 2; ++k) dst[n][k] = *(const LAS bf16x8*)(lds + PG8_SB(b, h) + boff + n * 2048 + k * 1024); } while (0)
#define PG8_MMA(ai, bj, At, Bt) do { __builtin_amdgcn_s_setprio(1); _Pragma("unroll") for (int m = 0; m < 4; ++m) _Pragma("unroll") for (int n = 0; n < 2; ++n) _Pragma("unroll") for (int k = 0; k < 2; ++k) \
        acc[ai][bj][m][n] = __builtin_amdgcn_mfma_f32_16x16x32_bf16(Bt[n][k], At[m][k], acc[ai][bj][m][n], 0, 0, 0); __builtin_amdgcn_s_setprio(0); } while (0)
#define PG8_WAIT_V(n) asm volatile("s_waitcnt vmcnt(" #n ")" ::: "memory")
#define PG8_WAIT_L(n) asm volatile("s_waitcnt lgkmcnt(" #n ")" ::: "memory")
#define PG8_BAR __builtin_amdgcn_s_barrier()
#define PG8_SCHED __builtin_amdgcn_sched_barrier(0)
    Unit cur, nxt; int ui = 0;
    if (!sched_next(sC, sc1, sc2, sc3, sc4, cur)) return;
    f32x4 acc[2][2][4][2];
#pragma unroll
    for (int a = 0; a < 2; ++a)
#pragma unroll
        for (int b = 0; b < 2; ++b)
#pragma unroll
            for (int m = 0; m < 4; ++m)
#pragma unroll
                for (int n = 0; n < 2; ++n) acc[a][b][m][n] = (f32x4){0.f, 0.f, 0.f, 0.f};
    bf16x8 At[4][2], B0[2][2], B1[2][2];
    const char* cA = (const char*)ws + pe->g[cur.gi].A + (size_t)cur.pm * tstep; const char* cB = (const char*)ws + pe->g[cur.gi].Bt + (size_t)cur.pn * tstep;
    PG8_STAGE(PG8_SB(0, 0), cB); PG8_STAGE(PG8_SA(0, 0), cA); PG8_STAGE(PG8_SB(0, 1), cB + hstep); PG8_STAGE(PG8_SA(0, 1), cA + hstep);
    if (wr == 1) PG8_BAR;
    PG8_WAIT_V(4); PG8_BAR;
    PG8_STAGE(PG8_SB(1, 0), cB + kstep); PG8_STAGE(PG8_SA(1, 0), cA + kstep); PG8_STAGE(PG8_SB(1, 1), cB + hstep + kstep);
    PG8_WAIT_V(6); PG8_BAR;
    for (;;) {
        const bool has_next = sched_next((ui + 1) * sG + sC, sc1, sc2, sc3, sc4, nxt);
        const char* nA = cA; const char* nB = cB;
        if (has_next) { nA = (const char*)ws + pe->g[nxt.gi].A + (size_t)nxt.pm * tstep; nB = (const char*)ws + pe->g[nxt.gi].Bt + (size_t)nxt.pn * tstep; }
        for (int t = 0; t < nt; t += 2) {
            const bool last = (t == nt - 2);
            const char* a1 = cA + (size_t)(t + 1) * kstep;
            const char* a2 = last ? nA : cA + (size_t)(t + 2) * kstep; const char* b2 = last ? nB : cB + (size_t)(t + 2) * kstep;
            const char* a3 = a2 + kstep; const char* b3 = b2 + kstep;
            PG8_LDB(B0, 0, 0); PG8_SCHED; PG8_LDA(At, 0, 0); PG8_STAGE(PG8_SA(1, 1), a1 + hstep);
            PG8_WAIT_L(8); PG8_BAR; PG8_WAIT_L(0); PG8_MMA(0, 0, At, B0); PG8_BAR; PG8_SCHED;
            PG8_LDB(B1, 0, 1); PG8_STAGE(PG8_SB(0, 0), b2);
            PG8_BAR; PG8_WAIT_L(0); PG8_MMA(0, 1, At, B1); PG8_BAR;
            PG8_LDA(At, 0, 1); PG8_STAGE(PG8_SA(0, 0), a2);
            PG8_BAR; PG8_WAIT_L(0); PG8_MMA(1, 0, At, B0); PG8_BAR; PG8_SCHED;
            PG8_STAGE(PG8_SB(0, 1), b2 + hstep);
            PG8_WAIT_V(6); PG8_BAR; PG8_MMA(1, 1, At, B1); PG8_BAR;
            PG8_LDB(B0, 1, 0); PG8_SCHED; PG8_LDA(At, 1, 0); PG8_STAGE(PG8_SA(0, 1), a2 + hstep);
            PG8_WAIT_L(8); PG8_BAR; PG8_WAIT_L(0); PG8_MMA(0, 0, At, B0); PG8_BAR; PG8_SCHED;
            PG8_LDB(B1, 1, 1); PG8_STAGE(PG8_SB(1, 0), b3);
            PG8_BAR; PG8_WAIT_L(0); PG8_MMA(0, 1, At, B1); PG8_BAR;
            PG8_LDA(At, 1, 1); PG8_STAGE(PG8_SA(1, 0), a3);
            PG8_BAR; PG8_WAIT_L(0); PG8_MMA(1, 0, At, B0); PG8_BAR; PG8_SCHED;
            PG8_STAGE(PG8_SB(1, 1), b3 + hstep);
            PG8_WAIT_V(6); PG8_BAR; PG8_MMA(1, 1, At, B1); PG8_BAR;
        }
        { const GD* gd = &pe->g[cur.gi];
          epilogue(acc, gd->mode, ws + gd->o0, ws + gd->o1, P.in[gd->bin] + gd->boff, gd->ldo, cur.pm, cur.pn, wr, wc, fr, fq, P.out, (float*)(ws + OFF_HT)); }
        if (!has_next) break;
#pragma unroll
        for (int a = 0; a < 2; ++a)
#pragma unroll
            for (int b = 0; b < 2; ++b)
#pragma unroll
                for (int m = 0; m < 4; ++m)
#pragma unroll
                    for (int n = 0; n < 2; ++n) acc[a][b][m][n] = (f32x4){0.f, 0.f, 0.f, 0.f};
        cur = nxt; cA = nA; cB = nB; ++ui;
    }
    PG8_WAIT_V(0);
    if (wr == 0) PG8_BAR;
    PG8_BAR;
#undef PG8_SA
#undef PG8_SB
#undef PG8_STAGE
#undef PG8_LDA
#undef PG8_LDB
#undef PG8_MMA
#undef PG8_WAIT_V
#undef PG8_WAIT_L
#undef PG8_BAR
#undef PG8_SCHED
}

#define TE_CALL(MD) epi_elem<MD>(r, c, v, o0, o1, bvt, ldo, P.out, (float*)(ws + OFF_HT))
__device__ void tail_gemm(LAS unsigned char* lds, const PE* pe, const Params& P) {
    const int tid = otid(), w = tid >> 6, lane = tid & 63, fr = lane & 15, fq = lane >> 4;
    unsigned char* const ws = P.ws;
    const int K = pe->K, ks = K >> 3, nstep = ks >> 5, ng = pe->ng;
    const int t1 = pe->g[0].N >> 4;
    const int t2 = t1 + (ng > 1 ? pe->g[1].N >> 4 : 0);
    const int t3 = t2 + (ng > 2 ? pe->g[2].N >> 4 : 0);
    const int t4 = t3 + (ng > 3 ? pe->g[3].N >> 4 : 0);
    LAS f32x4* part = (LAS f32x4*)lds;
    const int bid_ = obid();
    const int rank_ = (bid_ & 1) ? (bid_ >> 1) : ((int)(gridDim.x >> 1) + (bid_ >> 1));
    for (int item = rank_; item < t4; item += gridDim.x) {
        int gi = 0, base = 0;
        if (item >= t1) { gi = 1; base = t1; }
        if (item >= t2) { gi = 2; base = t2; }
        if (item >= t3) { gi = 3; base = t3; }
        const int cb = (item - base) >> 1, mh = (item - base) & 1;
        const GD* gd = &pe->g[gi];
        const bf16_t* A = (const bf16_t*)(ws + gd->A) + (size_t)(MMAIN + 32 * mh + fr) * K + (size_t)w * ks + 8 * fq;
        const bf16_t* Bt = (const bf16_t*)(ws + gd->Bt) + (size_t)(32 * cb + fr) * K + (size_t)w * ks + 8 * fq;
        const size_t r16 = (size_t)16 * K;
        f32x4 acc[2][2];
#pragma unroll
        for (int m = 0; m < 2; ++m) { acc[m][0] = (f32x4){0.f, 0.f, 0.f, 0.f}; acc[m][1] = acc[m][0]; }
        for (int s0 = 0; s0 < nstep; s0 += 8) {
            bf16x8 af[8][2], bfr[8][2];
#pragma unroll
            for (int s = 0; s < 8; ++s) if (s0 + s < nstep) {
                const int k0 = (s0 + s) * 32;
                af[s][0] = *(const bf16x8*)(A + k0); af[s][1] = *(const bf16x8*)(A + r16 + k0);
                bfr[s][0] = *(const bf16x8*)(Bt + k0); bfr[s][1] = *(const bf16x8*)(Bt + r16 + k0);
            }
#pragma unroll
            for (int s = 0; s < 8; ++s) if (s0 + s < nstep) {
#pragma unroll
                for (int m = 0; m < 2; ++m)
#pragma unroll
                    for (int nb = 0; nb < 2; ++nb) acc[m][nb] = __builtin_amdgcn_mfma_f32_16x16x32_bf16(bfr[s][nb], af[s][m], acc[m][nb], 0, 0, 0);
            }
        }
        __syncthreads();
#pragma unroll
        for (int m = 0; m < 2; ++m)
#pragma unroll
            for (int nb = 0; nb < 2; ++nb) part[(w * 4 + m * 2 + nb) * 64 + lane] = acc[m][nb];
        __syncthreads();
        if (tid < 256) {
            const int ml = tid >> 7, nb2 = (tid >> 6) & 1;
            f32x4 v = part[(ml * 2 + nb2) * 64 + lane];
#pragma unroll
            for (int x = 1; x < 8; ++x) v += part[(x * 4 + ml * 2 + nb2) * 64 + lane];
            const int r = MMAIN + 32 * mh + 16 * ml + fr, c = 32 * cb + 16 * nb2 + 4 * fq;
            const int mode = gd->mode, ldo = gd->ldo;
            void* o0 = ws + gd->o0; void* o1 = ws + gd->o1; const float* bias = P.in[gd->bin] + gd->boff;
            const f32x4 bvt = (mode == 5 || mode == 6 || mode == 7) ? *(const f32x4*)(bias + c) : (f32x4){0.f, 0.f, 0.f, 0.f};
            if (mode == 9) {
                if (nb2 == 0) { f32x4 up = part[(ml * 2 + 1) * 64 + lane];
#pragma unroll
                    for (int x = 1; x < 8; ++x) up += part[(x * 4 + ml * 2 + 1) * 64 + lane];
                    epi_swiglu(r, 16 * cb + 4 * fq, v, up, o0, ldo); }
            } else {
                switch (mode) {
                    case 0: TE_CALL(0); break;
                    case 1: TE_CALL(1); break;
                    case 2: TE_CALL(2); break;
                    case 3: TE_CALL(3); break;
                    case 4: TE_CALL(4); break;
                    case 5: TE_CALL(5); break;
                    case 6: TE_CALL(6); break;
                    case 7: TE_CALL(7); break;
                    default: TE_CALL(8); break;
                }
            }
        }
    }
}

__device__ void conv_T(const float* src, const float* src2, int ldsrc, bf16_t* dst, int K, int N, int Kpad, int Npad, int mode, LAS float* tile) {
    const int tid = otid();
    const int tk = Kpad / 256, tn = Npad / 64, ntile = tk * tn;
    for (int ti = obid(); ti < ntile; ti += gridDim.x) {
        const int R0 = (ti / tk) * 64, k0 = (ti % tk) * 256;
        f32x4 v[4][2];
#pragma unroll
        for (int sub = 0; sub < 4; ++sub)
#pragma unroll
            for (int pass = 0; pass < 2; ++pass) {
                const int kr = (tid >> 4) + pass * 32, c4 = (tid & 15) * 4;
                const int k = k0 + sub * 64 + kr, R = R0 + c4;
                v[sub][pass] = (f32x4){0.f, 0.f, 0.f, 0.f};
                if (k < K && R < N) {
                    const float* s; int col;
                    if (mode == 1) { const int g = R >> 5, wi = R & 31; s = wi < 16 ? src : src2; col = 16 * g + (wi & 15); }
                    else { s = src; col = R; }
                    v[sub][pass] = *(const f32x4*)(s + (size_t)k * ldsrc + col);
                }
            }
        __syncthreads();
#pragma unroll
        for (int sub = 0; sub < 4; ++sub)
#pragma unroll
            for (int pass = 0; pass < 2; ++pass) {
                const int kr = (tid >> 4) + pass * 32, c4 = (tid & 15) * 4;
                LAS float* t = tile + sub * (64 * 65) + kr * 65 + c4;
                t[0] = v[sub][pass][0]; t[1] = v[sub][pass][1]; t[2] = v[sub][pass][2]; t[3] = v[sub][pass][3];
            }
        __syncthreads();
        const int Rr = tid >> 3, k8 = (tid & 7) * 8;
#pragma unroll
        for (int sub = 0; sub < 4; ++sub) {
            float e[8];
#pragma unroll
            for (int i = 0; i < 8; ++i) e[i] = tile[sub * (64 * 65) + (k8 + i) * 65 + Rr];
            u32x4 o; o.x = cvt_pk_bf16(e[0], e[1]); o.y = cvt_pk_bf16(e[2], e[3]); o.z = cvt_pk_bf16(e[4], e[5]); o.w = cvt_pk_bf16(e[6], e[7]);
            *(u32x4*)(dst + (size_t)(R0 + Rr) * Kpad + k0 + sub * 64 + k8) = o;
        }
    }
}

struct CJ { int in0, in1, ldsrc, K, N, Kpad, Npad, mode; unsigned long long soff, doff; };
struct CJTab { CJ j[4][14]; int n[4]; };
constexpr CJ mkcj(int in0, int in1, unsigned long long soff, int ldsrc, unsigned long long doff, int K, int N, int Kpad, int Npad, int mode) {
    CJ c{}; c.in0 = in0; c.in1 = in1; c.ldsrc = ldsrc; c.K = K; c.N = N; c.Kpad = Kpad; c.Npad = Npad; c.mode = mode; c.soff = soff; c.doff = doff; return c;
}
constexpr CJTab make_cjtab() {
    CJTab t{};
    const unsigned long long DD = (unsigned long long)D * D, DF = (unsigned long long)D * FF;
    for (int layer = 0; layer < 4; ++layer) {
        int n = 0;
        if (layer < 2) {
            const unsigned long long i = layer;
            t.j[layer][n++] = mkcj(8, 8, i * DD, D, OFF_WA + WA_W0, D, D, D, D, 0);
            t.j[layer][n++] = mkcj(9, 9, i * DD, D, OFF_WA + WA_W1, D, D, D, D, 0);
            t.j[layer][n++] = mkcj(10, 10, i * DD, D, OFF_WA + WA_W2, D, D, D, D, 0);
            t.j[layer][n++] = mkcj(13, 13, i * D * 96, 96, OFF_WA + WA_L1 + 0 * WSLOT, D, 96, D, 256, 0);
            t.j[layer][n++] = mkcj(16, 16, i * D * 96, 96, OFF_WA + WA_L1 + 1 * WSLOT, D, 96, D, 256, 0);
            t.j[layer][n++] = mkcj(18, 18, i * D * 256, 256, OFF_WA + WA_L1 + 2 * WSLOT, D, 256, D, 256, 0);
            t.j[layer][n++] = mkcj(14, 14, i * 96 * D, D, OFF_WA + WA_L2 + 0 * WSLOT, 96, D, 256, D, 0);
            t.j[layer][n++] = mkcj(17, 17, i * 96 * D, D, OFF_WA + WA_L2 + 1 * WSLOT, 96, D, 256, D, 0);
            t.j[layer][n++] = mkcj(19, 19, i * 256 * D, D, OFF_WA + WA_L2 + 2 * WSLOT, 256, D, 256, D, 0);
            if (layer >= 1) {
                t.j[layer][n++] = mkcj(26, 26, (i - 1) * D * 64, 64, OFF_WA + WA_L1 + 3 * WSLOT, D, 64, D, 256, 0);
                t.j[layer][n++] = mkcj(27, 27, (i - 1) * 64 * D, D, OFF_WA + WA_L2 + 3 * WSLOT, 64, D, 256, D, 0);
            }
            t.j[layer][n++] = mkcj(11, 11, i * DD, D, OFF_WB + WB_WO, D, D, D, D, 0);
        } else {
            const unsigned long long jj = layer - 2;
            t.j[layer][n++] = mkcj(32, 32, jj * DD, D, OFF_WA + WA_W0, D, D, D, D, 0);
            if (layer == 2) {
                t.j[layer][n++] = mkcj(29, 29, 0, D, OFF_WA + WA_W1, D, D, D, D, 0);
                t.j[layer][n++] = mkcj(30, 30, 0, D, OFF_WA + WA_W2, D, D, D, D, 0);
            }
            t.j[layer][n++] = mkcj(34, 34, jj * DD, D, OFF_WB + WB_WO, D, D, D, D, 0);
        }
        t.j[layer][n++] = mkcj(4, 5, (unsigned long long)layer * DF, FF, OFF_WB + WB_F1, D, 2 * FF, D, 2 * FF, 1);
        t.j[layer][n++] = mkcj(6, 6, (unsigned long long)layer * DF, D, OFF_WB + WB_F2, FF, D, FF, D, 0);
        t.n[layer] = n;
    }
    return t;
}
__constant__ const CJTab CJT = make_cjtab();

__device__ void convert_layer(const Params& P, int layer, LAS unsigned char* lds) {
    LAS float* tile = (LAS float*)lds;
    const int nj = CJT.n[layer];
    for (int q = 0; q < nj; ++q) {
        const CJ* c = &CJT.j[layer][q];
        conv_T(P.in[c->in0] + c->soff, P.in[c->in1] + c->soff, c->ldsrc, (bf16_t*)(P.ws + c->doff), c->K, c->N, c->Kpad, c->Npad, c->mode, tile);
    }
}

__device__ void init_phase(const Params& P) {
    const f32x4* x = (const f32x4*)P.in[0]; f32x4* o = (f32x4*)P.out;
    const size_t n4 = (size_t)MMAIN * D / 4;
    for (size_t i = (size_t)obid() * NTHR + otid(); i < n4; i += (size_t)gridDim.x * NTHR) o[i] = x[i];
    const f32x4* mt = (const f32x4*)P.in[1]; f32x4* ht = (f32x4*)(P.ws + OFF_HT);
    const int m4 = NBATCH * NMETA * D / 4, per = NMETA * D / 4;
    for (int i = obid() * NTHR + otid(); i < m4; i += gridDim.x * NTHR) ht[i] = mt[i % per];
}

__device__ void mixprep_phase(const Params& P, int i) {
    const int tid_ = otid(); const int w = tid_ >> 6, lane = tid_ & 63;
    const float* g = P.in[2] + (size_t)i * D;
    const float* mu = P.in[7] + (size_t)i * 6 * D;
    bf16_t* const ob[6] = {(bf16_t*)(P.ws + OFF_MIX), (bf16_t*)(P.ws + OFF_DEC), (bf16_t*)(P.ws + OFF_MIX + SZB), (bf16_t*)(P.ws + OFF_MIX + 2 * SZB),
                           (bf16_t*)(P.ws + OFF_DEC + SZB), (bf16_t*)(P.ws + OFF_KF)};
    for (int idx = obid() * 8 + w; idx < M; idx += gridDim.x * 8) {
        const int b = idx / L, t = idx % L;
        const int r = rowof(b, t), rprev = rowof(b, t > 0 ? t - 1 : 0);
        const float* hc; const float* hp;
        if (i == 0) {
            hc = r < MMAIN ? P.in[0] + (size_t)r * D : P.in[1] + (size_t)((r - MMAIN) & 15) * D;
            hp = rprev < MMAIN ? P.in[0] + (size_t)rprev * D : P.in[1] + (size_t)((rprev - MMAIN) & 15) * D;
        } else { hc = hrow(P, r); hp = hrow(P, rprev); }
        float* hw = hrow(P, r);
        f32x4 c[8], p[8]; float sc = 0.f, sp = 0.f;
#pragma unroll
        for (int q = 0; q < 8; ++q) { c[q] = *(const f32x4*)(hc + 256 * q + 4 * lane); p[q] = *(const f32x4*)(hp + 256 * q + 4 * lane);
            sc += c[q][0] * c[q][0] + c[q][1] * c[q][1] + c[q][2] * c[q][2] + c[q][3] * c[q][3];
            sp += p[q][0] * p[q][0] + p[q][1] * p[q][1] + p[q][2] * p[q][2] + p[q][3] * p[q][3]; }
        if (i == 0) {
#pragma unroll
            for (int q = 0; q < 8; ++q) *(f32x4*)(hw + 256 * q + 4 * lane) = c[q];
        }
        sc = wavesum(sc); sp = wavesum(sp);
        const float rc = rsqrtf(sc * (1.0f / D) + 1e-6f);
        const float rp = t > 0 ? rsqrtf(sp * (1.0f / D) + 1e-6f) : 0.f;
#pragma unroll
        for (int q = 0; q < 8; ++q) {
            const int col = 256 * q + 4 * lane;
            const f32x4 gv = *(const f32x4*)(g + col);
            f32x4 hn, xx;
#pragma unroll
            for (int e = 0; e < 4; ++e) { hn[e] = c[q][e] * rc * gv[e]; xx[e] = p[q][e] * rp * gv[e] - hn[e]; }
#pragma unroll
            for (int j = 0; j < 6; ++j) {
                const f32x4 m = *(const f32x4*)(mu + j * D + col);
                u32x2 a; a.x = cvt_pk_bf16(hn[0] + xx[0] * m[0], hn[1] + xx[1] * m[1]); a.y = cvt_pk_bf16(hn[2] + xx[2] * m[2], hn[3] + xx[3] * m[3]);
                *(u32x2*)(ob[j] + (size_t)r * D + col) = a;
            }
        }
    }
}

__device__ void norm_phase(const Params& P, const float* g1, bf16_t* o1, const float* g2, bf16_t* o2) {
    const int tid_ = otid(); const int w = tid_ >> 6, lane = tid_ & 63;
    for (int r = obid() * 8 + w; r < M; r += gridDim.x * 8) {
        const float* hc = hrow(P, r);
        f32x4 c[8]; float sc = 0.f;
#pragma unroll
        for (int q = 0; q < 8; ++q) { c[q] = *(const f32x4*)(hc + 256 * q + 4 * lane); sc += c[q][0] * c[q][0] + c[q][1] * c[q][1] + c[q][2] * c[q][2] + c[q][3] * c[q][3]; }
        sc = wavesum(sc);
        const float rc = rsqrtf(sc * (1.0f / D) + 1e-6f);
#pragma unroll
        for (int q = 0; q < 8; ++q) {
            const int col = 256 * q + 4 * lane;
            const f32x4 gv = *(const f32x4*)(g1 + col);
            u32x2 a; a.x = cvt_pk_bf16(c[q][0] * rc * gv[0], c[q][1] * rc * gv[1]); a.y = cvt_pk_bf16(c[q][2] * rc * gv[2], c[q][3] * rc * gv[3]);
            *(u32x2*)(o1 + (size_t)r * D + col) = a;
            if (g2) { const f32x4 g2v = *(const f32x4*)(g2 + col);
                u32x2 bq; bq.x = cvt_pk_bf16(c[q][0] * rc * g2v[0], c[q][1] * rc * g2v[1]); bq.y = cvt_pk_bf16(c[q][2] * rc * g2v[2], c[q][3] * rc * g2v[3]);
                *(u32x2*)(o2 + (size_t)r * D + col) = bq; }
        }
    }
}

__device__ void scan_phase(const Params& P, int i, LAS unsigned char* lds) {
    const int tid = otid(), w = tid >> 6, lane = tid & 63;
    const bf16_t* RB = (const bf16_t*)(P.ws + OFF_RB); const float* KF = (const float*)(P.ws + OFF_KF);
    const float* VF = (const float*)(P.ws + OFF_VF); const float* DEC = (const float*)(P.ws + OFF_DEC);
    const bf16_t* AB = (const bf16_t*)(P.ws + OFF_MIX); bf16_t* YB = (bf16_t*)(P.ws + OFF_MIX + 2 * SZB);
    const float* k_k = P.in[20] + (size_t)i * D; const float* k_a = P.in[21] + (size_t)i * D; const float* r_k = P.in[22] + (size_t)i * D;
    float* SBON = (float*)(P.ws + OFF_LORA);
    LAS float* fl = (LAS float*)lds;
    constexpr int STG = 11264;
    LAS float* ybuf = fl + 2 * STG;
    typedef float f32x2 __attribute__((ext_vector_type(2)));
    const int wu = __builtin_amdgcn_readfirstlane(w);
    const int kg = lane & 15, rp = 4 * (wu & 3) + (lane >> 4);
    const int lt = tid & 255;
    const int lc = (lt & 15) * 4, vt = lt >> 3, vc = (lt & 7) * 4;
    constexpr int NCH = (L + 31) / 32;
    for (int u = obid(); u < 256; u += gridDim.x) {
        const int bh = u >> 1, rh = u & 1, b = bh >> 5, h = bh & 31;
        f32x4 kkp = (f32x4){0.f, 0.f, 0.f, 0.f}, kap = kkp, rkp = kkp;
        f32x4 gk[2], gd[2], gv; u32x2 gr[2], ga[2];
        __syncthreads();
#define SCAN_LOAD(cc) do { _Pragma("unroll") for (int q_ = 0; q_ < 2; ++q_) { const int t_ = 32 * (cc) + (lt >> 4) + 16 * q_; \
              gk[q_] = (f32x4){0.f, 0.f, 0.f, 0.f}; gd[q_] = gk[q_]; gr[q_] = (u32x2){0u, 0u}; ga[q_] = gr[q_]; \
              if (t_ < L) { const size_t o_ = (size_t)rowof(b, t_) * D + 64 * h + lc; gk[q_] = *(const f32x4*)(KF + o_); gd[q_] = *(const f32x4*)(DEC + o_); gr[q_] = *(const u32x2*)(RB + o_); ga[q_] = *(const u32x2*)(AB + o_); } } \
            { const int tv_ = 32 * (cc) + vt; gv = (f32x4){0.f, 0.f, 0.f, 0.f}; if (tv_ < L) gv = *(const f32x4*)(VF + (size_t)rowof(b, tv_) * D + 64 * h + 32 * rh + vc); } } while (0)
#define SCAN_STORE(st, cc) do { LAS float* s_ = fl + (st) * STG; _Pragma("unroll") for (int q_ = 0; q_ < 2; ++q_) { const int o_ = ((lt >> 4) + 16 * q_) * 64 + lc; \
              f32x4 kr_ = gk[q_] * kkp; float ss_ = kr_[0] * kr_[0] + kr_[1] * kr_[1] + kr_[2] * kr_[2] + kr_[3] * kr_[3]; ss_ = rowsum16(ss_); \
              const float inv_ = rsqrtf(fmaxf(ss_, 1e-24f)); \
              f32x4 av_; av_[0] = bf_lo(ga[q_].x); av_[1] = bf_hi(ga[q_].x); av_[2] = bf_lo(ga[q_].y); av_[3] = bf_hi(ga[q_].y); \
              f32x4 rv_; rv_[0] = bf_lo(gr[q_].x); rv_[1] = bf_hi(gr[q_].x); rv_[2] = bf_lo(gr[q_].y); rv_[3] = bf_hi(gr[q_].y); \
              const f32x4 kk_ = kr_ * inv_; f32x4 kp_; \
              for (int e_ = 0; e_ < 4; ++e_) kp_[e_] = gk[q_][e_] * (1.0f + (av_[e_] - 1.0f) * kap[e_]); \
              *(LAS f32x4*)(s_ + o_) = rv_; *(LAS f32x4*)(s_ + 2048 + o_) = gd[q_]; *(LAS f32x4*)(s_ + 4096 + o_) = kp_; \
              *(LAS f32x4*)(s_ + 6144 + o_) = kk_; *(LAS f32x4*)(s_ + 8192 + o_) = kk_ * av_; \
              float sb_ = rv_[0] * kp_[0] * rkp[0] + rv_[1] * kp_[1] * rkp[1] + rv_[2] * kp_[2] * rkp[2] + rv_[3] * kp_[3] * rkp[3]; sb_ = rowsum16(sb_); \
              { const int tb_ = 32 * (cc) + (lt >> 4) + 16 * q_; if (rh == 0 && (lt & 15) == 0 && tb_ < L) SBON[(size_t)rowof(b, tb_) * 32 + h] = sb_; } } \
            *(LAS f32x4*)(s_ + 10240 + vt * 32 + vc) = gv; } while (0)
#define SCAN_FLUSH(cc) do { const LAS float* yb_ = ybuf + ((cc) & 1) * 1024; _Pragma("unroll") for (int q_ = 0; q_ < 2; ++q_) { const int ft_ = (lt >> 4) + 16 * q_, fv_ = (lt & 15) * 2; const int tt_ = 32 * (cc) + ft_; \
              if (tt_ < L) { const unsigned pk_ = cvt_pk_bf16(yb_[ft_ * 32 + fv_], yb_[ft_ * 32 + fv_ + 1]); *(unsigned*)(YB + (size_t)rowof(b, tt_) * D + 64 * h + 32 * rh + fv_) = pk_; } } } while (0)
        if (wu >= 4) {
            kkp = *(const f32x4*)(k_k + 64 * h + lc); kap = *(const f32x4*)(k_a + 64 * h + lc); rkp = *(const f32x4*)(r_k + 64 * h + lc);
            SCAN_LOAD(0); SCAN_STORE(0, 0);
            SCAN_LOAD(1);
        }
        __syncthreads();
        f32x2 SA01 = {0.f, 0.f}, SA23 = SA01, SB01 = SA01, SB23 = SA01;
        for (int c = 0; c < NCH; ++c) {
            if (wu < 4) {
                const LAS float* s = fl + (c & 1) * STG;
                LAS float* yb = ybuf + (c & 1) * 1024;
                const int ns = (L - 32 * c) < 32 ? (L - 32 * c) : 32;
                for (int tb = 0; tb < ns; tb += 16) {
                    float ykA = 0.f, ykB = 0.f;
#pragma unroll
                    for (int j = 0; j < 16; ++j) {
                        const int t = tb + j;
                        const int o = t * 64 + 4 * kg;
                        const f32x4 r4 = *(const LAS f32x4*)(s + o), d4 = *(const LAS f32x4*)(s + 2048 + o), kp4 = *(const LAS f32x4*)(s + 4096 + o);
                        const f32x4 kk4 = *(const LAS f32x4*)(s + 6144 + o), ka4 = *(const LAS f32x4*)(s + 8192 + o);
                        const f32x2 vv = *(const LAS f32x2*)(s + 10240 + t * 32 + 2 * rp);
                        const f32x2 kk01 = {kk4[0], kk4[1]}, kk23 = {kk4[2], kk4[3]}, ka01 = {ka4[0], ka4[1]}, ka23 = {ka4[2], ka4[3]};
                        const f32x2 kp01 = {kp4[0], kp4[1]}, kp23 = {kp4[2], kp4[3]}, d01 = {d4[0], d4[1]}, d23 = {d4[2], d4[3]}, r01 = {r4[0], r4[1]}, r23 = {r4[2], r4[3]};
                        f32x2 pA = SA01 * kk01; pA = SA23 * kk23 + pA;
                        f32x2 pB = SB01 * kk01; pB = SB23 * kk23 + pB;
                        const float saA = -rowsum16(pA.x + pA.y), saB = -rowsum16(pB.x + pB.y);
                        f32x2 tA01 = kp01 * vv.x, tA23 = kp23 * vv.x, tB01 = kp01 * vv.y, tB23 = kp23 * vv.y;
                        tA01 = ka01 * saA + tA01; tA23 = ka23 * saA + tA23; tB01 = ka01 * saB + tB01; tB23 = ka23 * saB + tB23;
                        SA01 = SA01 * d01 + tA01; SA23 = SA23 * d23 + tA23; SB01 = SB01 * d01 + tB01; SB23 = SB23 * d23 + tB23;
                        f32x2 qA = SA01 * r01; qA = SA23 * r23 + qA;
                        f32x2 qB = SB01 * r01; qB = SB23 * r23 + qB;
                        const float yA = rowsum16(qA.x + qA.y), yB = rowsum16(qB.x + qB.y);
                        ykA = (kg == j) ? yA : ykA; ykB = (kg == j) ? yB : ykB;
                    }
                    { f32x2 yy = {ykA, ykB}; *(LAS f32x2*)(yb + (tb + kg) * 32 + 2 * rp) = yy; }
                }
            } else {
                if (c + 1 < NCH) SCAN_STORE((c + 1) & 1, c + 1);
                if (c + 2 < NCH) SCAN_LOAD(c + 2);
                if (c >= 1) SCAN_FLUSH(c - 1);
            }
            __syncthreads();
        }
        if (wu >= 4) SCAN_FLUSH(NCH - 1);
#undef SCAN_LOAD
#undef SCAN_STORE
#undef SCAN_FLUSH
    }
}

__device__ void post_phase(const Params& P, int i) {
    const int tid_ = otid(); const int w = tid_ >> 6, lane = tid_ & 63;
    const float* VF = (const float*)(P.ws + OFF_VF); const float* SBON = (const float*)(P.ws + OFF_LORA);
    const bf16_t* GB = (const bf16_t*)(P.ws + OFF_MIX + SZB); bf16_t* YB = (bf16_t*)(P.ws + OFF_MIX + 2 * SZB);
    const float* gn_w = P.in[23] + (size_t)i * D; const float* gn_b = P.in[24] + (size_t)i * D;
    for (int r = obid() * 8 + w; r < M; r += gridDim.x * 8) {
#pragma unroll
        for (int q = 0; q < 8; ++q) {
            const int col = 256 * q + 4 * lane; const size_t o = (size_t)r * D + col;
            const u32x2 yv = *(const u32x2*)(YB + o), gv = *(const u32x2*)(GB + o);
            const f32x4 vv = *(const f32x4*)(VF + o);
            const float sb = SBON[(size_t)r * 32 + 4 * q + (lane >> 4)];
            const f32x4 gw = *(const f32x4*)(gn_w + col), gb = *(const f32x4*)(gn_b + col);
            float y[4] = {bf_lo(yv.x), bf_hi(yv.x), bf_lo(yv.y), bf_hi(yv.y)};
            const float gg[4] = {bf_lo(gv.x), bf_hi(gv.x), bf_lo(gv.y), bf_hi(gv.y)};
            float sy = (y[0] + y[1]) + (y[2] + y[3]);
            sy = rowsum16(sy);
            const float mean = sy * (1.0f / 64.0f);
            float sv = 0.f;
#pragma unroll
            for (int e = 0; e < 4; ++e) { y[e] -= mean; sv += y[e] * y[e]; }
            sv = rowsum16(sv);
            const float rstd = rsqrtf(sv * (1.0f / 64.0f) + 64e-5f);
            float z[4];
#pragma unroll
            for (int e = 0; e < 4; ++e) z[e] = (y[e] * rstd * gw[e] + gb[e] + sb * vv[e]) * gg[e];
            u32x2 zo; zo.x = cvt_pk_bf16(z[0], z[1]); zo.y = cvt_pk_bf16(z[2], z[3]);
            *(u32x2*)(YB + o) = zo;
        }
    }
}

__device__ void headnorm_phase(const Params& P, LAS unsigned char* lds) {
    const int tid = otid(), w = tid >> 6, lane = tid & 63;
    const float* KR = (const float*)(P.ws + OFF_KF); const float* VR = (const float*)(P.ws + OFF_VF);
    bf16_t* KN = (bf16_t*)(P.ws + OFF_MIX + 2 * SZB); bf16_t* VT = (bf16_t*)(P.ws + OFF_DEC);
    const float* kg = P.in[31];
    for (int r = obid() * 8 + w; r < M; r += gridDim.x * 8) {
#pragma unroll
        for (int q = 0; q < 8; ++q) {
            const int col = 256 * q + 4 * lane; const size_t o = (size_t)r * D + col;
            const f32x4 kv = *(const f32x4*)(KR + o);
            float ss = kv[0] * kv[0] + kv[1] * kv[1] + kv[2] * kv[2] + kv[3] * kv[3];
            ss = rowsum16(ss); ss += __shfl_xor(ss, 16);
            const float rs = rsqrtf(ss * (1.0f / 128.0f) + 1e-6f);
            const f32x4 gv = *(const f32x4*)(kg + (col & 127));
            u32x2 a; a.x = cvt_pk_bf16(kv[0] * rs * gv[0], kv[1] * rs * gv[1]); a.y = cvt_pk_bf16(kv[2] * rs * gv[2], kv[3] * rs * gv[3]);
            *(u32x2*)(KN + o) = a;
        }
    }
    LAS float* tile = (LAS float*)lds;
    for (int it = obid(); it < NBATCH * 66 * 16; it += gridDim.x) {
        const int h = it & 15, pt = (it >> 4) % 66, b = it / (16 * 66);
        __syncthreads();
#pragma unroll
        for (int pass = 0; pass < 4; ++pass) {
            const int key = (tid >> 5) + pass * 16, c4 = (tid & 31) * 4;
            const int t = 64 * pt + key - PPAD;
            f32x4 v = (f32x4){0.f, 0.f, 0.f, 0.f};
            if (t >= 0) v = *(const f32x4*)(VR + (size_t)rowof(b, t) * D + 128 * h + c4);
            tile[key * 129 + c4] = v[0]; tile[key * 129 + c4 + 1] = v[1]; tile[key * 129 + c4 + 2] = v[2]; tile[key * 129 + c4 + 3] = v[3];
        }
        __syncthreads();
        const int d = tid >> 2, k16 = (tid & 3) * 16;
        float e[16];
#pragma unroll
        for (int x = 0; x < 16; ++x) e[x] = tile[(k16 + x) * 129 + d];
        u32x4 o0, o1;
        o0.x = cvt_pk_bf16(e[0], e[1]); o0.y = cvt_pk_bf16(e[2], e[3]); o0.z = cvt_pk_bf16(e[4], e[5]); o0.w = cvt_pk_bf16(e[6], e[7]);
        o1.x = cvt_pk_bf16(e[8], e[9]); o1.y = cvt_pk_bf16(e[10], e[11]); o1.z = cvt_pk_bf16(e[12], e[13]); o1.w = cvt_pk_bf16(e[14], e[15]);
        bf16_t* dst = VT + ((size_t)((b * 16 + h) * 128 + d)) * PLEN + 64 * pt + k16;
        *(u32x4*)dst = o0; *(u32x4*)(dst + 8) = o1;
    }
}

__device__ void attn_phase(const Params& P, int j, LAS unsigned char* lds) {
    const int tid = otid(), w = tid >> 6, lane = tid & 63, fr = lane & 15, fq = lane >> 4;
    const float* QF = (const float*)(P.ws + OFF_RB);
    const bf16_t* KN = (const bf16_t*)(P.ws + OFF_MIX + 2 * SZB);
    const bf16_t* VT = (const bf16_t*)(P.ws + OFF_DEC);
    bf16_t* OB = (bf16_t*)(P.ws + OFF_MIX);
    const float* qg = P.in[33] + j * 128;
    constexpr int KSTR = 272, VSTR = 144, KBYTES = 64 * KSTR, VBYTES = 128 * VSTR, STGB = KBYTES + VBYTES;
    for (int u = obid(); u < 64 * 33; u += gridDim.x) {
        const int qb = 32 - u / 64, bh = u % 64, b = bh >> 4, h = bh & 15;
        const int pq = 128 * qb + 16 * w + fr, tq = pq - PPAD;
        const int qrow = rowof(b, tq > 0 ? tq : 0);
        bf16x8 qf[4];
        {
            const float* qp = QF + (size_t)qrow * D + 128 * h + 8 * fq;
            f32x4 qa[4], qc[4]; float ss = 0.f;
#pragma unroll
            for (int s = 0; s < 4; ++s) { qa[s] = *(const f32x4*)(qp + 32 * s); qc[s] = *(const f32x4*)(qp + 32 * s + 4);
                ss += qa[s][0] * qa[s][0] + qa[s][1] * qa[s][1] + qa[s][2] * qa[s][2] + qa[s][3] * qa[s][3] + qc[s][0] * qc[s][0] + qc[s][1] * qc[s][1] + qc[s][2] * qc[s][2] + qc[s][3] * qc[s][3]; }
            ss += __shfl_xor(ss, 16); ss += __shfl_xor(ss, 32);
            const float rs = rsqrtf(ss * (1.0f / 128.0f) + 1e-6f) * 0.08838834764831845f;
#pragma unroll
            for (int s = 0; s < 4; ++s) {
                const f32x4 g0 = *(const f32x4*)(qg + 32 * s + 8 * fq), g1 = *(const f32x4*)(qg + 32 * s + 8 * fq + 4);
                u32x4 pk; pk.x = cvt_pk_bf16(qa[s][0] * rs * g0[0], qa[s][1] * rs * g0[1]); pk.y = cvt_pk_bf16(qa[s][2] * rs * g0[2], qa[s][3] * rs * g0[3]);
                pk.z = cvt_pk_bf16(qc[s][0] * rs * g1[0], qc[s][1] * rs * g1[1]); pk.w = cvt_pk_bf16(qc[s][2] * rs * g1[2], qc[s][3] * rs * g1[3]);
                qf[s] = __builtin_bit_cast(bf16x8, pk);
            }
        }
        f32x4 oacc[8];
#pragma unroll
        for (int x = 0; x < 8; ++x) oacc[x] = (f32x4){0.f, 0.f, 0.f, 0.f};
        float carry = 1.0f;
        u32x4 kr[2], vr[2];
#define ATT_LOAD(kt_) do { _Pragma("unroll") for (int i_ = 0; i_ < 2; ++i_) { const int id_ = tid + 512 * i_; \
            { const int row_ = id_ >> 4, c_ = id_ & 15; const int tk_ = 64 * (kt_) + row_ - PPAD; \
              kr[i_] = *(const u32x4*)(KN + (size_t)rowof(b, tk_ > 0 ? tk_ : 0) * D + 128 * h + 8 * c_); } \
            { const int d_ = id_ >> 3, c_ = id_ & 7; vr[i_] = *(const u32x4*)(VT + ((size_t)(bh * 128 + d_)) * PLEN + 64 * (kt_) + 8 * c_); } } } while (0)
#define ATT_WRITE(st_) do { _Pragma("unroll") for (int i_ = 0; i_ < 2; ++i_) { const int id_ = tid + 512 * i_; \
            *(LAS u32x4*)(lds + (st_) * STGB + (id_ >> 4) * KSTR + 16 * (id_ & 15)) = kr[i_]; \
            *(LAS u32x4*)(lds + (st_) * STGB + KBYTES + (id_ >> 3) * VSTR + 16 * (id_ & 7)) = vr[i_]; } } while (0)
        const int nti = 2 * qb + 1;
        __syncthreads();
        ATT_LOAD(nti); ATT_WRITE(0);
        __syncthreads();
        for (int it = 0; it < nti; ++it) {
            const int kt = nti - it;
            if (it + 1 < nti) ATT_LOAD(kt - 1);
            const LAS unsigned char* Ks = lds + (it & 1) * STGB; const LAS unsigned char* Vs = Ks + KBYTES;
            f32x4 st[4];
#pragma unroll
            for (int n = 0; n < 4; ++n) { st[n] = (f32x4){0.f, 0.f, 0.f, 0.f};
#pragma unroll
                for (int s = 0; s < 4; ++s) { const bf16x8 a = *(const LAS bf16x8*)(Ks + (16 * n + fr) * KSTR + 64 * s + 16 * fq);
                    st[n] = __builtin_amdgcn_mfma_f32_16x16x32_bf16(a, qf[s], st[n], 0, 0, 0); } }
            const bool need_mask = (kt >= 2 * qb) || (kt == 1);
            float kp[4][4], sg[4][4];
#pragma unroll
            for (int n = 0; n < 4; ++n)
#pragma unroll
                for (int e = 0; e < 4; ++e) { const float z = st[n][e]; const float ex = __expf(-fabsf(z)); const float r = __builtin_amdgcn_rcpf(1.0f + ex);
                    const bool pos = z >= 0.f; sg[n][e] = (pos ? 1.0f : ex) * r; kp[n][e] = (pos ? ex : 1.0f) * r; }
            if (need_mask) {
#pragma unroll
                for (int n = 0; n < 4; ++n)
#pragma unroll
                    for (int e = 0; e < 4; ++e) { const int pk = 64 * kt + 16 * n + 4 * fq + e; const bool valid = (pk < pq) && (pk >= PPAD);
                        if (!valid) { kp[n][e] = 1.0f; sg[n][e] = 0.f; } }
            }
            float X[4], Bt[4];
            {
                LAS f32x4* xch = (LAS f32x4*)(lds + 2 * STGB) + w * 64;
                f32x4 Tv;
#pragma unroll
                for (int n = 0; n < 4; ++n) Tv[n] = (kp[n][0] * kp[n][1]) * (kp[n][2] * kp[n][3]);
                xch[lane] = Tv;
                const f32x4 t0 = xch[fr], t1 = xch[fr + 16], t2 = xch[fr + 32], t3 = xch[fr + 48];
#pragma unroll
                for (int n = 0; n < 4; ++n) {
                    X[n] = (fq < 1 ? t1[n] : 1.0f) * (fq < 2 ? t2[n] : 1.0f) * (fq < 3 ? t3[n] : 1.0f);
                    Bt[n] = (t0[n] * t1[n]) * (t2[n] * t3[n]);
                }
            }
            float wgt[4][4]; float run = carry;
#pragma unroll
            for (int n = 3; n >= 0; --n) { const float s3 = run * X[n]; const float s2 = s3 * kp[n][3]; const float s1 = s2 * kp[n][2]; const float s0 = s1 * kp[n][1];
                wgt[n][3] = sg[n][3] * s3; wgt[n][2] = sg[n][2] * s2; wgt[n][1] = sg[n][1] * s1; wgt[n][0] = sg[n][0] * s0;
                run *= Bt[n]; }
            carry = run;
#pragma unroll
            for (int s2 = 0; s2 < 2; ++s2) {
                u32x4 pk; pk.x = cvt_pk_bf16(wgt[2 * s2][0], wgt[2 * s2][1]); pk.y = cvt_pk_bf16(wgt[2 * s2][2], wgt[2 * s2][3]);
                pk.z = cvt_pk_bf16(wgt[2 * s2 + 1][0], wgt[2 * s2 + 1][1]); pk.w = cvt_pk_bf16(wgt[2 * s2 + 1][2], wgt[2 * s2 + 1][3]);
                const bf16x8 pf = __builtin_bit_cast(bf16x8, pk);
#pragma unroll
                for (int db = 0; db < 8; ++db) {
                    const LAS unsigned char* vp = Vs + (16 * db + fr) * VSTR + 64 * s2 + 8 * fq;
                    const u32x2 v0 = *(const LAS u32x2*)vp, v1 = *(const LAS u32x2*)(vp + 32);
                    u32x4 vv; vv.x = v0.x; vv.y = v0.y; vv.z = v1.x; vv.w = v1.y;
                    oacc[db] = __builtin_amdgcn_mfma_f32_16x16x32_bf16(__builtin_bit_cast(bf16x8, vv), pf, oacc[db], 0, 0, 0);
                }
            }
            if (it + 1 < nti) ATT_WRITE((it + 1) & 1);
#ifndef NO_EARLY_EXIT
            LAS int* flg = (LAS int*)(lds + 2 * STGB + 8192) + (it & 1) * 8;
            { const int dead = __all(carry == 0.f); if (lane == 0) flg[w] = dead; }
            __syncthreads();
            { int alld = 1;
#pragma unroll
              for (int x = 0; x < 8; ++x) alld &= flg[x];
              if (alld) break; }
#else
            __syncthreads();
#endif
        }
#undef ATT_LOAD
#undef ATT_WRITE
        if (tq >= 0) {
#pragma unroll
            for (int db = 0; db < 8; ++db) { u32x2 o; o.x = cvt_pk_bf16(oacc[db][0], oacc[db][1]); o.y = cvt_pk_bf16(oacc[db][2], oacc[db][3]);
                *(u32x2*)(OB + (size_t)qrow * D + 128 * h + 16 * db + 4 * fq) = o; }
        }
    }
}

#define XB_TMO      128
#define XB_XCNT(j)  (256  + 64 * (j))
#define XB_XSUB(j)  (1280 + 64 * (j))
#define XB_XGEN(j)  (2304 + 64 * (j))
#define XB_TOP      3328
#define XB_TOPGEN   3392
#define XCD_BAR_WORDS 3456
#define XB_SPIN_CAP (1u << 18)

__device__ __forceinline__ unsigned xb_ld(unsigned* p)              { return __hip_atomic_load(p, __ATOMIC_RELAXED, __HIP_MEMORY_SCOPE_AGENT); }
__device__ __forceinline__ unsigned xb_add(unsigned* p, unsigned v) { return __hip_atomic_fetch_add(p, v, __ATOMIC_RELAXED, __HIP_MEMORY_SCOPE_AGENT); }
__device__ __forceinline__ unsigned xb_xcc_id() { return (unsigned)__builtin_amdgcn_s_getreg((3 << 11) | 20) & 0xFu; }
#define XB_SPIN(cond, bar) do { unsigned _sp = 0; while (cond) { __builtin_amdgcn_s_sleep(1); \
    if ((++_sp & 255u) == 0u) { if (xb_ld(&(bar)[XB_TMO])) break; if (_sp > XB_SPIN_CAP) { atomicAdd(&(bar)[XB_TMO], 1u); break; } } } } while (0)

struct XcdBarrier {
    unsigned* bar; unsigned x;
    volatile LAS unsigned* st;
};

__device__ __forceinline__ XcdBarrier xcd_barrier_post(unsigned* bar, volatile LAS unsigned* st) {
    XcdBarrier b; b.bar = bar; b.x = xb_xcc_id(); b.st = st;
    if (threadIdx.x == 0) (void)xb_add(&bar[XB_XCNT(b.x)], 1u);
    return b;
}
__device__ __forceinline__ void xcd_barrier_complete(unsigned* bar, unsigned x, unsigned& nloc, unsigned& nx) {
    const unsigned G = gridDim.x * gridDim.y * gridDim.z;
    unsigned sum, cnt, mine, sp = 0u;
    for (;;) {
        sum = 0u; cnt = 0u; mine = 0u;
#pragma unroll
        for (unsigned j = 0; j < 16; ++j) { const unsigned c = xb_ld(&bar[XB_XCNT(j)]); sum += c; cnt += (c > 0u) ? 1u : 0u; mine = (j == x) ? c : mine; }
        if (sum == G) break;
        __builtin_amdgcn_s_sleep(1);
        if ((++sp & 255u) == 0u) { if (xb_ld(&bar[XB_TMO])) break; if (sp > XB_SPIN_CAP) { atomicAdd(&bar[XB_TMO], 1u); break; } }
    }
    nloc = mine > 0u ? mine : 1u; nx = cnt > 0u ? cnt : 1u;
}

__device__ __forceinline__ void xcd_barrier(const XcdBarrier& b) {
    asm volatile("s_waitcnt vmcnt(0)" ::: "memory");
    __syncthreads();
    if (threadIdx.x == 0) {
        unsigned* bar = b.bar;
        __builtin_amdgcn_s_waitcnt(0);
        unsigned nloc = b.st[0], nx = b.st[1];
        if (nloc == 0u) { xcd_barrier_complete(bar, b.x, nloc, nx); b.st[0] = nloc; b.st[1] = nx; }
        const unsigned old = xb_add(&bar[XB_XSUB(b.x)], 1u);
        const unsigned gen = old / nloc;
        if (old + 1u == (gen + 1u) * nloc) {
            __builtin_amdgcn_fence(__ATOMIC_RELEASE, "agent");
            asm volatile("s_waitcnt vmcnt(0)" ::: "memory");
            const unsigned og = xb_add(&bar[XB_TOP], 1u);
            const unsigned tg = og / nx;
            if (og + 1u == (tg + 1u) * nx) xb_add(&bar[XB_TOPGEN], 1u);
            else XB_SPIN(xb_ld(&bar[XB_TOPGEN]) == tg, bar);
            __builtin_amdgcn_fence(__ATOMIC_ACQUIRE, "agent");
            xb_add(&bar[XB_XGEN(b.x)], 1u);
            asm volatile("s_waitcnt vmcnt(0)" ::: "memory");
        } else {
            XB_SPIN(xb_ld(&bar[XB_XGEN(b.x)]) == gen, bar);
            __builtin_amdgcn_fence(__ATOMIC_ACQUIRE, "agent");
            asm volatile("s_waitcnt vmcnt(0)" ::: "memory");
        }
    }
    __syncthreads();
}


__device__ __forceinline__ void grid_barrier(unsigned* ctr, unsigned target) {
    asm volatile("s_waitcnt vmcnt(0) lgkmcnt(0)" ::: "memory");
    __syncthreads();
    if (threadIdx.x == 0) {
        __builtin_amdgcn_fence(__ATOMIC_RELEASE, "agent");
        asm volatile("s_waitcnt vmcnt(0)" ::: "memory");
        __hip_atomic_fetch_add(ctr, 1u, __ATOMIC_RELAXED, __HIP_MEMORY_SCOPE_AGENT);
        while (__hip_atomic_load(ctr, __ATOMIC_RELAXED, __HIP_MEMORY_SCOPE_AGENT) < target) __builtin_amdgcn_s_sleep(2);
        __builtin_amdgcn_fence(__ATOMIC_ACQUIRE, "agent");
        asm volatile("s_waitcnt vmcnt(0)" ::: "memory");
    }
    __syncthreads();
}

#ifndef DUP_ATTN
#define DUP_ATTN 0
#endif
#ifndef DUP_FFN1
#define DUP_FFN1 0
#endif
#ifndef DUP_SCAN
#define DUP_SCAN 0
#endif
constexpr int NPHASE = 35 + 2 * DUP_ATTN + 4 * DUP_FFN1 + 2 * DUP_SCAN;
enum { K_INIT = 0, K_MIXPREP, K_GEMM, K_SCAN, K_POST, K_NORMF, K_NORMSB, K_HEADNORM, K_ATTN };
struct Tab { PE e[NPHASE]; };
constexpr GD mkgd(size_t A, size_t Bt, int N, int mode, size_t o0, size_t o1, int bin, int boff, int ldo) {
    GD g{}; g.A = A; g.Bt = Bt; g.o0 = o0; g.o1 = o1; g.N = N; g.mode = mode; g.bin = bin; g.boff = boff; g.ldo = ldo; g.pad = 0; return g;
}
constexpr PE mkgemm(int layer, int sub) {
    PE p{}; p.kind = K_GEMM; p.layer = layer; p.sub = sub; p.ng = 1; p.K = D; p.pad = 0;
    const int i = layer;
    for (int q = 0; q < 4; ++q) p.g[q] = mkgd(0, 0, 256, 0, 0, 0, 0, 0, D);
    if (sub == 0) {
        p.g[0] = mkgd(OFF_MIX, OFF_WA + WA_W0, D, 0, OFF_RB, 0, 0, 0, D);
        p.g[1] = mkgd(OFF_MIX + SZB, OFF_WA + WA_W1, D, 1, OFF_KF, 0, 0, 0, D);
        p.g[2] = mkgd(OFF_MIX + 2 * SZB, OFF_WA + WA_W2, D, i == 0 ? 2 : 1, OFF_VF, OFF_VFIRST, 0, 0, D);
        p.ng = 3;
    } else if (sub == 1) {
        p.g[0] = mkgd(OFF_DEC, OFF_WA + WA_L1 + 0 * WSLOT, 256, 3, OFF_LORA + 0 * SZLORA, 0, 0, 0, 256);
        p.g[1] = mkgd(OFF_DEC + SZB, OFF_WA + WA_L1 + 1 * WSLOT, 256, 0, OFF_LORA + 1 * SZLORA, 0, 0, 0, 256);
        p.g[2] = mkgd(OFF_KF, OFF_WA + WA_L1 + 2 * WSLOT, 256, 4, OFF_LORA + 2 * SZLORA, 0, 0, 0, 256);
        p.ng = 3;
        if (i >= 1) { p.g[3] = mkgd(OFF_MIX + 2 * SZB, OFF_WA + WA_L1 + 3 * WSLOT, 256, 0, OFF_LORA + 3 * SZLORA, 0, 0, 0, 256); p.ng = 4; }
    } else if (sub == 2) {
        p.K = 256;
        p.g[0] = mkgd(OFF_LORA + 0 * SZLORA, OFF_WA + WA_L2 + 0 * WSLOT, D, 5, OFF_DEC, 0, 12, i * D, D);
        p.g[1] = mkgd(OFF_LORA + 1 * SZLORA, OFF_WA + WA_L2 + 1 * WSLOT, D, 6, OFF_MIX, 0, 15, i * D, D);
        p.g[2] = mkgd(OFF_LORA + 2 * SZLORA, OFF_WA + WA_L2 + 2 * WSLOT, D, 0, OFF_MIX + SZB, 0, 0, 0, D);
        p.ng = 3;
        if (i >= 1) { p.g[3] = mkgd(OFF_LORA + 3 * SZLORA, OFF_WA + WA_L2 + 3 * WSLOT, D, 7, OFF_VF, OFF_VFIRST, 25, (i - 1) * D, D); p.ng = 4; }
    } else if (sub == 3) {
        p.g[0] = mkgd(OFF_MIX + 2 * SZB, OFF_WB + WB_WO, D, 8, 0, 0, 0, 0, D);
    } else if (sub == 4) {
        p.g[0] = mkgd(OFF_HN2, OFF_WB + WB_F1, 2 * FF, 9, OFF_ACT, 0, 0, 0, FF);
    } else if (sub == 5) {
        p.K = FF;
        p.g[0] = mkgd(OFF_ACT, OFF_WB + WB_F2, D, 8, 0, 0, 0, 0, D);
    } else if (sub == 6) {
        p.g[0] = mkgd(OFF_MIX, OFF_WA + WA_W0, D, 1, OFF_RB, 0, 0, 0, D);
        if (layer == 2) {
            p.g[1] = mkgd(OFF_MIX + SZB, OFF_WA + WA_W1, D, 1, OFF_KF, 0, 0, 0, D);
            p.g[2] = mkgd(OFF_MIX + SZB, OFF_WA + WA_W2, D, 1, OFF_VF, 0, 0, 0, D);
            p.ng = 3;
        }
    } else {
        p.g[0] = mkgd(OFF_MIX, OFF_WB + WB_WO, D, 8, 0, 0, 0, 0, D);
    }
    return p;
}
constexpr PE mkother(int kind, int layer, int sub) { PE p{}; p.kind = kind; p.layer = layer; p.sub = sub; p.ng = 0; p.K = D; p.pad = 0; for (int q = 0; q < 4; ++q) p.g[q] = mkgd(0, 0, 256, 0, 0, 0, 0, 0, D); return p; }
constexpr Tab make_tab() {
    Tab t{};
    int n = 0;
    for (int i = 0; i < 2; ++i) {
        t.e[n++] = mkother(K_MIXPREP, i, 0);
        t.e[n++] = mkgemm(i, 1);
        t.e[n++] = mkgemm(i, 0);
        t.e[n++] = mkgemm(i, 2);
        t.e[n++] = mkother(K_SCAN, i, 0);
        if (DUP_SCAN) t.e[n++] = mkother(K_SCAN, i, 0);
        t.e[n++] = mkother(K_POST, i, 0);
        t.e[n++] = mkgemm(i, 3);
        t.e[n++] = mkother(K_NORMF, i, 0);
        t.e[n++] = mkgemm(i, 4);
        if (DUP_FFN1) t.e[n++] = mkgemm(i, 4);
        t.e[n++] = mkgemm(i, 5);
    }
    for (int j = 0; j < 2; ++j) {
        const int layer = 2 + j;
        t.e[n++] = mkother(K_NORMSB, layer, 0);
        t.e[n++] = mkgemm(layer, 6);
        if (j == 0) t.e[n++] = mkother(K_HEADNORM, layer, 0);
        t.e[n++] = mkother(K_ATTN, layer, 0);
        if (DUP_ATTN) t.e[n++] = mkother(K_ATTN, layer, 0);
        t.e[n++] = mkgemm(layer, 7);
        t.e[n++] = mkother(K_NORMF, layer, 0);
        t.e[n++] = mkgemm(layer, 4);
        if (DUP_FFN1) t.e[n++] = mkgemm(layer, 4);
        t.e[n++] = mkgemm(layer, 5);
    }
    return t;
}
__constant__ const Tab TAB = make_tab();

#ifndef ONLY
#define ONLY -1
#endif
#define EN(k) (ONLY < 0 || ONLY == (k))

__global__ void __launch_bounds__(512, 2) mk_forward(Params P, int ph_lo, int ph_hi) {
    extern __shared__ __attribute__((aligned(16))) unsigned char shm[];
    LAS unsigned char* lds = (LAS unsigned char*)shm;
    cg::grid_group grid = cg::this_grid();
    __shared__ uint4 xb_words;
    if (threadIdx.x == 0) xb_words = make_uint4(0u, 0u, 0u, 0u);
    unsigned* const xbar = (unsigned*)(P.ws + WS_END);
    XcdBarrier xb; xb.bar = xbar; xb.x = 0; xb.st = (volatile LAS unsigned*)&xb_words;
    for (int ph = ph_lo; ph < ph_hi; ++ph) {
        const PE* pe = &TAB.e[ph];
        const int kind = pe->kind, layer = pe->layer, sub = pe->sub;
        if (kind == K_GEMM) { if (EN(K_GEMM)) {
            const bool tail_first = (blockIdx.x & 1) != 0;
            if (tail_first) { tail_gemm(lds, pe, P); __syncthreads(); }
            gemm_phase(lds, pe, P);
            if (!tail_first) tail_gemm(lds, pe, P); } }
        else if (!EN(kind)) {}
        else if (kind == K_MIXPREP) { mixprep_phase(P, layer); convert_layer(P, layer, lds); }
        else if (kind == K_SCAN) scan_phase(P, layer, lds);
        else if (kind == K_POST) post_phase(P, layer);
        else if (kind == K_NORMF) norm_phase(P, P.in[3] + (size_t)layer * D, (bf16_t*)(P.ws + OFF_HN2), nullptr, nullptr);
        else if (kind == K_NORMSB) {
            norm_phase(P, P.in[2] + (size_t)layer * D, (bf16_t*)(P.ws + OFF_MIX), layer == 2 ? P.in[28] : nullptr, (bf16_t*)(P.ws + OFF_MIX + SZB));
            convert_layer(P, layer, lds);
        }
        else if (kind == K_HEADNORM) { if (layer == 2) headnorm_phase(P, lds); }
        else if (kind == K_ATTN) attn_phase(P, layer - 2, lds);
        if (ph + 1 < ph_hi) {
#ifdef USE_CG_SYNC
            grid.sync();
#else
            if (ph == ph_lo) {
                if (blockIdx.x == 0) for (int q = threadIdx.x; q < XCD_BAR_WORDS; q += NTHR) __hip_atomic_store(xbar + q, 0u, __ATOMIC_RELAXED, __HIP_MEMORY_SCOPE_AGENT);
                grid.sync();
                xb = xcd_barrier_post(xbar, (volatile LAS unsigned*)&xb_words);
            }
            else xcd_barrier(xb);
#endif
        }
    }
}

__global__ void dbg_copy(Params P, size_t off_bf16a, size_t off_bf16b, size_t off_f32) {
    const size_t n = (size_t)MMAIN * D;
    for (size_t i = (size_t)blockIdx.x * blockDim.x + threadIdx.x; i < n; i += (size_t)gridDim.x * blockDim.x) {
        float v = 0.f;
        if (off_bf16a) v += __uint_as_float(((unsigned)((const bf16_t*)(P.ws + off_bf16a))[i]) << 16);
        if (off_bf16b) v += __uint_as_float(((unsigned)((const bf16_t*)(P.ws + off_bf16b))[i]) << 16);
        if (off_f32) v += ((const float*)(P.ws + off_f32))[i];
        P.out[i] = v;
    }
}
extern "C" void kernel_launch(void* const* d_in, const int* in_sizes, int n_in, void* d_out, int out_size, void* d_ws, size_t ws_size, hipStream_t stream) {
    constexpr size_t kDynLds = 131072;
    static int grid_blocks = 0;
    if (!grid_blocks) {
        hipFuncSetAttribute((const void*)mk_forward, hipFuncAttributeMaxDynamicSharedMemorySize, (int)kDynLds);
        int dev = 0, cus = 0, per_cu = 0;
        hipGetDevice(&dev);
        hipDeviceGetAttribute(&cus, hipDeviceAttributeMultiprocessorCount, dev);
        hipOccupancyMaxActiveBlocksPerMultiprocessor(&per_cu, mk_forward, NTHR, kDynLds);
        if (per_cu < 1) per_cu = 1;
        grid_blocks = cus * per_cu;
        if (ws_size < WS_END) fprintf(stderr, "workspace too small: %zu < %zu\n", ws_size, (size_t)WS_END);
    }
    Params p{};
    for (int i = 0; i < 35; ++i) p.in[i] = (const float*)d_in[i];
    p.out = (float*)d_out; p.ws = (unsigned char*)d_ws;
#ifdef MULTI_LAUNCH
    for (int ph = 0; ph < NPHASE; ++ph) hipLaunchKernelGGL(mk_forward, dim3(grid_blocks), dim3(NTHR), kDynLds, stream, p, ph, ph + 1);
#ifdef DBG_A
    hipLaunchKernelGGL(dbg_copy, dim3(2048), dim3(256), 0, stream, p, (size_t)DBG_A, (size_t)DBG_B, (size_t)DBG_F);
#endif
#else
    int lo = 0, hi = NPHASE;
    void* args[] = {&p, &lo, &hi};
    hipError_t e = hipLaunchCooperativeKernel((void*)mk_forward, dim3(grid_blocks), dim3(NTHR), args, kDynLds, stream);
    if (e != hipSuccess) fprintf(stderr, "cooperative launch failed: %s (grid %d)\n", hipGetErrorString(e), grid_blocks);
#endif
}
```

```cpp
#include <hip/hip_runtime.h>
#include <hip/hip_cooperative_groups.h>
#include <cstdio>
namespace cg = cooperative_groups;

#define LAS __attribute__((address_space(3)))
typedef unsigned short bf16_t;
typedef short bf16x8 __attribute__((ext_vector_type(8)));
typedef float f32x4 __attribute__((ext_vector_type(4)));
typedef unsigned u32x2 __attribute__((ext_vector_type(2)));
typedef unsigned u32x4 __attribute__((ext_vector_type(4)));

constexpr int D = 2048, FF = 5632, NBATCH = 4, SEQ = 4096, NMETA = 16, L = SEQ + NMETA;
constexpr int M = NBATCH * L;
constexpr int MMAIN = NBATCH * SEQ;
constexpr int MP = 16640;
constexpr int NTHR = 512;
constexpr int PPAD = 112, PLEN = 4224;

constexpr size_t SZB = (size_t)MP * D * 2, SZF = 2 * SZB;
constexpr size_t OFF_WA = 0;
constexpr size_t OFF_WB = 37748736;
constexpr size_t OFF_HT = OFF_WB + 83886080;
constexpr size_t OFF_RB = OFF_HT + 1048576;
constexpr size_t OFF_VFIRST = OFF_RB + SZB;
constexpr size_t OFF_KF = OFF_VFIRST + SZB;
constexpr size_t OFF_VF = OFF_KF + SZF;
constexpr size_t OFF_DEC = OFF_VF + SZF;
constexpr size_t OFF_MIX = OFF_DEC + SZF;
constexpr size_t OFF_LORA = OFF_MIX + 3 * SZB;
constexpr size_t SZLORA = (size_t)MP * 256 * 2;
constexpr size_t WS_END = OFF_LORA + 4 * SZLORA;
constexpr size_t OFF_HN2 = OFF_KF, OFF_ACT = OFF_KF + SZB;
constexpr size_t WA_W0 = 0, WA_W1 = 8388608, WA_W2 = 16777216, WA_L1 = 25165824, WA_L2 = 29360128, WSLOT = 1048576;
constexpr size_t WB_WO = 0, WB_F1 = 8388608, WB_F2 = WB_F1 + (size_t)2 * FF * D * 2;

struct Params {
    const float* in[35];
    float* out;
    unsigned char* ws;
};

__device__ __forceinline__ int rowof(int b, int t) { return t < NMETA ? MMAIN + b * NMETA + t : b * SEQ + (t - NMETA); }
__device__ __forceinline__ float* hrow(const Params& P, int r) {
    return r < MMAIN ? P.out + (size_t)r * D : (float*)(P.ws + OFF_HT) + (size_t)(r - MMAIN) * D;
}
__device__ __forceinline__ unsigned cvt_pk_bf16(float lo, float hi) { unsigned r; asm volatile("v_cvt_pk_bf16_f32 %0, %1, %2" : "=v"(r) : "v"(lo), "v"(hi)); return r; }
__device__ __forceinline__ float bf_lo(unsigned x) { return __uint_as_float(x << 16); }
__device__ __forceinline__ float bf_hi(unsigned x) { return __uint_as_float(x & 0xffff0000u); }
template <int CTRL> __device__ __forceinline__ float dpp_mov(float x) {
    return __int_as_float(__builtin_amdgcn_update_dpp(0, __float_as_int(x), CTRL, 0xF, 0xF, true));
}
__device__ __forceinline__ float rowsum16(float x) {
    x += dpp_mov<0x128>(x); x += dpp_mov<0x124>(x); x += dpp_mov<0x122>(x); x += dpp_mov<0x121>(x); return x;
}
__device__ __forceinline__ float wavesum(float x) { x = rowsum16(x); x += __shfl_xor(x, 16); x += __shfl_xor(x, 32); return x; }
__device__ __forceinline__ int otid() { int t = threadIdx.x; asm volatile("" : "+v"(t)); return t; }
__device__ __forceinline__ int obid() { int t = blockIdx.x; asm volatile("" : "+s"(t)); return t; }
__device__ __forceinline__ float sigmoidf_(float x) { return 1.0f / (1.0f + __expf(-x)); }

constexpr int BM = 256, BK = 64, HALF = 128, HTB = HALF * BK * 2, NXCD = 8, WGM = 8, NMT = MMAIN / BM;
__device__ __forceinline__ int lds_byte(int r, int c) { const int st = (r >> 4) * 2 + (c >> 5), rr = r & 15, cc = c & 31, ob = rr * 64 + cc * 2; return st * 1024 + (ob ^ (((ob >> 9) & 1) << 5)); }
__device__ __forceinline__ void stage_rc(int b, int& R, int& C) { const int st = b / 1024, sb = b % 1024, swz = sb ^ (((sb >> 9) & 1) << 5); R = (st >> 1) * 16 + swz / 64; C = (st & 1) * 32 + (swz % 64) / 2; }

struct GD { unsigned long long A, Bt, o0, o1; int N, mode, bin, boff, ldo, pad; };
struct PE { int kind, layer, sub, ng, K, pad; GD g[4]; };
struct Unit { int pm, pn, gi; };

__device__ __forceinline__ bool sched_next(const int Lx, const int c1, const int c2, const int c3, const int c4, Unit& u) {
    if (Lx >= c4) return false;
    int gi = 0, base = 0, top = c1;
    if (Lx >= c1) { gi = 1; base = c1; top = c2; }
    if (Lx >= c2) { gi = 2; base = c2; top = c3; }
    if (Lx >= c3) { gi = 3; base = c3; top = c4; }
    const int nM = NMT, nwg = top - base, nN = nwg / NMT;
    int wgid = Lx - base; { const int q = nwg / NXCD, r = nwg % NXCD, xcd = wgid % NXCD, off = wgid / NXCD; wgid = (xcd < r ? xcd * (q + 1) : r * (q + 1) + (xcd - r) * q) + off; }
    const int nig = WGM * nN, gid = wgid / nig, fm = gid * WGM, gsz = (nM - fm) < WGM ? (nM - fm) : WGM;
    u.pm = fm + ((wgid % nig) % gsz); u.pn = (wgid % nig) / gsz; u.gi = gi; return true;
}

template <int MODE>
__device__ __forceinline__ void epi_elem(const int r, const int c, f32x4 v, void* g_o0, void* g_o1, const f32x4 bv, const int ldo, float* outp, float* htp) {
    if constexpr (MODE == 8) {
        float* p = (r < MMAIN ? outp + (size_t)r * D : htp + (size_t)(r - MMAIN) * D) + c; f32x4 hv = *(f32x4*)p; *(f32x4*)p = hv + v;
    } else if constexpr (MODE == 1) {
        *(f32x4*)((float*)g_o0 + (size_t)r * ldo + c) = v;
    } else if constexpr (MODE == 2) {
        *(f32x4*)((float*)g_o0 + (size_t)r * ldo + c) = v;
        u32x2 wv; wv.x = cvt_pk_bf16(v[0], v[1]); wv.y = cvt_pk_bf16(v[2], v[3]);
        *(u32x2*)((bf16_t*)g_o1 + (size_t)r * ldo + c) = wv;
    } else if constexpr (MODE == 5) {
        f32x4 o;
#pragma unroll
        for (int e = 0; e < 4; ++e) { const float x = -(bv[e] + v[e]); const float sp = fmaxf(x, 0.f) + __logf(1.0f + __expf(-fabsf(x))); const float wl = -sp - 0.5f; o[e] = __expf(-__expf(wl)); }
        *(f32x4*)((float*)g_o0 + (size_t)r * ldo + c) = o;
    } else if constexpr (MODE == 7) {
        float* vp = (float*)g_o0 + (size_t)r * ldo + c; const f32x4 vv = *(f32x4*)vp;
        const u32x2 vf = *(const u32x2*)((const bf16_t*)g_o1 + (size_t)r * ldo + c);
        const float f0 = bf_lo(vf.x), f1 = bf_hi(vf.x), f2 = bf_lo(vf.y), f3 = bf_hi(vf.y);
        f32x4 o;
        o[0] = vv[0] + (f0 - vv[0]) * sigmoidf_(bv[0] + v[0]); o[1] = vv[1] + (f1 - vv[1]) * sigmoidf_(bv[1] + v[1]);
        o[2] = vv[2] + (f2 - vv[2]) * sigmoidf_(bv[2] + v[2]); o[3] = vv[3] + (f3 - vv[3]) * sigmoidf_(bv[3] + v[3]);
        *(f32x4*)vp = o;
    } else {
        if constexpr (MODE == 3) {
#pragma unroll
            for (int e = 0; e < 4; ++e) { const float ax = fminf(fabsf(v[e]), 15.0f); const float t = 1.0f - 2.0f / (__expf(2.0f * ax) + 1.0f); v[e] = v[e] < 0.f ? -t : t; } }
        else if constexpr (MODE == 4) { v[0] = sigmoidf_(v[0]); v[1] = sigmoidf_(v[1]); v[2] = sigmoidf_(v[2]); v[3] = sigmoidf_(v[3]); }
        else if constexpr (MODE == 6) { v[0] = sigmoidf_(bv[0] + v[0]); v[1] = sigmoidf_(bv[1] + v[1]); v[2] = sigmoidf_(bv[2] + v[2]); v[3] = sigmoidf_(bv[3] + v[3]); }
        u32x2 wv; wv.x = cvt_pk_bf16(v[0], v[1]); wv.y = cvt_pk_bf16(v[2], v[3]);
        *(u32x2*)((bf16_t*)g_o0 + (size_t)r * ldo + c) = wv;
    }
}
__device__ __forceinline__ void epi_swiglu(const int r, const int oc, const f32x4 g, const f32x4 up, void* g_o0, const int ldo) {
    float o[4];
#pragma unroll
    for (int e = 0; e < 4; ++e) o[e] = g[e] * __builtin_amdgcn_rcpf(1.0f + __expf(-g[e])) * up[e];
    u32x2 wv; wv.x = cvt_pk_bf16(o[0], o[1]); wv.y = cvt_pk_bf16(o[2], o[3]);
    *(u32x2*)((bf16_t*)g_o0 + (size_t)r * ldo + oc) = wv;
}
template <int MODE>
__device__ __forceinline__ void epi_t(const f32x4 (&acc)[2][2][4][2], void* g_o0, void* g_o1, const float* g_bias, const int ldo, const int u_pm, const int u_pn, int wr, int wc, int fr, int fq, float* outp, float* htp) {
    const int row0 = u_pm * BM + wr * 64 + fr, col0 = u_pn * BM + wc * 32 + 4 * fq;
    f32x4 bvv[2][2];
#pragma unroll
    for (int bj = 0; bj < 2; ++bj)
#pragma unroll
        for (int n = 0; n < 2; ++n) bvv[bj][n] = (MODE == 5 || MODE == 6 || MODE == 7) ? *(const f32x4*)(g_bias + col0 + bj * HALF + n * 16) : (f32x4){0.f, 0.f, 0.f, 0.f};
    if constexpr (MODE == 7) {
#pragma unroll
        for (int ai = 0; ai < 2; ++ai) {
#pragma unroll
            for (int mh = 0; mh < 2; ++mh) {
                f32x4 vv[2][2][2]; u32x2 vf[2][2][2];
#pragma unroll
                for (int ml = 0; ml < 2; ++ml) { const size_t o = (size_t)(row0 + ai * HALF + (2 * mh + ml) * 16) * ldo + col0;
#pragma unroll
                    for (int bj = 0; bj < 2; ++bj)
#pragma unroll
                        for (int n = 0; n < 2; ++n) { vv[ml][bj][n] = *(const f32x4*)((const float*)g_o0 + o + bj * HALF + n * 16); vf[ml][bj][n] = *(const u32x2*)((const bf16_t*)g_o1 + o + bj * HALF + n * 16); } }
#pragma unroll
                for (int ml = 0; ml < 2; ++ml) { const size_t o = (size_t)(row0 + ai * HALF + (2 * mh + ml) * 16) * ldo + col0;
#pragma unroll
                    for (int bj = 0; bj < 2; ++bj)
#pragma unroll
                        for (int n = 0; n < 2; ++n) { const f32x4 a = acc[ai][bj][2 * mh + ml][n], x = vv[ml][bj][n], bb = bvv[bj][n]; const u32x2 f = vf[ml][bj][n];
                            f32x4 ov;
                            ov[0] = x[0] + (bf_lo(f.x) - x[0]) * sigmoidf_(bb[0] + a[0]); ov[1] = x[1] + (bf_hi(f.x) - x[1]) * sigmoidf_(bb[1] + a[1]);
                            ov[2] = x[2] + (bf_lo(f.y) - x[2]) * sigmoidf_(bb[2] + a[2]); ov[3] = x[3] + (bf_hi(f.y) - x[3]) * sigmoidf_(bb[3] + a[3]);
                            *(f32x4*)((float*)g_o0 + o + bj * HALF + n * 16) = ov; } }
            }
        }
        return;
    }
    if constexpr (MODE == 8) {
#pragma unroll
        for (int ai = 0; ai < 2; ++ai) {
            f32x4 hv[4][2][2];
#pragma unroll
            for (int m = 0; m < 4; ++m) { const int r = row0 + ai * HALF + m * 16; float* p = (r < MMAIN ? outp + (size_t)r * D : htp + (size_t)(r - MMAIN) * D) + col0;
#pragma unroll
                for (int bj = 0; bj < 2; ++bj)
#pragma unroll
                    for (int n = 0; n < 2; ++n) hv[m][bj][n] = *(const f32x4*)(p + bj * HALF + n * 16); }
#pragma unroll
            for (int m = 0; m < 4; ++m) { const int r = row0 + ai * HALF + m * 16; float* p = (r < MMAIN ? outp + (size_t)r * D : htp + (size_t)(r - MMAIN) * D) + col0;
#pragma unroll
                for (int bj = 0; bj < 2; ++bj)
#pragma unroll
                    for (int n = 0; n < 2; ++n) *(f32x4*)(p + bj * HALF + n * 16) = hv[m][bj][n] + acc[ai][bj][m][n]; }
        }
        return;
    }
#pragma unroll
    for (int ai = 0; ai < 2; ++ai) {
#pragma unroll
        for (int m = 0; m < 4; ++m) {
            const int r = row0 + ai * HALF + m * 16;
            if constexpr (MODE == 9) {
#pragma unroll
                for (int bj = 0; bj < 2; ++bj)
                    epi_swiglu(r, 16 * (u_pn * 8 + bj * 4 + wc) + 4 * fq, acc[ai][bj][m][0], acc[ai][bj][m][1], g_o0, ldo);
            } else if constexpr (MODE == 8 || MODE == 7) {
            } else {
#pragma unroll
                for (int bj = 0; bj < 2; ++bj) {
#pragma unroll
                    for (int n = 0; n < 2; ++n)
                        epi_elem<MODE>(r, col0 + bj * HALF + n * 16, acc[ai][bj][m][n], g_o0, g_o1, bvv[bj][n], ldo, outp, htp);
                }
            }
        }
    }
}
#define EPI_CALL(MD) epi_t<MD>(acc, g_o0, g_o1, g_bias, ldo, u_pm, u_pn, wr, wc, fr, fq, outp, htp)
__device__ __forceinline__ void epilogue(const f32x4 (&acc)[2][2][4][2], const int mode, void* g_o0, void* g_o1, const float* g_bias, const int ldo, const int u_pm, const int u_pn, int wr, int wc, int fr, int fq, float* outp, float* htp) {
    switch (mode) {
        case 0: EPI_CALL(0); break;
        case 1: EPI_CALL(1); break;
        case 2: EPI_CALL(2); break;
        case 3: EPI_CALL(3); break;
        case 4: EPI_CALL(4); break;
        case 5: EPI_CALL(5); break;
        case 6: EPI_CALL(6); break;
        case 7: EPI_CALL(7); break;
        case 8: EPI_CALL(8); break;
        default: EPI_CALL(9); break;
    }
}

__device__ __forceinline__ void gemm_phase(LAS unsigned char* lds, const PE* pe, const Params& P) {
    const int tid = threadIdx.x, wid = __builtin_amdgcn_readfirstlane(tid >> 6), lane = tid & 63, wr = wid >> 2, wc = wid & 3, fr = lane & 15, fq = lane >> 4;
    const int K = pe->K, nt = K / BK;
    const int sG = (int)gridDim.x, sC = (int)blockIdx.x, s_ng = pe->ng;
    const int sc1 = NMT * (pe->g[0].N / BM);
    const int sc2 = sc1 + (s_ng > 1 ? NMT * (pe->g[1].N / BM) : 0);
    const int sc3 = sc2 + (s_ng > 2 ? NMT * (pe->g[2].N / BM) : 0);
    const int sc4 = sc3 + (s_ng > 3 ? NMT * (pe->g[3].N / BM) : 0);
    unsigned char* const ws = P.ws;
    unsigned voff[2];
#pragma unroll
    for (int i = 0; i < 2; ++i) { int R, C; stage_rc(tid * 16 + i * 8192, R, C); voff[i] = (unsigned)(R * K + C) * 2u; }
    const size_t kstep = (size_t)(BK * 2);
    const size_t hstep = (size_t)HALF * K * 2;
    const size_t tstep = 2 * hstep;
    const unsigned ldsw = (unsigned)wid * 1024u;
    const int aoff = lds_byte(wr * 64 + fr, fq * 8), boff = lds_byte(wc * 32 + fr, fq * 8);
#define PG8_SA(b, h) (((b) * 2 + (h)) * HTB)
#define PG8_SB(b, h) ((4 + (b) * 2 + (h)) * HTB)
#define PG8_STAGE(bufoff, gbase) do { _Pragma("unroll") for (int _i = 0; _i < 2; ++_i) \
        __builtin_amdgcn_global_load_lds((const unsigned*)((const char*)(gbase) + voff[_i]), (LAS unsigned*)(lds + (bufoff) + ldsw + _i * 8192), 16, 0, 0); } while (0)
#define PG8_LDA(dst, b, h) do { _Pragma("unroll") for (int m = 0; m < 4; ++m) _Pragma("unroll") for (int k = 0; k < 2; ++k) dst[m][k] = *(const LAS bf16x8*)(lds + PG8_SA(b, h) + aoff + m * 2048 + k * 1024); } while (0)
#define PG8_LDB(dst, b, h) do { _Pragma("unroll") for (int n = 0; n < 2; ++n) _Pragma("unroll") for (int k = 0; k < 2; ++k) dst[n][k] = *(const LAS bf16x8*)(lds + PG8_SB(b, h) + boff + n * 2048 + k * 1024); } while (0)
#define PG8_MMA(ai, bj, At, Bt) do { __builtin_amdgcn_s_setprio(1); _Pragma("unroll") for (int m = 0; m < 4; ++m) _Pragma("unroll") for (int n = 0; n < 2; ++n) _Pragma("unroll") for (int k = 0; k < 2; ++k) \
        acc[ai][bj][m][n] = __builtin_amdgcn_mfma_f32_16x16x32_bf16(Bt[n][k], At[m][k], acc[ai][bj][m][n], 0, 0, 0); __builtin_amdgcn_s_setprio(0); } while (0)
#define PG8_WAIT_V(n) asm volatile("s_waitcnt vmcnt(" #n ")" ::: "memory")
#define PG8_WAIT_L(n) asm volatile("s_waitcnt lgkmcnt(" #n ")" ::: "memory")
#define PG8_BAR __builtin_amdgcn_s_barrier()
#define PG8_SCHED __builtin_amdgcn_sched_barrier(0)
    Unit cur, nxt; int ui = 0;
    if (!sched_next(sC, sc1, sc2, sc3, sc4, cur)) return;
    f32x4 acc[2][2][4][2];
#pragma unroll
    for (int a = 0; a < 2; ++a)
#pragma unroll
        for (int b = 0; b < 2; ++b)
#pragma unroll
            for (int m = 0; m < 4; ++m)
#pragma unroll
                for (int n = 0; n < 2; ++n) acc[a][b][m][n] = (f32x4){0.f, 0.f, 0.f, 0.f};
    bf16x8 At[4][2], B0[2][2], B1[2][2];
    const char* cA = (const char*)ws + pe->g[cur.gi].A + (size_t)cur.pm * tstep; const char* cB = (const char*)ws + pe->g[cur.gi].Bt + (size_t)cur.pn * tstep;
    PG8_STAGE(PG8_SB(0, 0), cB); PG8_STAGE(PG8_SA(0, 0), cA); PG8_STAGE(PG8_SB(0, 1), cB + hstep); PG8_STAGE(PG8_SA(0, 1), cA + hstep);
    if (wr == 1) PG8_BAR;
    PG8_WAIT_V(4); PG8_BAR;
    PG8_STAGE(PG8_SB(1, 0), cB + kstep); PG8_STAGE(PG8_SA(1, 0), cA + kstep); PG8_STAGE(PG8_SB(1, 1), cB + hstep + kstep);
    PG8_WAIT_V(6); PG8_BAR;
    for (;;) {
        const bool has_next = sched_next((ui + 1) * sG + sC, sc1, sc2, sc3, sc4, nxt);
        const char* nA = cA; const char* nB = cB;
        if (has_next) { nA = (const char*)ws + pe->g[nxt.gi].A + (size_t)nxt.pm * tstep; nB = (const char*)ws + pe->g[nxt.gi].Bt + (size_t)nxt.pn * tstep; }
        for (int t = 0; t < nt; t += 2) {
            const bool last = (t == nt - 2);
            const char* a1 = cA + (size_t)(t + 1) * kstep;
            const char* a2 = last ? nA : cA + (size_t)(t + 2) * kstep; const char* b2 = last ? nB : cB + (size_t)(t + 2) * kstep;
            const char* a3 = a2 + kstep; const char* b3 = b2 + kstep;
            PG8_LDB(B0, 0, 0); PG8_SCHED; PG8_LDA(At, 0, 0); PG8_STAGE(PG8_SA(1, 1), a1 + hstep);
            PG8_WAIT_L(8); PG8_BAR; PG8_WAIT_L(0); PG8_MMA(0, 0, At, B0); PG8_BAR; PG8_SCHED;
            PG8_LDB(B1, 0, 1); PG8_STAGE(PG8_SB(0, 0), b2);
            PG8_BAR; PG8_WAIT_L(0); PG8_MMA(0, 1, At, B1); PG8_BAR;
            PG8_LDA(At, 0, 1); PG8_STAGE(PG8_SA(0, 0), a2);
            PG8_BAR; PG8_WAIT_L(0); PG8_MMA(1, 0, At, B0); PG8_BAR; PG8_SCHED;
            PG8_STAGE(PG8_SB(0, 1), b2 + hstep);
            PG8_WAIT_V(6); PG8_BAR; PG8_MMA(1, 1, At, B1); PG8_BAR;
            PG8_LDB(B0, 1, 0); PG8_SCHED; PG8_LDA(At, 1, 0); PG8_STAGE(PG8_SA(0, 1), a2 + hstep);
            PG8_WAIT_L(8); PG8_BAR; PG8_WAIT_L(0); PG8_MMA(0, 0, At, B0); PG8_BAR; PG8_SCHED;
            PG8_LDB(B1, 1, 1); PG8_STAGE(PG8_SB(1, 0), b3);
            PG8_BAR; PG8_WAIT_L(0); PG8_MMA(0, 1, At, B1); PG8_BAR;
            PG8_LDA(At, 1, 1); PG8_STAGE(PG8_SA(1, 0), a3);
            PG8_BAR; PG8_WAIT_L(0); PG8_MMA(1, 0, At, B0); PG8_BAR; PG8_SCHED;
            PG8_STAGE(PG8_SB(1, 1), b3 + hstep);
            PG8_WAIT_V(6); PG8_BAR; PG8_MMA(1, 1, At, B1); PG8_BAR;
        }
        { const GD* gd = &pe->g[cur.gi];
          epilogue(acc, gd->mode, ws + gd->o0, ws + gd->o1, P.in[gd->bin] + gd->boff, gd->ldo, cur.pm, cur.pn, wr, wc, fr, fq, P.out, (float*)(ws + OFF_HT)); }
        if (!has_next) break;
#pragma unroll
        for (int a = 0; a < 2; ++a)
#pragma unroll
            for (int b = 0; b < 2; ++b)
#pragma unroll
                for (int m = 0; m < 4; ++m)
#pragma unroll
                    for (int n = 0; n < 2; ++n) acc[a][b][m][n] = (f32x4){0.f, 0.f, 0.f, 0.f};
        cur = nxt; cA = nA; cB = nB; ++ui;
    }
    PG8_WAIT_V(0);
    if (wr == 0) PG8_BAR;
    PG8_BAR;
#undef PG8_SA
#undef PG8_SB
#undef PG8_STAGE
#undef PG8_LDA
#undef PG8_LDB
#undef PG8_MMA
#undef PG8_WAIT_V
#undef PG8_WAIT_L
#undef PG8_BAR
#undef PG8_SCHED
}

#define TE_CALL(MD) epi_elem<MD>(r, c, v, o0, o1, bvt, ldo, P.out, (float*)(ws + OFF_HT))
__device__ void tail_gemm(LAS unsigned char* lds, const PE* pe, const Params& P) {
    const int tid = otid(), w = tid >> 6, lane = tid & 63, fr = lane & 15, fq = lane >> 4;
    unsigned char* const ws = P.ws;
    const int K = pe->K, ks = K >> 3, nstep = ks >> 5, ng = pe->ng;
    const int t1 = pe->g[0].N >> 4;
    const int t2 = t1 + (ng > 1 ? pe->g[1].N >> 4 : 0);
    const int t3 = t2 + (ng > 2 ? pe->g[2].N >> 4 : 0);
    const int t4 = t3 + (ng > 3 ? pe->g[3].N >> 4 : 0);
    LAS f32x4* part = (LAS f32x4*)lds;
    const int bid_ = obid();
    const int rank_ = (bid_ & 1) ? (bid_ >> 1) : ((int)(gridDim.x >> 1) + (bid_ >> 1));
    for (int item = rank_; item < t4; item += gridDim.x) {
        int gi = 0, base = 0;
        if (item >= t1) { gi = 1; base = t1; }
        if (item >= t2) { gi = 2; base = t2; }
        if (item >= t3) { gi = 3; base = t3; }
        const int cb = (item - base) >> 1, mh = (item - base) & 1;
        const GD* gd = &pe->g[gi];
        const bf16_t* A = (const bf16_t*)(ws + gd->A) + (size_t)(MMAIN + 32 * mh + fr) * K + (size_t)w * ks + 8 * fq;
        const bf16_t* Bt = (const bf16_t*)(ws + gd->Bt) + (size_t)(32 * cb + fr) * K + (size_t)w * ks + 8 * fq;
        const size_t r16 = (size_t)16 * K;
        f32x4 acc[2][2];
#pragma unroll
        for (int m = 0; m < 2; ++m) { acc[m][0] = (f32x4){0.f, 0.f, 0.f, 0.f}; acc[m][1] = acc[m][0]; }
        for (int s0 = 0; s0 < nstep; s0 += 8) {
            bf16x8 af[8][2], bfr[8][2];
#pragma unroll
            for (int s = 0; s < 8; ++s) if (s0 + s < nstep) {
                const int k0 = (s0 + s) * 32;
                af[s][0] = *(const bf16x8*)(A + k0); af[s][1] = *(const bf16x8*)(A + r16 + k0);
                bfr[s][0] = *(const bf16x8*)(Bt + k0); bfr[s][1] = *(const bf16x8*)(Bt + r16 + k0);
            }
#pragma unroll
            for (int s = 0; s < 8; ++s) if (s0 + s < nstep) {
#pragma unroll
                for (int m = 0; m < 2; ++m)
#pragma unroll
                    for (int nb = 0; nb < 2; ++nb) acc[m][nb] = __builtin_amdgcn_mfma_f32_16x16x32_bf16(bfr[s][nb], af[s][m], acc[m][nb], 0, 0, 0);
            }
        }
        __syncthreads();
#pragma unroll
        for (int m = 0; m < 2; ++m)
#pragma unroll
            for (int nb = 0; nb < 2; ++nb) part[(w * 4 + m * 2 + nb) * 64 + lane] = acc[m][nb];
        __syncthreads();
        if (tid < 256) {
            const int ml = tid >> 7, nb2 = (tid >> 6) & 1;
            f32x4 v = part[(ml * 2 + nb2) * 64 + lane];
#pragma unroll
            for (int x = 1; x < 8; ++x) v += part[(x * 4 + ml * 2 + nb2) * 64 + lane];
            const int r = MMAIN + 32 * mh + 16 * ml + fr, c = 32 * cb + 16 * nb2 + 4 * fq;
            const int mode = gd->mode, ldo = gd->ldo;
            void* o0 = ws + gd->o0; void* o1 = ws + gd->o1; const float* bias = P.in[gd->bin] + gd->boff;
            const f32x4 bvt = (mode == 5 || mode == 6 || mode == 7) ? *(const f32x4*)(bias + c) : (f32x4){0.f, 0.f, 0.f, 0.f};
            if (mode == 9) {
                if (nb2 == 0) { f32x4 up = part[(ml * 2 + 1) * 64 + lane];
#pragma unroll
                    for (int x = 1; x < 8; ++x) up += part[(x * 4 + ml * 2 + 1) * 64 + lane];
                    epi_swiglu(r, 16 * cb + 4 * fq, v, up, o0, ldo); }
            } else {
                switch (mode) {
                    case 0: TE_CALL(0); break;
                    case 1: TE_CALL(1); break;
                    case 2: TE_CALL(2); break;
                    case 3: TE_CALL(3); break;
                    case 4: TE_CALL(4); break;
                    case 5: TE_CALL(5); break;
                    case 6: TE_CALL(6); break;
                    case 7: TE_CALL(7); break;
                    default: TE_CALL(8); break;
                }
            }
        }
    }
}

__device__ void conv_T(const float* src, const float* src2, int ldsrc, bf16_t* dst, int K, int N, int Kpad, int Npad, int mode, LAS float* tile) {
    const int tid = otid();
    const int tk = Kpad / 256, tn = Npad / 64, ntile = tk * tn;
    for (int ti = obid(); ti < ntile; ti += gridDim.x) {
        const int R0 = (ti / tk) * 64, k0 = (ti % tk) * 256;
        f32x4 v[4][2];
#pragma unroll
        for (int sub = 0; sub < 4; ++sub)
#pragma unroll
            for (int pass = 0; pass < 2; ++pass) {
                const int kr = (tid >> 4) + pass * 32, c4 = (tid & 15) * 4;
                const int k = k0 + sub * 64 + kr, R = R0 + c4;
                v[sub][pass] = (f32x4){0.f, 0.f, 0.f, 0.f};
                if (k < K && R < N) {
                    const float* s; int col;
                    if (mode == 1) { const int g = R >> 5, wi = R & 31; s = wi < 16 ? src : src2; col = 16 * g + (wi & 15); }
                    else { s = src; col = R; }
                    v[sub][pass] = *(const f32x4*)(s + (size_t)k * ldsrc + col);
                }
            }
        __syncthreads();
#pragma unroll
        for (int sub = 0; sub < 4; ++sub)
#pragma unroll
            for (int pass = 0; pass < 2; ++pass) {
                const int kr = (tid >> 4) + pass * 32, c4 = (tid & 15) * 4;
                LAS float* t = tile + sub * (64 * 65) + kr * 65 + c4;
                t[0] = v[sub][pass][0]; t[1] = v[sub][pass][1]; t[2] = v[sub][pass][2]; t[3] = v[sub][pass][3];
            }
        __syncthreads();
        const int Rr = tid >> 3, k8 = (tid & 7) * 8;
#pragma unroll
        for (int sub = 0; sub < 4; ++sub) {
            float e[8];
#pragma unroll
            for (int i = 0; i < 8; ++i) e[i] = tile[sub * (64 * 65) + (k8 + i) * 65 + Rr];
            u32x4 o; o.x = cvt_pk_bf16(e[0], e[1]); o.y = cvt_pk_bf16(e[2], e[3]); o.z = cvt_pk_bf16(e[4], e[5]); o.w = cvt_pk_bf16(e[6], e[7]);
            *(u32x4*)(dst + (size_t)(R0 + Rr) * Kpad + k0 + sub * 64 + k8) = o;
        }
    }
}

struct CJ { int in0, in1, ldsrc, K, N, Kpad, Npad, mode; unsigned long long soff, doff; };
struct CJTab { CJ j[4][14]; int n[4]; };
constexpr CJ mkcj(int in0, int in1, unsigned long long soff, int ldsrc, unsigned long long doff, int K, int N, int Kpad, int Npad, int mode) {
    CJ c{}; c.in0 = in0; c.in1 = in1; c.ldsrc = ldsrc; c.K = K; c.N = N; c.Kpad = Kpad; c.Npad = Npad; c.mode = mode; c.soff = soff; c.doff = doff; return c;
}
constexpr CJTab make_cjtab() {
    CJTab t{};
    const unsigned long long DD = (unsigned long long)D * D, DF = (unsigned long long)D * FF;
    for (int layer = 0; layer < 4; ++layer) {
        int n = 0;
        if (layer < 2) {
            const unsigned long long i = layer;
            t.j[layer][n++] = mkcj(8, 8, i * DD, D, OFF_WA + WA_W0, D, D, D, D, 0);
            t.j[layer][n++] = mkcj(9, 9, i * DD, D, OFF_WA + WA_W1, D, D, D, D, 0);
            t.j[layer][n++] = mkcj(10, 10, i * DD, D, OFF_WA + WA_W2, D, D, D, D, 0);
            t.j[layer][n++] = mkcj(13, 13, i * D * 96, 96, OFF_WA + WA_L1 + 0 * WSLOT, D, 96, D, 256, 0);
            t.j[layer][n++] = mkcj(16, 16, i * D * 96, 96, OFF_WA + WA_L1 + 1 * WSLOT, D, 96, D, 256, 0);
            t.j[layer][n++] = mkcj(18, 18, i * D * 256, 256, OFF_WA + WA_L1 + 2 * WSLOT, D, 256, D, 256, 0);
            t.j[layer][n++] = mkcj(14, 14, i * 96 * D, D, OFF_WA + WA_L2 + 0 * WSLOT, 96, D, 256, D, 0);
            t.j[layer][n++] = mkcj(17, 17, i * 96 * D, D, OFF_WA + WA_L2 + 1 * WSLOT, 96, D, 256, D, 0);
            t.j[layer][n++] = mkcj(19, 19, i * 256 * D, D, OFF_WA + WA_L2 + 2 * WSLOT, 256, D, 256, D, 0);
            if (layer >= 1) {
                t.j[layer][n++] = mkcj(26, 26, (i - 1) * D * 64, 64, OFF_WA + WA_L1 + 3 * WSLOT, D, 64, D, 256, 0);
                t.j[layer][n++] = mkcj(27, 27, (i - 1) * 64 * D, D, OFF_WA + WA_L2 + 3 * WSLOT, 64, D, 256, D, 0);
            }
            t.j[layer][n++] = mkcj(11, 11, i * DD, D, OFF_WB + WB_WO, D, D, D, D, 0);
        } else {
            const unsigned long long jj = layer - 2;
            t.j[layer][n++] = mkcj(32, 32, jj * DD, D, OFF_WA + WA_W0, D, D, D, D, 0);
            if (layer == 2) {
                t.j[layer][n++] = mkcj(29, 29, 0, D, OFF_WA + WA_W1, D, D, D, D, 0);
                t.j[layer][n++] = mkcj(30, 30, 0, D, OFF_WA + WA_W2, D, D, D, D, 0);
            }
            t.j[layer][n++] = mkcj(34, 34, jj * DD, D, OFF_WB + WB_WO, D, D, D, D, 0);
        }
        t.j[layer][n++] = mkcj(4, 5, (unsigned long long)layer * DF, FF, OFF_WB + WB_F1, D, 2 * FF, D, 2 * FF, 1);
        t.j[layer][n++] = mkcj(6, 6, (unsigned long long)layer * DF, D, OFF_WB + WB_F2, FF, D, FF, D, 0);
        t.n[layer] = n;
    }
    return t;
}
__constant__ const CJTab CJT = make_cjtab();

__device__ void convert_layer(const Params& P, int layer, LAS unsigned char* lds) {
    LAS float* tile = (LAS float*)lds;
    const int nj = CJT.n[layer];
    for (int q = 0; q < nj; ++q) {
        const CJ* c = &CJT.j[layer][q];
        conv_T(P.in[c->in0] + c->soff, P.in[c->in1] + c->soff, c->ldsrc, (bf16_t*)(P.ws + c->doff), c->K, c->N, c->Kpad, c->Npad, c->mode, tile);
    }
}

__device__ void init_phase(const Params& P) {
    const f32x4* x = (const f32x4*)P.in[0]; f32x4* o = (f32x4*)P.out;
    const size_t n4 = (size_t)MMAIN * D / 4;
    for (size_t i = (size_t)obid() * NTHR + otid(); i < n4; i += (size_t)gridDim.x * NTHR) o[i] = x[i];
    const f32x4* mt = (const f32x4*)P.in[1]; f32x4* ht = (f32x4*)(P.ws + OFF_HT);
    const int m4 = NBATCH * NMETA * D / 4, per = NMETA * D / 4;
    for (int i = obid() * NTHR + otid(); i < m4; i += gridDim.x * NTHR) ht[i] = mt[i % per];
}

__device__ void mixprep_phase(const Params& P, int i) {
    const int tid_ = otid(); const int w = tid_ >> 6, lane = tid_ & 63;
    const float* g = P.in[2] + (size_t)i * D;
    const float* mu = P.in[7] + (size_t)i * 6 * D;
    bf16_t* const ob[6] = {(bf16_t*)(P.ws + OFF_MIX), (bf16_t*)(P.ws + OFF_DEC), (bf16_t*)(P.ws + OFF_MIX + SZB), (bf16_t*)(P.ws + OFF_MIX + 2 * SZB),
                           (bf16_t*)(P.ws + OFF_DEC + SZB), (bf16_t*)(P.ws + OFF_KF)};
    for (int idx = obid() * 8 + w; idx < M; idx += gridDim.x * 8) {
        const int b = idx / L, t = idx % L;
        const int r = rowof(b, t), rprev = rowof(b, t > 0 ? t - 1 : 0);
        const float* hc; const float* hp;
        if (i == 0) {
            hc = r < MMAIN ? P.in[0] + (size_t)r * D : P.in[1] + (size_t)((r - MMAIN) & 15) * D;
            hp = rprev < MMAIN ? P.in[0] + (size_t)rprev * D : P.in[1] + (size_t)((rprev - MMAIN) & 15) * D;
        } else { hc = hrow(P, r); hp = hrow(P, rprev); }
        float* hw = hrow(P, r);
        f32x4 c[8], p[8]; float sc = 0.f, sp = 0.f;
#pragma unroll
        for (int q = 0; q < 8; ++q) { c[q] = *(const f32x4*)(hc + 256 * q + 4 * lane); p[q] = *(const f32x4*)(hp + 256 * q + 4 * lane);
            sc += c[q][0] * c[q][0] + c[q][1] * c[q][1] + c[q][2] * c[q][2] + c[q][3] * c[q][3];
            sp += p[q][0] * p[q][0] + p[q][1] * p[q][1] + p[q][2] * p[q][2] + p[q][3] * p[q][3]; }
        if (i == 0) {
#pragma unroll
            for (int q = 0; q < 8; ++q) *(f32x4*)(hw + 256 * q + 4 * lane) = c[q];
        }
        sc = wavesum(sc); sp = wavesum(sp);
        const float rc = rsqrtf(sc * (1.0f / D) + 1e-6f);
        const float rp = t > 0 ? rsqrtf(sp * (1.0f / D) + 1e-6f) : 0.f;
#pragma unroll
        for (int q = 0; q < 8; ++q) {
            const int col = 256 * q + 4 * lane;
            const f32x4 gv = *(const f32x4*)(g + col);
            f32x4 hn, xx;
#pragma unroll
            for (int e = 0; e < 4; ++e) { hn[e] = c[q][e] * rc * gv[e]; xx[e] = p[q][e] * rp * gv[e] - hn[e]; }
#pragma unroll
            for (int j = 0; j < 6; ++j) {
                const f32x4 m = *(const f32x4*)(mu + j * D + col);
                u32x2 a; a.x = cvt_pk_bf16(hn[0] + xx[0] * m[0], hn[1] + xx[1] * m[1]); a.y = cvt_pk_bf16(hn[2] + xx[2] * m[2], hn[3] + xx[3] * m[3]);
                *(u32x2*)(ob[j] + (size_t)r * D + col) = a;
            }
        }
    }
}

__device__ void norm_phase(const Params& P, const float* g1, bf16_t* o1, const float* g2, bf16_t* o2) {
    const int tid_ = otid(); const int w = tid_ >> 6, lane = tid_ & 63;
    for (int r = obid() * 8 + w; r < M; r += gridDim.x * 8) {
        const float* hc = hrow(P, r);
        f32x4 c[8]; float sc = 0.f;
#pragma unroll
        for (int q = 0; q < 8; ++q) { c[q] = *(const f32x4*)(hc + 256 * q + 4 * lane); sc += c[q][0] * c[q][0] + c[q][1] * c[q][1] + c[q][2] * c[q][2] + c[q][3] * c[q][3]; }
        sc = wavesum(sc);
        const float rc = rsqrtf(sc * (1.0f / D) + 1e-6f);
#pragma unroll
        for (int q = 0; q < 8; ++q) {
            const int col = 256 * q + 4 * lane;
            const f32x4 gv = *(const f32x4*)(g1 + col);
            u32x2 a; a.x = cvt_pk_bf16(c[q][0] * rc * gv[0], c[q][1] * rc * gv[1]); a.y = cvt_pk_bf16(c[q][2] * rc * gv[2], c[q][3] * rc * gv[3]);
            *(u32x2*)(o1 + (size_t)r * D + col) = a;
            if (g2) { const f32x4 g2v = *(const f32x4*)(g2 + col);
                u32x2 bq; bq.x = cvt_pk_bf16(c[q][0] * rc * g2v[0], c[q][1] * rc * g2v[1]); bq.y = cvt_pk_bf16(c[q][2] * rc * g2v[2], c[q][3] * rc * g2v[3]);
                *(u32x2*)(o2 + (size_t)r * D + col) = bq; }
        }
    }
}

__device__ void scan_phase(const Params& P, int i, LAS unsigned char* lds) {
    const int tid = otid(), w = tid >> 6, lane = tid & 63;
    const bf16_t* RB = (const bf16_t*)(P.ws + OFF_RB); const float* KF = (const float*)(P.ws + OFF_KF);
    const float* VF = (const float*)(P.ws + OFF_VF); const float* DEC = (const float*)(P.ws + OFF_DEC);
    const bf16_t* AB = (const bf16_t*)(P.ws + OFF_MIX); bf16_t* YB = (bf16_t*)(P.ws + OFF_MIX + 2 * SZB);
    const float* k_k = P.in[20] + (size_t)i * D; const float* k_a = P.in[21] + (size_t)i * D; const float* r_k = P.in[22] + (size_t)i * D;
    float* SBON = (float*)(P.ws + OFF_LORA);
    LAS float* fl = (LAS float*)lds;
    constexpr int STG = 11264;
    LAS float* ybuf = fl + 2 * STG;
    typedef float f32x2 __attribute__((ext_vector_type(2)));
    const int wu = __builtin_amdgcn_readfirstlane(w);
    const int kg = lane & 15, rp = 4 * (wu & 3) + (lane >> 4);
    const int lt = tid & 255;
    const int lc = (lt & 15) * 4, vt = lt >> 3, vc = (lt & 7) * 4;
    constexpr int NCH = (L + 31) / 32;
    for (int u = obid(); u < 256; u += gridDim.x) {
        const int bh = u >> 1, rh = u & 1, b = bh >> 5, h = bh & 31;
        f32x4 kkp = (f32x4){0.f, 0.f, 0.f, 0.f}, kap = kkp, rkp = kkp;
        f32x4 gk[2], gd[2], gv; u32x2 gr[2], ga[2];
        __syncthreads();
#define SCAN_LOAD(cc) do { _Pragma("unroll") for (int q_ = 0; q_ < 2; ++q_) { const int t_ = 32 * (cc) + (lt >> 4) + 16 * q_; \
              gk[q_] = (f32x4){0.f, 0.f, 0.f, 0.f}; gd[q_] = gk[q_]; gr[q_] = (u32x2){0u, 0u}; ga[q_] = gr[q_]; \
              if (t_ < L) { const size_t o_ = (size_t)rowof(b, t_) * D + 64 * h + lc; gk[q_] = *(const f32x4*)(KF + o_); gd[q_] = *(const f32x4*)(DEC + o_); gr[q_] = *(const u32x2*)(RB + o_); ga[q_] = *(const u32x2*)(AB + o_); } } \
            { const int tv_ = 32 * (cc) + vt; gv = (f32x4){0.f, 0.f, 0.f, 0.f}; if (tv_ < L) gv = *(const f32x4*)(VF + (size_t)rowof(b, tv_) * D + 64 * h + 32 * rh + vc); } } while (0)
#define SCAN_STORE(st, cc) do { LAS float* s_ = fl + (st) * STG; _Pragma("unroll") for (int q_ = 0; q_ < 2; ++q_) { const int o_ = ((lt >> 4) + 16 * q_) * 64 + lc; \
              f32x4 kr_ = gk[q_] * kkp; float ss_ = kr_[0] * kr_[0] + kr_[1] * kr_[1] + kr_[2] * kr_[2] + kr_[3] * kr_[3]; ss_ = rowsum16(ss_); \
              const float inv_ = rsqrtf(fmaxf(ss_, 1e-24f)); \
              f32x4 av_; av_[0] = bf_lo(ga[q_].x); av_[1] = bf_hi(ga[q_].x); av_[2] = bf_lo(ga[q_].y); av_[3] = bf_hi(ga[q_].y); \
              f32x4 rv_; rv_[0] = bf_lo(gr[q_].x); rv_[1] = bf_hi(gr[q_].x); rv_[2] = bf_lo(gr[q_].y); rv_[3] = bf_hi(gr[q_].y); \
              const f32x4 kk_ = kr_ * inv_; f32x4 kp_; \
              for (int e_ = 0; e_ < 4; ++e_) kp_[e_] = gk[q_][e_] * (1.0f + (av_[e_] - 1.0f) * kap[e_]); \
              *(LAS f32x4*)(s_ + o_) = rv_; *(LAS f32x4*)(s_ + 2048 + o_) = gd[q_]; *(LAS f32x4*)(s_ + 4096 + o_) = kp_; \
              *(LAS f32x4*)(s_ + 6144 + o_) = kk_; *(LAS f32x4*)(s_ + 8192 + o_) = kk_ * av_; \
              float sb_ = rv_[0] * kp_[0] * rkp[0] + rv_[1] * kp_[1] * rkp[1] + rv_[2] * kp_[2] * rkp[2] + rv_[3] * kp_[3] * rkp[3]; sb_ = rowsum16(sb_); \
              { const int tb_ = 32 * (cc) + (lt >> 4) + 16 * q_; if (rh == 0 && (lt & 15) == 0 && tb_ < L) SBON[(size_t)rowof(b, tb_) * 32 + h] = sb_; } } \
            *(LAS f32x4*)(s_ + 10240 + vt * 32 + vc) = gv; } while (0)
#define SCAN_FLUSH(cc) do { const LAS float* yb_ = ybuf + ((cc) & 1) * 1024; _Pragma("unroll") for (int q_ = 0; q_ < 2; ++q_) { const int ft_ = (lt >> 4) + 16 * q_, fv_ = (lt & 15) * 2; const int tt_ = 32 * (cc) + ft_; \
              if (tt_ < L) { const unsigned pk_ = cvt_pk_bf16(yb_[ft_ * 32 + fv_], yb_[ft_ * 32 + fv_ + 1]); *(unsigned*)(YB + (size_t)rowof(b, tt_) * D + 64 * h + 32 * rh + fv_) = pk_; } } } while (0)
        if (wu >= 4) {
            kkp = *(const f32x4*)(k_k + 64 * h + lc); kap = *(const f32x4*)(k_a + 64 * h + lc); rkp = *(const f32x4*)(r_k + 64 * h + lc);
            SCAN_LOAD(0); SCAN_STORE(0, 0);
            SCAN_LOAD(1);
        }
        __syncthreads();
        f32x2 SA01 = {0.f, 0.f}, SA23 = SA01, SB01 = SA01, SB23 = SA01;
        for (int c = 0; c < NCH; ++c) {
            if (wu < 4) {
                const LAS float* s = fl + (c & 1) * STG;
                LAS float* yb = ybuf + (c & 1) * 1024;
                const int ns = (L - 32 * c) < 32 ? (L - 32 * c) : 32;
                for (int tb = 0; tb < ns; tb += 16) {
                    float ykA = 0.f, ykB = 0.f;
#pragma unroll
                    for (int j = 0; j < 16; ++j) {
                        const int t = tb + j;
                        const int o = t * 64 + 4 * kg;
                        const f32x4 r4 = *(const LAS f32x4*)(s + o), d4 = *(const LAS f32x4*)(s + 2048 + o), kp4 = *(const LAS f32x4*)(s + 4096 + o);
                        const f32x4 kk4 = *(const LAS f32x4*)(s + 6144 + o), ka4 = *(const LAS f32x4*)(s + 8192 + o);
                        const f32x2 vv = *(const LAS f32x2*)(s + 10240 + t * 32 + 2 * rp);
                        const f32x2 kk01 = {kk4[0], kk4[1]}, kk23 = {kk4[2], kk4[3]}, ka01 = {ka4[0], ka4[1]}, ka23 = {ka4[2], ka4[3]};
                        const f32x2 kp01 = {kp4[0], kp4[1]}, kp23 = {kp4[2], kp4[3]}, d01 = {d4[0], d4[1]}, d23 = {d4[2], d4[3]}, r01 = {r4[0], r4[1]}, r23 = {r4[2], r4[3]};
                        f32x2 pA = SA01 * kk01; pA = SA23 * kk23 + pA;
                        f32x2 pB = SB01 * kk01; pB = SB23 * kk23 + pB;
                        const float saA = -rowsum16(pA.x + pA.y), saB = -rowsum16(pB.x + pB.y);
                        f32x2 tA01 = kp01 * vv.x, tA23 = kp23 * vv.x, tB01 = kp01 * vv.y, tB23 = kp23 * vv.y;
                        tA01 = ka01 * saA + tA01; tA23 = ka23 * saA + tA23; tB01 = ka01 * saB + tB01; tB23 = ka23 * saB + tB23;
                        SA01 = SA01 * d01 + tA01; SA23 = SA23 * d23 + tA23; SB01 = SB01 * d01 + tB01; SB23 = SB23 * d23 + tB23;
                        f32x2 qA = SA01 * r01; qA = SA23 * r23 + qA;
                        f32x2 qB = SB01 * r01; qB = SB23 * r23 + qB;
                        const float yA = rowsum16(qA.x + qA.y), yB = rowsum16(qB.x + qB.y);
                        ykA = (kg == j) ? yA : ykA; ykB = (kg == j) ? yB : ykB;
                    }
                    { f32x2 yy = {ykA, ykB}; *(LAS f32x2*)(yb + (tb + kg) * 32 + 2 * rp) = yy; }
                }
            } else {
                if (c + 1 < NCH) SCAN_STORE((c + 1) & 1, c + 1);
                if (c + 2 < NCH) SCAN_LOAD(c + 2);
                if (c >= 1) SCAN_FLUSH(c - 1);
            }
            __syncthreads();
        }
        if (wu >= 4) SCAN_FLUSH(NCH - 1);
#undef SCAN_LOAD
#undef SCAN_STORE
#undef SCAN_FLUSH
    }
}

__device__ void post_phase(const Params& P, int i) {
    const int tid_ = otid(); const int w = tid_ >> 6, lane = tid_ & 63;
    const float* VF = (const float*)(P.ws + OFF_VF); const float* SBON = (const float*)(P.ws + OFF_LORA);
    const bf16_t* GB = (const bf16_t*)(P.ws + OFF_MIX + SZB); bf16_t* YB = (bf16_t*)(P.ws + OFF_MIX + 2 * SZB);
    const float* gn_w = P.in[23] + (size_t)i * D; const float* gn_b = P.in[24] + (size_t)i * D;
    for (int r = obid() * 8 + w; r < M; r += gridDim.x * 8) {
#pragma unroll
        for (int q = 0; q < 8; ++q) {
            const int col = 256 * q + 4 * lane; const size_t o = (size_t)r * D + col;
            const u32x2 yv = *(const u32x2*)(YB + o), gv = *(const u32x2*)(GB + o);
            const f32x4 vv = *(const f32x4*)(VF + o);
            const float sb = SBON[(size_t)r * 32 + 4 * q + (lane >> 4)];
            const f32x4 gw = *(const f32x4*)(gn_w + col), gb = *(const f32x4*)(gn_b + col);
            float y[4] = {bf_lo(yv.x), bf_hi(yv.x), bf_lo(yv.y), bf_hi(yv.y)};
            const float gg[4] = {bf_lo(gv.x), bf_hi(gv.x), bf_lo(gv.y), bf_hi(gv.y)};
            float sy = (y[0] + y[1]) + (y[2] + y[3]);
            sy = rowsum16(sy);
            const float mean = sy * (1.0f / 64.0f);
            float sv = 0.f;
#pragma unroll
            for (int e = 0; e < 4; ++e) { y[e] -= mean; sv += y[e] * y[e]; }
            sv = rowsum16(sv);
            const float rstd = rsqrtf(sv * (1.0f / 64.0f) + 64e-5f);
            float z[4];
#pragma unroll
            for (int e = 0; e < 4; ++e) z[e] = (y[e] * rstd * gw[e] + gb[e] + sb * vv[e]) * gg[e];
            u32x2 zo; zo.x = cvt_pk_bf16(z[0], z[1]); zo.y = cvt_pk_bf16(z[2], z[3]);
            *(u32x2*)(YB + o) = zo;
        }
    }
}

__device__ void headnorm_phase(const Params& P, LAS unsigned char* lds) {
    const int tid = otid(), w = tid >> 6, lane = tid & 63;
    const bf16_t* KR = (const bf16_t*)(P.ws + OFF_KF); const bf16_t* VR = (const bf16_t*)(P.ws + OFF_VF);
    bf16_t* KN = (bf16_t*)(P.ws + OFF_MIX + 2 * SZB); bf16_t* VT = (bf16_t*)(P.ws + OFF_DEC);
    const float* kg = P.in[31];
    for (int r = obid() * 8 + w; r < M; r += gridDim.x * 8) {
#pragma unroll
        for (int q = 0; q < 8; ++q) {
            const int col = 256 * q + 4 * lane; const size_t o = (size_t)r * D + col;
            const u32x2 kraw = *(const u32x2*)(KR + o); f32x4 kv; kv[0] = bf_lo(kraw.x); kv[1] = bf_hi(kraw.x); kv[2] = bf_lo(kraw.y); kv[3] = bf_hi(kraw.y);
            float ss = kv[0] * kv[0] + kv[1] * kv[1] + kv[2] * kv[2] + kv[3] * kv[3];
            ss = rowsum16(ss); ss += __shfl_xor(ss, 16);
            const float rs = rsqrtf(ss * (1.0f / 128.0f) + 1e-6f);
            const f32x4 gv = *(const f32x4*)(kg + (col & 127));
            u32x2 a; a.x = cvt_pk_bf16(kv[0] * rs * gv[0], kv[1] * rs * gv[1]); a.y = cvt_pk_bf16(kv[2] * rs * gv[2], kv[3] * rs * gv[3]);
            *(u32x2*)(KN + o) = a;
        }
    }
    LAS float* tile = (LAS float*)lds;
    for (int it = obid(); it < NBATCH * 66 * 16; it += gridDim.x) {
        const int h = it & 15, pt = (it >> 4) % 66, b = it / (16 * 66);
        __syncthreads();
#pragma unroll
        for (int pass = 0; pass < 4; ++pass) {
            const int key = (tid >> 5) + pass * 16, c4 = (tid & 31) * 4;
            const int t = 64 * pt + key - PPAD;
            f32x4 v = (f32x4){0.f, 0.f, 0.f, 0.f};
            if (t >= 0) { const u32x2 vraw = *(const u32x2*)(VR + (size_t)rowof(b, t) * D + 128 * h + c4); v[0] = bf_lo(vraw.x); v[1] = bf_hi(vraw.x); v[2] = bf_lo(vraw.y); v[3] = bf_hi(vraw.y); }
            tile[key * 129 + c4] = v[0]; tile[key * 129 + c4 + 1] = v[1]; tile[key * 129 + c4 + 2] = v[2]; tile[key * 129 + c4 + 3] = v[3];
        }
        __syncthreads();
        const int d = tid >> 2, k16 = (tid & 3) * 16;
        float e[16];
#pragma unroll
        for (int x = 0; x < 16; ++x) e[x] = tile[(k16 + x) * 129 + d];
        u32x4 o0, o1;
        o0.x = cvt_pk_bf16(e[0], e[1]); o0.y = cvt_pk_bf16(e[2], e[3]); o0.z = cvt_pk_bf16(e[4], e[5]); o0.w = cvt_pk_bf16(e[6], e[7]);
        o1.x = cvt_pk_bf16(e[8], e[9]); o1.y = cvt_pk_bf16(e[10], e[11]); o1.z = cvt_pk_bf16(e[12], e[13]); o1.w = cvt_pk_bf16(e[14], e[15]);
        bf16_t* dst = VT + ((size_t)((b * 16 + h) * 128 + d)) * PLEN + 64 * pt + k16;
        *(u32x4*)dst = o0; *(u32x4*)(dst + 8) = o1;
    }
}

__device__ void attn_phase(const Params& P, int j, LAS unsigned char* lds) {
    const int tid = otid(), w = tid >> 6, lane = tid & 63, fr = lane & 15, fq = lane >> 4;
    const bf16_t* QF = (const bf16_t*)(P.ws + OFF_RB);
    const bf16_t* KN = (const bf16_t*)(P.ws + OFF_MIX + 2 * SZB);
    const bf16_t* VT = (const bf16_t*)(P.ws + OFF_DEC);
    bf16_t* OB = (bf16_t*)(P.ws + OFF_MIX);
    const float* qg = P.in[33] + j * 128;
    constexpr int KSTR = 272, VSTR = 144, KBYTES = 64 * KSTR, VBYTES = 128 * VSTR, STGB = KBYTES + VBYTES;
    for (int u = obid(); u < 64 * 33; u += gridDim.x) {
        const int qb = 32 - u / 64, bh = u % 64, b = bh >> 4, h = bh & 15;
        const int pq = 128 * qb + 16 * w + fr, tq = pq - PPAD;
        const int qrow = rowof(b, tq > 0 ? tq : 0);
        bf16x8 qf[4];
        {
            const bf16_t* qp = QF + (size_t)qrow * D + 128 * h + 8 * fq;
            f32x4 qa[4], qc[4]; float ss = 0.f;
#pragma unroll
            for (int s = 0; s < 4; ++s) { const u32x4 qraw = *(const u32x4*)(qp + 32 * s);
                qa[s][0] = bf_lo(qraw.x); qa[s][1] = bf_hi(qraw.x); qa[s][2] = bf_lo(qraw.y); qa[s][3] = bf_hi(qraw.y); qc[s][0] = bf_lo(qraw.z); qc[s][1] = bf_hi(qraw.z); qc[s][2] = bf_lo(qraw.w); qc[s][3] = bf_hi(qraw.w);
                ss += qa[s][0] * qa[s][0] + qa[s][1] * qa[s][1] + qa[s][2] * qa[s][2] + qa[s][3] * qa[s][3] + qc[s][0] * qc[s][0] + qc[s][1] * qc[s][1] + qc[s][2] * qc[s][2] + qc[s][3] * qc[s][3]; }
            ss += __shfl_xor(ss, 16); ss += __shfl_xor(ss, 32);
            const float rs = rsqrtf(ss * (1.0f / 128.0f) + 1e-6f) * 0.08838834764831845f;
#pragma unroll
            for (int s = 0; s < 4; ++s) {
                const f32x4 g0 = *(const f32x4*)(qg + 32 * s + 8 * fq), g1 = *(const f32x4*)(qg + 32 * s + 8 * fq + 4);
                u32x4 pk; pk.x = cvt_pk_bf16(qa[s][0] * rs * g0[0], qa[s][1] * rs * g0[1]); pk.y = cvt_pk_bf16(qa[s][2] * rs * g0[2], qa[s][3] * rs * g0[3]);
                pk.z = cvt_pk_bf16(qc[s][0] * rs * g1[0], qc[s][1] * rs * g1[1]); pk.w = cvt_pk_bf16(qc[s][2] * rs * g1[2], qc[s][3] * rs * g1[3]);
                qf[s] = __builtin_bit_cast(bf16x8, pk);
            }
        }
        f32x4 oacc[8];
#pragma unroll
        for (int x = 0; x < 8; ++x) oacc[x] = (f32x4){0.f, 0.f, 0.f, 0.f};
        float carry = 1.0f;
        u32x4 kr[2], vr[2];
#define ATT_LOAD(kt_) do { _Pragma("unroll") for (int i_ = 0; i_ < 2; ++i_) { const int id_ = tid + 512 * i_; \
            { const int row_ = id_ >> 4, c_ = id_ & 15; const int tk_ = 64 * (kt_) + row_ - PPAD; \
              kr[i_] = *(const u32x4*)(KN + (size_t)rowof(b, tk_ > 0 ? tk_ : 0) * D + 128 * h + 8 * c_); } \
            { const int d_ = id_ >> 3, c_ = id_ & 7; vr[i_] = *(const u32x4*)(VT + ((size_t)(bh * 128 + d_)) * PLEN + 64 * (kt_) + 8 * c_); } } } while (0)
#define ATT_WRITE(st_) do { _Pragma("unroll") for (int i_ = 0; i_ < 2; ++i_) { const int id_ = tid + 512 * i_; \
            *(LAS u32x4*)(lds + (st_) * STGB + (id_ >> 4) * KSTR + 16 * (id_ & 15)) = kr[i_]; \
            *(LAS u32x4*)(lds + (st_) * STGB + KBYTES + (id_ >> 3) * VSTR + 16 * (id_ & 7)) = vr[i_]; } } while (0)
        const int nti = 2 * qb + 1;
        __syncthreads();
        ATT_LOAD(nti); ATT_WRITE(0);
        __syncthreads();
        for (int it = 0; it < nti; ++it) {
            const int kt = nti - it;
            if (it + 1 < nti) ATT_LOAD(kt - 1);
            const LAS unsigned char* Ks = lds + (it & 1) * STGB; const LAS unsigned char* Vs = Ks + KBYTES;
            f32x4 st[4];
#pragma unroll
            for (int n = 0; n < 4; ++n) { st[n] = (f32x4){0.f, 0.f, 0.f, 0.f};
#pragma unroll
                for (int s = 0; s < 4; ++s) { const bf16x8 a = *(const LAS bf16x8*)(Ks + (16 * n + fr) * KSTR + 64 * s + 16 * fq);
                    st[n] = __builtin_amdgcn_mfma_f32_16x16x32_bf16(a, qf[s], st[n], 0, 0, 0); } }
            const bool need_mask = (kt >= 2 * qb) || (kt == 1);
            float kp[4][4], sg[4][4];
#pragma unroll
            for (int n = 0; n < 4; ++n)
#pragma unroll
                for (int e = 0; e < 4; ++e) { const float z = st[n][e]; const float ex = __expf(-fabsf(z)); const float r = __builtin_amdgcn_rcpf(1.0f + ex);
                    const bool pos = z >= 0.f; sg[n][e] = (pos ? 1.0f : ex) * r; kp[n][e] = (pos ? ex : 1.0f) * r; }
            if (need_mask) {
#pragma unroll
                for (int n = 0; n < 4; ++n)
#pragma unroll
                    for (int e = 0; e < 4; ++e) { const int pk = 64 * kt + 16 * n + 4 * fq + e; const bool valid = (pk < pq) && (pk >= PPAD);
                        if (!valid) { kp[n][e] = 1.0f; sg[n][e] = 0.f; } }
            }
            float X[4], Bt[4];
            {
                LAS f32x4* xch = (LAS f32x4*)(lds + 2 * STGB) + w * 64;
                f32x4 Tv;
#pragma unroll
                for (int n = 0; n < 4; ++n) Tv[n] = (kp[n][0] * kp[n][1]) * (kp[n][2] * kp[n][3]);
                xch[lane] = Tv;
                const f32x4 t0 = xch[fr], t1 = xch[fr + 16], t2 = xch[fr + 32], t3 = xch[fr + 48];
#pragma unroll
                for (int n = 0; n < 4; ++n) {
                    X[n] = (fq < 1 ? t1[n] : 1.0f) * (fq < 2 ? t2[n] : 1.0f) * (fq < 3 ? t3[n] : 1.0f);
                    Bt[n] = (t0[n] * t1[n]) * (t2[n] * t3[n]);
                }
            }
            float wgt[4][4]; float run = carry;
#pragma unroll
            for (int n = 3; n >= 0; --n) { const float s3 = run * X[n]; const float s2 = s3 * kp[n][3]; const float s1 = s2 * kp[n][2]; const float s0 = s1 * kp[n][1];
                wgt[n][3] = sg[n][3] * s3; wgt[n][2] = sg[n][2] * s2; wgt[n][1] = sg[n][1] * s1; wgt[n][0] = sg[n][0] * s0;
                run *= Bt[n]; }
            carry = run;
#pragma unroll
            for (int s2 = 0; s2 < 2; ++s2) {
                u32x4 pk; pk.x = cvt_pk_bf16(wgt[2 * s2][0], wgt[2 * s2][1]); pk.y = cvt_pk_bf16(wgt[2 * s2][2], wgt[2 * s2][3]);
                pk.z = cvt_pk_bf16(wgt[2 * s2 + 1][0], wgt[2 * s2 + 1][1]); pk.w = cvt_pk_bf16(wgt[2 * s2 + 1][2], wgt[2 * s2 + 1][3]);
                const bf16x8 pf = __builtin_bit_cast(bf16x8, pk);
#pragma unroll
                for (int db = 0; db < 8; ++db) {
                    const LAS unsigned char* vp = Vs + (16 * db + fr) * VSTR + 64 * s2 + 8 * fq;
                    const u32x2 v0 = *(const LAS u32x2*)vp, v1 = *(const LAS u32x2*)(vp + 32);
                    u32x4 vv; vv.x = v0.x; vv.y = v0.y; vv.z = v1.x; vv.w = v1.y;
                    oacc[db] = __builtin_amdgcn_mfma_f32_16x16x32_bf16(__builtin_bit_cast(bf16x8, vv), pf, oacc[db], 0, 0, 0);
                }
            }
            if (it + 1 < nti) ATT_WRITE((it + 1) & 1);
#ifndef NO_EARLY_EXIT
            LAS int* flg = (LAS int*)(lds + 2 * STGB + 8192) + (it & 1) * 8;
            { const int dead = __all(carry == 0.f); if (lane == 0) flg[w] = dead; }
            __syncthreads();
            { int alld = 1;
#pragma unroll
              for (int x = 0; x < 8; ++x) alld &= flg[x];
              if (alld) break; }
#else
            __syncthreads();
#endif
        }
#undef ATT_LOAD
#undef ATT_WRITE
        if (tq >= 0) {
#pragma unroll
            for (int db = 0; db < 8; ++db) { u32x2 o; o.x = cvt_pk_bf16(oacc[db][0], oacc[db][1]); o.y = cvt_pk_bf16(oacc[db][2], oacc[db][3]);
                *(u32x2*)(OB + (size_t)qrow * D + 128 * h + 16 * db + 4 * fq) = o; }
        }
    }
}

#define XB_TMO      128
#define XB_XCNT(j)  (256  + 64 * (j))
#define XB_XSUB(j)  (1280 + 64 * (j))
#define XB_XGEN(j)  (2304 + 64 * (j))
#define XB_TOP      3328
#define XB_TOPGEN   3392
#define XCD_BAR_WORDS 3456
#define XB_SPIN_CAP (1u << 18)

__device__ __forceinline__ unsigned xb_ld(unsigned* p)              { return __hip_atomic_load(p, __ATOMIC_RELAXED, __HIP_MEMORY_SCOPE_AGENT); }
__device__ __forceinline__ unsigned xb_add(unsigned* p, unsigned v) { return __hip_atomic_fetch_add(p, v, __ATOMIC_RELAXED, __HIP_MEMORY_SCOPE_AGENT); }
__device__ __forceinline__ unsigned xb_xcc_id() { return (unsigned)__builtin_amdgcn_s_getreg((3 << 11) | 20) & 0xFu; }
#define XB_SPIN(cond, bar) do { unsigned _sp = 0; while (cond) { __builtin_amdgcn_s_sleep(1); \
    if ((++_sp & 255u) == 0u) { if (xb_ld(&(bar)[XB_TMO])) break; if (_sp > XB_SPIN_CAP) { atomicAdd(&(bar)[XB_TMO], 1u); break; } } } } while (0)

struct XcdBarrier {
    unsigned* bar; unsigned x;
    volatile LAS unsigned* st;
};

__device__ __forceinline__ XcdBarrier xcd_barrier_post(unsigned* bar, volatile LAS unsigned* st) {
    XcdBarrier b; b.bar = bar; b.x = xb_xcc_id(); b.st = st;
    if (threadIdx.x == 0) (void)xb_add(&bar[XB_XCNT(b.x)], 1u);
    return b;
}
__device__ __forceinline__ void xcd_barrier_complete(unsigned* bar, unsigned x, unsigned& nloc, unsigned& nx) {
    const unsigned G = gridDim.x * gridDim.y * gridDim.z;
    unsigned sum, cnt, mine, sp = 0u;
    for (;;) {
        sum = 0u; cnt = 0u; mine = 0u;
#pragma unroll
        for (unsigned j = 0; j < 16; ++j) { const unsigned c = xb_ld(&bar[XB_XCNT(j)]); sum += c; cnt += (c > 0u) ? 1u : 0u; mine = (j == x) ? c : mine; }
        if (sum == G) break;
        __builtin_amdgcn_s_sleep(1);
        if ((++sp & 255u) == 0u) { if (xb_ld(&bar[XB_TMO])) break; if (sp > XB_SPIN_CAP) { atomicAdd(&bar[XB_TMO], 1u); break; } }
    }
    nloc = mine > 0u ? mine : 1u; nx = cnt > 0u ? cnt : 1u;
}

__device__ __forceinline__ void xcd_barrier(const XcdBarrier& b) {
    asm volatile("s_waitcnt vmcnt(0)" ::: "memory");
    __syncthreads();
    if (threadIdx.x == 0) {
        unsigned* bar = b.bar;
        __builtin_amdgcn_s_waitcnt(0);
        unsigned nloc = b.st[0], nx = b.st[1];
        if (nloc == 0u) { xcd_barrier_complete(bar, b.x, nloc, nx); b.st[0] = nloc; b.st[1] = nx; }
        const unsigned old = xb_add(&bar[XB_XSUB(b.x)], 1u);
        const unsigned gen = old / nloc;
        if (old + 1u == (gen + 1u) * nloc) {
            __builtin_amdgcn_fence(__ATOMIC_RELEASE, "agent");
            asm volatile("s_waitcnt vmcnt(0)" ::: "memory");
            const unsigned og = xb_add(&bar[XB_TOP], 1u);
            const unsigned tg = og / nx;
            if (og + 1u == (tg + 1u) * nx) xb_add(&bar[XB_TOPGEN], 1u);
            else XB_SPIN(xb_ld(&bar[XB_TOPGEN]) == tg, bar);
            __builtin_amdgcn_fence(__ATOMIC_ACQUIRE, "agent");
            xb_add(&bar[XB_XGEN(b.x)], 1u);
            asm volatile("s_waitcnt vmcnt(0)" ::: "memory");
        } else {
            XB_SPIN(xb_ld(&bar[XB_XGEN(b.x)]) == gen, bar);
            __builtin_amdgcn_fence(__ATOMIC_ACQUIRE, "agent");
            asm volatile("s_waitcnt vmcnt(0)" ::: "memory");
        }
    }
    __syncthreads();
}


__device__ __forceinline__ void grid_barrier(unsigned* ctr, unsigned target) {
    asm volatile("s_waitcnt vmcnt(0) lgkmcnt(0)" ::: "memory");
    __syncthreads();
    if (threadIdx.x == 0) {
        __builtin_amdgcn_fence(__ATOMIC_RELEASE, "agent");
        asm volatile("s_waitcnt vmcnt(0)" ::: "memory");
        __hip_atomic_fetch_add(ctr, 1u, __ATOMIC_RELAXED, __HIP_MEMORY_SCOPE_AGENT);
        while (__hip_atomic_load(ctr, __ATOMIC_RELAXED, __HIP_MEMORY_SCOPE_AGENT) < target) __builtin_amdgcn_s_sleep(2);
        __builtin_amdgcn_fence(__ATOMIC_ACQUIRE, "agent");
        asm volatile("s_waitcnt vmcnt(0)" ::: "memory");
    }
    __syncthreads();
}

#ifndef DUP_ATTN
#define DUP_ATTN 0
#endif
#ifndef DUP_FFN1
#define DUP_FFN1 0
#endif
#ifndef DUP_SCAN
#define DUP_SCAN 0
#endif
constexpr int NPHASE = 35 + 2 * DUP_ATTN + 4 * DUP_FFN1 + 2 * DUP_SCAN;
enum { K_INIT = 0, K_MIXPREP, K_GEMM, K_SCAN, K_POST, K_NORMF, K_NORMSB, K_HEADNORM, K_ATTN };
struct Tab { PE e[NPHASE]; };
constexpr GD mkgd(size_t A, size_t Bt, int N, int mode, size_t o0, size_t o1, int bin, int boff, int ldo) {
    GD g{}; g.A = A; g.Bt = Bt; g.o0 = o0; g.o1 = o1; g.N = N; g.mode = mode; g.bin = bin; g.boff = boff; g.ldo = ldo; g.pad = 0; return g;
}
constexpr PE mkgemm(int layer, int sub) {
    PE p{}; p.kind = K_GEMM; p.layer = layer; p.sub = sub; p.ng = 1; p.K = D; p.pad = 0;
    const int i = layer;
    for (int q = 0; q < 4; ++q) p.g[q] = mkgd(0, 0, 256, 0, 0, 0, 0, 0, D);
    if (sub == 0) {
        p.g[0] = mkgd(OFF_MIX, OFF_WA + WA_W0, D, 0, OFF_RB, 0, 0, 0, D);
        p.g[1] = mkgd(OFF_MIX + SZB, OFF_WA + WA_W1, D, 1, OFF_KF, 0, 0, 0, D);
        p.g[2] = mkgd(OFF_MIX + 2 * SZB, OFF_WA + WA_W2, D, i == 0 ? 2 : 1, OFF_VF, OFF_VFIRST, 0, 0, D);
        p.ng = 3;
    } else if (sub == 1) {
        p.g[0] = mkgd(OFF_DEC, OFF_WA + WA_L1 + 0 * WSLOT, 256, 3, OFF_LORA + 0 * SZLORA, 0, 0, 0, 256);
        p.g[1] = mkgd(OFF_DEC + SZB, OFF_WA + WA_L1 + 1 * WSLOT, 256, 0, OFF_LORA + 1 * SZLORA, 0, 0, 0, 256);
        p.g[2] = mkgd(OFF_KF, OFF_WA + WA_L1 + 2 * WSLOT, 256, 4, OFF_LORA + 2 * SZLORA, 0, 0, 0, 256);
        p.ng = 3;
        if (i >= 1) { p.g[3] = mkgd(OFF_MIX + 2 * SZB, OFF_WA + WA_L1 + 3 * WSLOT, 256, 0, OFF_LORA + 3 * SZLORA, 0, 0, 0, 256); p.ng = 4; }
    } else if (sub == 2) {
        p.K = 256;
        p.g[0] = mkgd(OFF_LORA + 0 * SZLORA, OFF_WA + WA_L2 + 0 * WSLOT, D, 5, OFF_DEC, 0, 12, i * D, D);
        p.g[1] = mkgd(OFF_LORA + 1 * SZLORA, OFF_WA + WA_L2 + 1 * WSLOT, D, 6, OFF_MIX, 0, 15, i * D, D);
        p.g[2] = mkgd(OFF_LORA + 2 * SZLORA, OFF_WA + WA_L2 + 2 * WSLOT, D, 0, OFF_MIX + SZB, 0, 0, 0, D);
        p.ng = 3;
        if (i >= 1) { p.g[3] = mkgd(OFF_LORA + 3 * SZLORA, OFF_WA + WA_L2 + 3 * WSLOT, D, 7, OFF_VF, OFF_VFIRST, 25, (i - 1) * D, D); p.ng = 4; }
    } else if (sub == 3) {
        p.g[0] = mkgd(OFF_MIX + 2 * SZB, OFF_WB + WB_WO, D, 8, 0, 0, 0, 0, D);
    } else if (sub == 4) {
        p.g[0] = mkgd(OFF_HN2, OFF_WB + WB_F1, 2 * FF, 9, OFF_ACT, 0, 0, 0, FF);
    } else if (sub == 5) {
        p.K = FF;
        p.g[0] = mkgd(OFF_ACT, OFF_WB + WB_F2, D, 8, 0, 0, 0, 0, D);
    } else if (sub == 6) {
        p.g[0] = mkgd(OFF_MIX, OFF_WA + WA_W0, D, 0, OFF_RB, 0, 0, 0, D);
        if (layer == 2) {
            p.g[1] = mkgd(OFF_MIX + SZB, OFF_WA + WA_W1, D, 0, OFF_KF, 0, 0, 0, D);
            p.g[2] = mkgd(OFF_MIX + SZB, OFF_WA + WA_W2, D, 0, OFF_VF, 0, 0, 0, D);
            p.ng = 3;
        }
    } else {
        p.g[0] = mkgd(OFF_MIX, OFF_WB + WB_WO, D, 8, 0, 0, 0, 0, D);
    }
    return p;
}
constexpr PE mkother(int kind, int layer, int sub) { PE p{}; p.kind = kind; p.layer = layer; p.sub = sub; p.ng = 0; p.K = D; p.pad = 0; for (int q = 0; q < 4; ++q) p.g[q] = mkgd(0, 0, 256, 0, 0, 0, 0, 0, D); return p; }
constexpr Tab make_tab() {
    Tab t{};
    int n = 0;
    for (int i = 0; i < 2; ++i) {
        t.e[n++] = mkother(K_MIXPREP, i, 0);
        t.e[n++] = mkgemm(i, 1);
        t.e[n++] = mkgemm(i, 0);
        t.e[n++] = mkgemm(i, 2);
        t.e[n++] = mkother(K_SCAN, i, 0);
        if (DUP_SCAN) t.e[n++] = mkother(K_SCAN, i, 0);
        t.e[n++] = mkother(K_POST, i, 0);
        t.e[n++] = mkgemm(i, 3);
        t.e[n++] = mkother(K_NORMF, i, 0);
        t.e[n++] = mkgemm(i, 4);
        if (DUP_FFN1) t.e[n++] = mkgemm(i, 4);
        t.e[n++] = mkgemm(i, 5);
    }
    for (int j = 0; j < 2; ++j) {
        const int layer = 2 + j;
        t.e[n++] = mkother(K_NORMSB, layer, 0);
        t.e[n++] = mkgemm(layer, 6);
        if (j == 0) t.e[n++] = mkother(K_HEADNORM, layer, 0);
        t.e[n++] = mkother(K_ATTN, layer, 0);
        if (DUP_ATTN) t.e[n++] = mkother(K_ATTN, layer, 0);
        t.e[n++] = mkgemm(layer, 7);
        t.e[n++] = mkother(K_NORMF, layer, 0);
        t.e[n++] = mkgemm(layer, 4);
        if (DUP_FFN1) t.e[n++] = mkgemm(layer, 4);
        t.e[n++] = mkgemm(layer, 5);
    }
    return t;
}
__constant__ const Tab TAB = make_tab();

#ifndef ONLY
#define ONLY -1
#endif
#define EN(k) (ONLY < 0 || ONLY == (k))

__global__ void __launch_bounds__(512, 2) mk_forward(Params P, int ph_lo, int ph_hi) {
    extern __shared__ __attribute__((aligned(16))) unsigned char shm[];
    LAS unsigned char* lds = (LAS unsigned char*)shm;
    cg::grid_group grid = cg::this_grid();
    __shared__ uint4 xb_words;
    if (threadIdx.x == 0) xb_words = make_uint4(0u, 0u, 0u, 0u);
    unsigned* const xbar = (unsigned*)(P.ws + WS_END);
    XcdBarrier xb; xb.bar = xbar; xb.x = 0; xb.st = (volatile LAS unsigned*)&xb_words;
    for (int ph = ph_lo; ph < ph_hi; ++ph) {
        const PE* pe = &TAB.e[ph];
        const int kind = pe->kind, layer = pe->layer, sub = pe->sub;
        if (kind == K_GEMM) { if (EN(K_GEMM)) {
            const bool tail_first = (blockIdx.x & 1) != 0;
            if (tail_first) { tail_gemm(lds, pe, P); __syncthreads(); }
            gemm_phase(lds, pe, P);
            if (!tail_first) tail_gemm(lds, pe, P); } }
        else if (!EN(kind)) {}
        else if (kind == K_MIXPREP) { mixprep_phase(P, layer); convert_layer(P, layer, lds); }
        else if (kind == K_SCAN) scan_phase(P, layer, lds);
        else if (kind == K_POST) post_phase(P, layer);
        else if (kind == K_NORMF) norm_phase(P, P.in[3] + (size_t)layer * D, (bf16_t*)(P.ws + OFF_HN2), nullptr, nullptr);
        else if (kind == K_NORMSB) {
            norm_phase(P, P.in[2] + (size_t)layer * D, (bf16_t*)(P.ws + OFF_MIX), layer == 2 ? P.in[28] : nullptr, (bf16_t*)(P.ws + OFF_MIX + SZB));
            convert_layer(P, layer, lds);
        }
        else if (kind == K_HEADNORM) { if (layer == 2) headnorm_phase(P, lds); }
        else if (kind == K_ATTN) attn_phase(P, layer - 2, lds);
        if (ph + 1 < ph_hi) {
#ifdef USE_CG_SYNC
            grid.sync();
#else
            if (ph == ph_lo) {
                if (blockIdx.x == 0) for (int q = threadIdx.x; q < XCD_BAR_WORDS; q += NTHR) __hip_atomic_store(xbar + q, 0u, __ATOMIC_RELAXED, __HIP_MEMORY_SCOPE_AGENT);
                grid.sync();
                xb = xcd_barrier_post(xbar, (volatile LAS unsigned*)&xb_words);
            }
            else xcd_barrier(xb);
#endif
        }
    }
}

__global__ void dbg_copy(Params P, size_t off_bf16a, size_t off_bf16b, size_t off_f32) {
    const size_t n = (size_t)MMAIN * D;
    for (size_t i = (size_t)blockIdx.x * blockDim.x + threadIdx.x; i < n; i += (size_t)gridDim.x * blockDim.x) {
        float v = 0.f;
        if (off_bf16a) v += __uint_as_float(((unsigned)((const bf16_t*)(P.ws + off_bf16a))[i]) << 16);
        if (off_bf16b) v += __uint_as_float(((unsigned)((const bf16_t*)(P.ws + off_bf16b))[i]) << 16);
        if (off_f32) v += ((const float*)(P.ws + off_f32))[i];
        P.out[i] = v;
    }
}
extern "C" void kernel_launch(void* const* d_in, const int* in_sizes, int n_in, void* d_out, int out_size, void* d_ws, size_t ws_size, hipStream_t stream) {
    constexpr size_t kDynLds = 131072;
    static int grid_blocks = 0;
    if (!grid_blocks) {
        hipFuncSetAttribute((const void*)mk_forward, hipFuncAttributeMaxDynamicSharedMemorySize, (int)kDynLds);
        int dev = 0, cus = 0, per_cu = 0;
        hipGetDevice(&dev);
        hipDeviceGetAttribute(&cus, hipDeviceAttributeMultiprocessorCount, dev);
        hipOccupancyMaxActiveBlocksPerMultiprocessor(&per_cu, mk_forward, NTHR, kDynLds);
        if (per_cu < 1) per_cu = 1;
        grid_blocks = cus * per_cu;
        if (ws_size < WS_END) fprintf(stderr, "workspace too small: %zu < %zu\n", ws_size, (size_t)WS_END);
    }
    Params p{};
    for (int i = 0; i < 35; ++i) p.in[i] = (const float*)d_in[i];
    p.out = (float*)d_out; p.ws = (unsigned char*)d_ws;
#ifdef MULTI_LAUNCH
    for (int ph = 0; ph < NPHASE; ++ph) hipLaunchKernelGGL(mk_forward, dim3(grid_blocks), dim3(NTHR), kDynLds, stream, p, ph, ph + 1);
#ifdef DBG_A
    hipLaunchKernelGGL(dbg_copy, dim3(2048), dim3(256), 0, stream, p, (size_t)DBG_A, (size_t)DBG_B, (size_t)DBG_F);
#endif
#else
    int lo = 0, hi = NPHASE;
    void* args[] = {&p, &lo, &hi};
    hipError_t e = hipLaunchCooperativeKernel((void*)mk_forward, dim3(grid_blocks), dim3(NTHR), args, kDynLds, stream);
    if (e != hipSuccess) fprintf(stderr, "cooperative launch failed: %s (grid %d)\n", hipGetErrorString(e), grid_blocks);
#endif
}
```

```cpp
#include <hip/hip_runtime.h>
#include <hip/hip_cooperative_groups.h>
#include <cstdio>
namespace cg = cooperative_groups;

#define LAS __attribute__((address_space(3)))
typedef unsigned short bf16_t;
typedef short bf16x8 __attribute__((ext_vector_type(8)));
typedef float f32x4 __attribute__((ext_vector_type(4)));
typedef unsigned u32x2 __attribute__((ext_vector_type(2)));
typedef unsigned u32x4 __attribute__((ext_vector_type(4)));

constexpr int D = 2048, FF = 5632, NBATCH = 4, SEQ = 4096, NMETA = 16, L = SEQ + NMETA;
constexpr int M = NBATCH * L;
constexpr int MMAIN = NBATCH * SEQ;
constexpr int MP = 16640;
constexpr int NTHR = 512;
constexpr int PPAD = 112, PLEN = 4224;

constexpr size_t SZB = (size_t)MP * D * 2, SZF = 2 * SZB;
constexpr size_t OFF_WA = 0;
constexpr size_t OFF_WB = 37748736;
constexpr size_t OFF_HT = OFF_WB + 83886080;
constexpr size_t OFF_RB = OFF_HT + 1048576;
constexpr size_t OFF_VFIRST = OFF_RB + SZB;
constexpr size_t OFF_KF = OFF_VFIRST + SZB;
constexpr size_t OFF_VF = OFF_KF + SZF;
constexpr size_t OFF_DEC = OFF_VF + SZF;
constexpr size_t OFF_MIX = OFF_DEC + SZF;
constexpr size_t OFF_LORA = OFF_MIX + 3 * SZB;
constexpr size_t SZLORA = (size_t)MP * 256 * 2;
constexpr size_t WS_END = OFF_LORA + 4 * SZLORA;
constexpr size_t OFF_HN2 = OFF_KF, OFF_ACT = OFF_KF + SZB;
constexpr size_t WA_W0 = 0, WA_W1 = 8388608, WA_W2 = 16777216, WA_L1 = 25165824, WA_L2 = 29360128, WSLOT = 1048576;
constexpr size_t WB_WO = 0, WB_F1 = 8388608, WB_F2 = WB_F1 + (size_t)2 * FF * D * 2;

struct Params {
    const float* in[35];
    float* out;
    unsigned char* ws;
};

__device__ __forceinline__ int rowof(int b, int t) { return t < NMETA ? MMAIN + b * NMETA + t : b * SEQ + (t - NMETA); }
__device__ __forceinline__ float* hrow(const Params& P, int r) {
    return r < MMAIN ? P.out + (size_t)r * D : (float*)(P.ws + OFF_HT) + (size_t)(r - MMAIN) * D;
}
__device__ __forceinline__ unsigned cvt_pk_bf16(float lo, float hi) { unsigned r; asm volatile("v_cvt_pk_bf16_f32 %0, %1, %2" : "=v"(r) : "v"(lo), "v"(hi)); return r; }
__device__ __forceinline__ float bf_lo(unsigned x) { return __uint_as_float(x << 16); }
__device__ __forceinline__ float bf_hi(unsigned x) { return __uint_as_float(x & 0xffff0000u); }
template <int CTRL> __device__ __forceinline__ float dpp_mov(float x) {
    return __int_as_float(__builtin_amdgcn_update_dpp(0, __float_as_int(x), CTRL, 0xF, 0xF, true));
}
__device__ __forceinline__ float rowsum16(float x) {
    x += dpp_mov<0x128>(x); x += dpp_mov<0x124>(x); x += dpp_mov<0x122>(x); x += dpp_mov<0x121>(x); return x;
}
__device__ __forceinline__ float wavesum(float x) { x = rowsum16(x); x += __shfl_xor(x, 16); x += __shfl_xor(x, 32); return x; }
__device__ __forceinline__ int otid() { int t = threadIdx.x; asm volatile("" : "+v"(t)); return t; }
__device__ __forceinline__ int obid() { int t = blockIdx.x; asm volatile("" : "+s"(t)); return t; }
__device__ __forceinline__ float sigmoidf_(float x) { return 1.0f / (1.0f + __expf(-x)); }

constexpr int BM = 256, BK = 64, HALF = 128, HTB = HALF * BK * 2, NXCD = 8, WGM = 8, NMT = MMAIN / BM;
__device__ __forceinline__ int lds_byte(int r, int c) { const int st = (r >> 4) * 2 + (c >> 5), rr = r & 15, cc = c & 31, ob = rr * 64 + cc * 2; return st * 1024 + (ob ^ (((ob >> 9) & 1) << 5)); }
__device__ __forceinline__ void stage_rc(int b, int& R, int& C) { const int st = b / 1024, sb = b % 1024, swz = sb ^ (((sb >> 9) & 1) << 5); R = (st >> 1) * 16 + swz / 64; C = (st & 1) * 32 + (swz % 64) / 2; }

struct GD { unsigned long long A, Bt, o0, o1; int N, mode, bin, boff, ldo, pad; };
struct PE { int kind, layer, sub, ng, K, pad; GD g[4]; };
struct Unit { int pm, pn, gi; };

__device__ __forceinline__ bool sched_next(const int Lx, const int c1, const int c2, const int c3, const int c4, Unit& u) {
    if (Lx >= c4) return false;
    int gi = 0, base = 0, top = c1;
    if (Lx >= c1) { gi = 1; base = c1; top = c2; }
    if (Lx >= c2) { gi = 2; base = c2; top = c3; }
    if (Lx >= c3) { gi = 3; base = c3; top = c4; }
    const int nM = NMT, nwg = top - base, nN = nwg / NMT;
    int wgid = Lx - base; { const int q = nwg / NXCD, r = nwg % NXCD, xcd = wgid % NXCD, off = wgid / NXCD; wgid = (xcd < r ? xcd * (q + 1) : r * (q + 1) + (xcd - r) * q) + off; }
    const int nig = WGM * nN, gid = wgid / nig, fm = gid * WGM, gsz = (nM - fm) < WGM ? (nM - fm) : WGM;
    u.pm = fm + ((wgid % nig) % gsz); u.pn = (wgid % nig) / gsz; u.gi = gi; return true;
}

template <int MODE>
__device__ __forceinline__ void epi_elem(const int r, const int c, f32x4 v, void* g_o0, void* g_o1, const f32x4 bv, const int ldo, float* outp, float* htp) {
    if constexpr (MODE == 8) {
        float* p = (r < MMAIN ? outp + (size_t)r * D : htp + (size_t)(r - MMAIN) * D) + c; f32x4 hv = *(f32x4*)p; *(f32x4*)p = hv + v;
    } else if constexpr (MODE == 1) {
        *(f32x4*)((float*)g_o0 + (size_t)r * ldo + c) = v;
    } else if constexpr (MODE == 2) {
        *(f32x4*)((float*)g_o0 + (size_t)r * ldo + c) = v;
        u32x2 wv; wv.x = cvt_pk_bf16(v[0], v[1]); wv.y = cvt_pk_bf16(v[2], v[3]);
        *(u32x2*)((bf16_t*)g_o1 + (size_t)r * ldo + c) = wv;
    } else if constexpr (MODE == 5) {
        f32x4 o;
#pragma unroll
        for (int e = 0; e < 4; ++e) { const float x = -(bv[e] + v[e]); const float sp = fmaxf(x, 0.f) + __logf(1.0f + __expf(-fabsf(x))); const float wl = -sp - 0.5f; o[e] = __expf(-__expf(wl)); }
        *(f32x4*)((float*)g_o0 + (size_t)r * ldo + c) = o;
    } else if constexpr (MODE == 7) {
        float* vp = (float*)g_o0 + (size_t)r * ldo + c; const f32x4 vv = *(f32x4*)vp;
        const u32x2 vf = *(const u32x2*)((const bf16_t*)g_o1 + (size_t)r * ldo + c);
        const float f0 = bf_lo(vf.x), f1 = bf_hi(vf.x), f2 = bf_lo(vf.y), f3 = bf_hi(vf.y);
        f32x4 o;
        o[0] = vv[0] + (f0 - vv[0]) * sigmoidf_(bv[0] + v[0]); o[1] = vv[1] + (f1 - vv[1]) * sigmoidf_(bv[1] + v[1]);
        o[2] = vv[2] + (f2 - vv[2]) * sigmoidf_(bv[2] + v[2]); o[3] = vv[3] + (f3 - vv[3]) * sigmoidf_(bv[3] + v[3]);
        *(f32x4*)vp = o;
    } else {
        if constexpr (MODE == 3) {
#pragma unroll
            for (int e = 0; e < 4; ++e) { const float ax = fminf(fabsf(v[e]), 15.0f); const float t = 1.0f - 2.0f / (__expf(2.0f * ax) + 1.0f); v[e] = v[e] < 0.f ? -t : t; } }
        else if constexpr (MODE == 4) { v[0] = sigmoidf_(v[0]); v[1] = sigmoidf_(v[1]); v[2] = sigmoidf_(v[2]); v[3] = sigmoidf_(v[3]); }
        else if constexpr (MODE == 6) { v[0] = sigmoidf_(bv[0] + v[0]); v[1] = sigmoidf_(bv[1] + v[1]); v[2] = sigmoidf_(bv[2] + v[2]); v[3] = sigmoidf_(bv[3] + v[3]); }
        u32x2 wv; wv.x = cvt_pk_bf16(v[0], v[1]); wv.y = cvt_pk_bf16(v[2], v[3]);
        *(u32x2*)((bf16_t*)g_o0 + (size_t)r * ldo + c) = wv;
    }
}
__device__ __forceinline__ void epi_swiglu(const int r, const int oc, const f32x4 g, const f32x4 up, void* g_o0, const int ldo) {
    float o[4];
#pragma unroll
    for (int e = 0; e < 4; ++e) o[e] = g[e] * __builtin_amdgcn_rcpf(1.0f + __expf(-g[e])) * up[e];
    u32x2 wv; wv.x = cvt_pk_bf16(o[0], o[1]); wv.y = cvt_pk_bf16(o[2], o[3]);
    *(u32x2*)((bf16_t*)g_o0 + (size_t)r * ldo + oc) = wv;
}
template <int MODE>
__device__ __forceinline__ void epi_t(const f32x4 (&acc)[2][2][4][2], void* g_o0, void* g_o1, const float* g_bias, const int ldo, const int u_pm, const int u_pn, int wr, int wc, int fr, int fq, float* outp, float* htp) {
    const int row0 = u_pm * BM + wr * 64 + fr, col0 = u_pn * BM + wc * 32 + 4 * fq;
    f32x4 bvv[2][2];
#pragma unroll
    for (int bj = 0; bj < 2; ++bj)
#pragma unroll
        for (int n = 0; n < 2; ++n) bvv[bj][n] = (MODE == 5 || MODE == 6 || MODE == 7) ? *(const f32x4*)(g_bias + col0 + bj * HALF + n * 16) : (f32x4){0.f, 0.f, 0.f, 0.f};
    if constexpr (MODE == 7) {
#pragma unroll
        for (int ai = 0; ai < 2; ++ai) {
#pragma unroll
            for (int mh = 0; mh < 2; ++mh) {
                f32x4 vv[2][2][2]; u32x2 vf[2][2][2];
#pragma unroll
                for (int ml = 0; ml < 2; ++ml) { const size_t o = (size_t)(row0 + ai * HALF + (2 * mh + ml) * 16) * ldo + col0;
#pragma unroll
                    for (int bj = 0; bj < 2; ++bj)
#pragma unroll
                        for (int n = 0; n < 2; ++n) { vv[ml][bj][n] = *(const f32x4*)((const float*)g_o0 + o + bj * HALF + n * 16); vf[ml][bj][n] = *(const u32x2*)((const bf16_t*)g_o1 + o + bj * HALF + n * 16); } }
#pragma unroll
                for (int ml = 0; ml < 2; ++ml) { const size_t o = (size_t)(row0 + ai * HALF + (2 * mh + ml) * 16) * ldo + col0;
#pragma unroll
                    for (int bj = 0; bj < 2; ++bj)
#pragma unroll
                        for (int n = 0; n < 2; ++n) { const f32x4 a = acc[ai][bj][2 * mh + ml][n], x = vv[ml][bj][n], bb = bvv[bj][n]; const u32x2 f = vf[ml][bj][n];
                            f32x4 ov;
                            ov[0] = x[0] + (bf_lo(f.x) - x[0]) * sigmoidf_(bb[0] + a[0]); ov[1] = x[1] + (bf_hi(f.x) - x[1]) * sigmoidf_(bb[1] + a[1]);
                            ov[2] = x[2] + (bf_lo(f.y) - x[2]) * sigmoidf_(bb[2] + a[2]); ov[3] = x[3] + (bf_hi(f.y) - x[3]) * sigmoidf_(bb[3] + a[3]);
                            *(f32x4*)((float*)g_o0 + o + bj * HALF + n * 16) = ov; } }
            }
        }
        return;
    }
    if constexpr (MODE == 8) {
#pragma unroll
        for (int ai = 0; ai < 2; ++ai) {
            f32x4 hv[4][2][2];
#pragma unroll
            for (int m = 0; m < 4; ++m) { const int r = row0 + ai * HALF + m * 16; float* p = (r < MMAIN ? outp + (size_t)r * D : htp + (size_t)(r - MMAIN) * D) + col0;
#pragma unroll
                for (int bj = 0; bj < 2; ++bj)
#pragma unroll
                    for (int n = 0; n < 2; ++n) hv[m][bj][n] = *(const f32x4*)(p + bj * HALF + n * 16); }
#pragma unroll
            for (int m = 0; m < 4; ++m) { const int r = row0 + ai * HALF + m * 16; float* p = (r < MMAIN ? outp + (size_t)r * D : htp + (size_t)(r - MMAIN) * D) + col0;
#pragma unroll
                for (int bj = 0; bj < 2; ++bj)
#pragma unroll
                    for (int n = 0; n < 2; ++n) *(f32x4*)(p + bj * HALF + n * 16) = hv[m][bj][n] + acc[ai][bj][m][n]; }
        }
        return;
    }
#pragma unroll
    for (int ai = 0; ai < 2; ++ai) {
#pragma unroll
        for (int m = 0; m < 4; ++m) {
            const int r = row0 + ai * HALF + m * 16;
            if constexpr (MODE == 9) {
#pragma unroll
                for (int bj = 0; bj < 2; ++bj)
                    epi_swiglu(r, 16 * (u_pn * 8 + bj * 4 + wc) + 4 * fq, acc[ai][bj][m][0], acc[ai][bj][m][1], g_o0, ldo);
            } else if constexpr (MODE == 8 || MODE == 7) {
            } else {
#pragma unroll
                for (int bj = 0; bj < 2; ++bj) {
#pragma unroll
                    for (int n = 0; n < 2; ++n)
                        epi_elem<MODE>(r, col0 + bj * HALF + n * 16, acc[ai][bj][m][n], g_o0, g_o1, bvv[bj][n], ldo, outp, htp);
                }
            }
        }
    }
}
#define EPI_CALL(MD) epi_t<MD>(acc, g_o0, g_o1, g_bias, ldo, u_pm, u_pn, wr, wc, fr, fq, outp, htp)
__device__ __forceinline__ void epilogue(const f32x4 (&acc)[2][2][4][2], const int mode, void* g_o0, void* g_o1, const float* g_bias, const int ldo, const int u_pm, const int u_pn, int wr, int wc, int fr, int fq, float* outp, float* htp) {
    switch (mode) {
        case 0: EPI_CALL(0); break;
        case 1: EPI_CALL(1); break;
        case 2: EPI_CALL(2); break;
        case 3: EPI_CALL(3); break;
        case 4: EPI_CALL(4); break;
        case 5: EPI_CALL(5); break;
        case 6: EPI_CALL(6); break;
        case 7: EPI_CALL(7); break;
        case 8: EPI_CALL(8); break;
        default: EPI_CALL(9); break;
    }
}

__device__ __forceinline__ void gemm_phase(LAS unsigned char* lds, const PE* pe, const Params& P) {
    const int tid = threadIdx.x, wid = __builtin_amdgcn_readfirstlane(tid >> 6), lane = tid & 63, wr = wid >> 2, wc = wid & 3, fr = lane & 15, fq = lane >> 4;
    const int K = pe->K, nt = K / BK;
    const int sG = (int)gridDim.x, sC = (int)blockIdx.x, s_ng = pe->ng;
    const int sc1 = NMT * (pe->g[0].N / BM);
    const int sc2 = sc1 + (s_ng > 1 ? NMT * (pe->g[1].N / BM) : 0);
    const int sc3 = sc2 + (s_ng > 2 ? NMT * (pe->g[2].N / BM) : 0);
    const int sc4 = sc3 + (s_ng > 3 ? NMT * (pe->g[3].N / BM) : 0);
    unsigned char* const ws = P.ws;
    unsigned voff[2];
#pragma unroll
    for (int i = 0; i < 2; ++i) { int R, C; stage_rc(tid * 16 + i * 8192, R, C); voff[i] = (unsigned)(R * K + C) * 2u; }
    const size_t kstep = (size_t)(BK * 2);
    const size_t hstep = (size_t)HALF * K * 2;
    const size_t tstep = 2 * hstep;
    const unsigned ldsw = (unsigned)wid * 1024u;
    const int aoff = lds_byte(wr * 64 + fr, fq * 8), boff = lds_byte(wc * 32 + fr, fq * 8);
#define PG8_SA(b, h) (((b) * 2 + (h)) * HTB)
#define PG8_SB(b, h) ((4 + (b) * 2 + (h)) * HTB)
#define PG8_STAGE(bufoff, gbase) do { _Pragma("unroll") for (int _i = 0; _i < 2; ++_i) \
        __builtin_amdgcn_global_load_lds((const unsigned*)((const char*)(gbase) + voff[_i]), (LAS unsigned*)(lds + (bufoff) + ldsw + _i * 8192), 16, 0, 0); } while (0)
#define PG8_LDA(dst, b, h) do { _Pragma("unroll") for (int m = 0; m < 4; ++m) _Pragma("unroll") for (int k = 0; k < 2; ++k) dst[m][k] = *(const LAS bf16x8*)(lds + PG8_SA(b, h) + aoff + m * 2048 + k * 1024); } while (0)
#define PG8_LDB(dst, b, h) do { _Pragma("unroll") for (int n = 0; n < 2; ++n) _Pragma("unroll") for (int k = 0; k < 2; ++k) dst[n][k] = *(const LAS bf16x8*)(lds + PG8_SB(b, h) + boff + n * 2048 + k * 1024); } while (0)
#define PG8_MMA(ai, bj, At, Bt) do { __builtin_amdgcn_s_setprio(1); _Pragma("unroll") for (int m = 0; m < 4; ++m) _Pragma("unroll") for (int n = 0; n < 2; ++n) _Pragma("unroll") for (int k = 0; k < 2; ++k) \
        acc[ai][bj][m][n] = __builtin_amdgcn_mfma_f32_16x16x32_bf16(Bt[n][k], At[m][k], acc[ai][bj][m][n], 0, 0, 0); __builtin_amdgcn_s_setprio(0); } while (0)
#define PG8_WAIT_V(n) asm volatile("s_waitcnt vmcnt(" #n ")" ::: "memory")
#define PG8_WAIT_L(n) asm volatile("s_waitcnt lgkmcnt(" #n ")" ::: "memory")
#define PG8_BAR __builtin_amdgcn_s_barrier()
#define PG8_SCHED __builtin_amdgcn_sched_barrier(0)
    Unit cur, nxt; int ui = 0;
    if (!sched_next(sC, sc1, sc2, sc3, sc4, cur)) return;
    f32x4 acc[2][2][4][2];
#pragma unroll
    for (int a = 0; a < 2; ++a)
#pragma unroll
        for (int b = 0; b < 2; ++b)
#pragma unroll
            for (int m = 0; m < 4; ++m)
#pragma unroll
                for (int n = 0; n < 2; ++n) acc[a][b][m][n] = (f32x4){0.f, 0.f, 0.f, 0.f};
    bf16x8 At[4][2], B0[2][2], B1[2][2];
    const char* cA = (const char*)ws + pe->g[cur.gi].A + (size_t)cur.pm * tstep; const char* cB = (const char*)ws + pe->g[cur.gi].Bt + (size_t)cur.pn * tstep;
    PG8_STAGE(PG8_SB(0, 0), cB); PG8_STAGE(PG8_SA(0, 0), cA); PG8_STAGE(PG8_SB(0, 1), cB + hstep); PG8_STAGE(PG8_SA(0, 1), cA + hstep);
    if (wr == 1) PG8_BAR;
    PG8_WAIT_V(4); PG8_BAR;
    PG8_STAGE(PG8_SB(1, 0), cB + kstep); PG8_STAGE(PG8_SA(1, 0), cA + kstep); PG8_STAGE(PG8_SB(1, 1), cB + hstep + kstep);
    PG8_WAIT_V(6); PG8_BAR;
    for (;;) {
        const bool has_next = sched_next((ui + 1) * sG + sC, sc1, sc2, sc3, sc4, nxt);
        const char* nA = cA; const char* nB = cB;
        if (has_next) { nA = (const char*)ws + pe->g[nxt.gi].A + (size_t)nxt.pm * tstep; nB = (const char*)ws + pe->g[nxt.gi].Bt + (size_t)nxt.pn * tstep; }
        for (int t = 0; t < nt; t += 2) {
            const bool last = (t == nt - 2);
            const char* a1 = cA + (size_t)(t + 1) * kstep;
            const char* a2 = last ? nA : cA + (size_t)(t + 2) * kstep; const char* b2 = last ? nB : cB + (size_t)(t + 2) * kstep;
            const char* a3 = a2 + kstep; const char* b3 = b2 + kstep;
            PG8_LDB(B0, 0, 0); PG8_SCHED; PG8_LDA(At, 0, 0); PG8_STAGE(PG8_SA(1, 1), a1 + hstep);
            PG8_WAIT_L(8); PG8_BAR; PG8_WAIT_L(0); PG8_MMA(0, 0, At, B0); PG8_BAR; PG8_SCHED;
            PG8_LDB(B1, 0, 1); PG8_STAGE(PG8_SB(0, 0), b2);
            PG8_BAR; PG8_WAIT_L(0); PG8_MMA(0, 1, At, B1); PG8_BAR;
            PG8_LDA(At, 0, 1); PG8_STAGE(PG8_SA(0, 0), a2);
            PG8_BAR; PG8_WAIT_L(0); PG8_MMA(1, 0, At, B0); PG8_BAR; PG8_SCHED;
            PG8_STAGE(PG8_SB(0, 1), b2 + hstep);
            PG8_WAIT_V(6); PG8_BAR; PG8_MMA(1, 1, At, B1); PG8_BAR;
            PG8_LDB(B0, 1, 0); PG8_SCHED; PG8_LDA(At, 1, 0); PG8_STAGE(PG8_SA(0, 1), a2 + hstep);
            PG8_WAIT_L(8); PG8_BAR; PG8_WAIT_L(0); PG8_MMA(0, 0, At, B0); PG8_BAR; PG8_SCHED;
            PG8_LDB(B1, 1, 1); PG8_STAGE(PG8_SB(1, 0), b3);
            PG8_BAR; PG8_WAIT_L(0); PG8_MMA(0, 1, At, B1); PG8_BAR;
            PG8_LDA(At, 1, 1); PG8_STAGE(PG8_SA(1, 0), a3);
            PG8_BAR; PG8_WAIT_L(0); PG8_MMA(1, 0, At, B0); PG8_BAR; PG8_SCHED;
            PG8_STAGE(PG8_SB(1, 1), b3 + hstep);
            PG8_WAIT_V(6); PG8_BAR; PG8_MMA(1, 1, At, B1); PG8_BAR;
        }
        { const GD* gd = &pe->g[cur.gi];
          epilogue(acc, gd->mode, ws + gd->o0, ws + gd->o1, P.in[gd->bin] + gd->boff, gd->ldo, cur.pm, cur.pn, wr, wc, fr, fq, P.out, (float*)(ws + OFF_HT)); }
        if (!has_next) break;
#pragma unroll
        for (int a = 0; a < 2; ++a)
#pragma unroll
            for (int b = 0; b < 2; ++b)
#pragma unroll
                for (int m = 0; m < 4; ++m)
#pragma unroll
                    for (int n = 0; n < 2; ++n) acc[a][b][m][n] = (f32x4){0.f, 0.f, 0.f, 0.f};
        cur = nxt; cA = nA; cB = nB; ++ui;
    }
    PG8_WAIT_V(0);
    if (wr == 0) PG8_BAR;
    PG8_BAR;
#undef PG8_SA
#undef PG8_SB
#undef PG8_STAGE
#undef PG8_LDA
#undef PG8_LDB
#undef PG8_MMA
#undef PG8_WAIT_V
#undef PG8_WAIT_L
#undef PG8_BAR
#undef PG8_SCHED
}

#define TE_CALL(MD) epi_elem<MD>(r, c, v, o0, o1, bvt, ldo, P.out, (float*)(ws + OFF_HT))
__device__ void tail_gemm(LAS unsigned char* lds, const PE* pe, const Params& P) {
    const int tid = otid(), w = tid >> 6, lane = tid & 63, fr = lane & 15, fq = lane >> 4;
    unsigned char* const ws = P.ws;
    const int K = pe->K, ks = K >> 3, nstep = ks >> 5, ng = pe->ng;
    const int t1 = pe->g[0].N >> 4;
    const int t2 = t1 + (ng > 1 ? pe->g[1].N >> 4 : 0);
    const int t3 = t2 + (ng > 2 ? pe->g[2].N >> 4 : 0);
    const int t4 = t3 + (ng > 3 ? pe->g[3].N >> 4 : 0);
    LAS f32x4* part = (LAS f32x4*)lds;
    const int bid_ = obid();
    const int rank_ = (bid_ & 1) ? (bid_ >> 1) : ((int)(gridDim.x >> 1) + (bid_ >> 1));
    for (int item = rank_; item < t4; item += gridDim.x) {
        int gi = 0, base = 0;
        if (item >= t1) { gi = 1; base = t1; }
        if (item >= t2) { gi = 2; base = t2; }
        if (item >= t3) { gi = 3; base = t3; }
        const int cb = (item - base) >> 1, mh = (item - base) & 1;
        const GD* gd = &pe->g[gi];
        const bf16_t* A = (const bf16_t*)(ws + gd->A) + (size_t)(MMAIN + 32 * mh + fr) * K + (size_t)w * ks + 8 * fq;
        const bf16_t* Bt = (const bf16_t*)(ws + gd->Bt) + (size_t)(32 * cb + fr) * K + (size_t)w * ks + 8 * fq;
        const size_t r16 = (size_t)16 * K;
        f32x4 acc[2][2];
#pragma unroll
        for (int m = 0; m < 2; ++m) { acc[m][0] = (f32x4){0.f, 0.f, 0.f, 0.f}; acc[m][1] = acc[m][0]; }
        for (int s0 = 0; s0 < nstep; s0 += 8) {
            bf16x8 af[8][2], bfr[8][2];
#pragma unroll
            for (int s = 0; s < 8; ++s) if (s0 + s < nstep) {
                const int k0 = (s0 + s) * 32;
                af[s][0] = *(const bf16x8*)(A + k0); af[s][1] = *(const bf16x8*)(A + r16 + k0);
                bfr[s][0] = *(const bf16x8*)(Bt + k0); bfr[s][1] = *(const bf16x8*)(Bt + r16 + k0);
            }
#pragma unroll
            for (int s = 0; s < 8; ++s) if (s0 + s < nstep) {
#pragma unroll
                for (int m = 0; m < 2; ++m)
#pragma unroll
                    for (int nb = 0; nb < 2; ++nb) acc[m][nb] = __builtin_amdgcn_mfma_f32_16x16x32_bf16(bfr[s][nb], af[s][m], acc[m][nb], 0, 0, 0);
            }
        }
        __syncthreads();
#pragma unroll
        for (int m = 0; m < 2; ++m)
#pragma unroll
            for (int nb = 0; nb < 2; ++nb) part[(w * 4 + m * 2 + nb) * 64 + lane] = acc[m][nb];
        __syncthreads();
        if (tid < 256) {
            const int ml = tid >> 7, nb2 = (tid >> 6) & 1;
            f32x4 v = part[(ml * 2 + nb2) * 64 + lane];
#pragma unroll
            for (int x = 1; x < 8; ++x) v += part[(x * 4 + ml * 2 + nb2) * 64 + lane];
            const int r = MMAIN + 32 * mh + 16 * ml + fr, c = 32 * cb + 16 * nb2 + 4 * fq;
            const int mode = gd->mode, ldo = gd->ldo;
            void* o0 = ws + gd->o0; void* o1 = ws + gd->o1; const float* bias = P.in[gd->bin] + gd->boff;
            const f32x4 bvt = (mode == 5 || mode == 6 || mode == 7) ? *(const f32x4*)(bias + c) : (f32x4){0.f, 0.f, 0.f, 0.f};
            if (mode == 9) {
                if (nb2 == 0) { f32x4 up = part[(ml * 2 + 1) * 64 + lane];
#pragma unroll
                    for (int x = 1; x < 8; ++x) up += part[(x * 4 + ml * 2 + 1) * 64 + lane];
                    epi_swiglu(r, 16 * cb + 4 * fq, v, up, o0, ldo); }
            } else {
                switch (mode) {
                    case 0: TE_CALL(0); break;
                    case 1: TE_CALL(1); break;
                    case 2: TE_CALL(2); break;
                    case 3: TE_CALL(3); break;
                    case 4: TE_CALL(4); break;
                    case 5: TE_CALL(5); break;
                    case 6: TE_CALL(6); break;
                    case 7: TE_CALL(7); break;
                    default: TE_CALL(8); break;
                }
            }
        }
    }
}

__device__ void conv_T(const float* src, const float* src2, int ldsrc, bf16_t* dst, int K, int N, int Kpad, int Npad, int mode, LAS float* tile) {
    const int tid = otid();
    const int tk = Kpad / 256, tn = Npad / 64, ntile = tk * tn;
    for (int ti = obid(); ti < ntile; ti += gridDim.x) {
        const int R0 = (ti / tk) * 64, k0 = (ti % tk) * 256;
        f32x4 v[4][2];
#pragma unroll
        for (int sub = 0; sub < 4; ++sub)
#pragma unroll
            for (int pass = 0; pass < 2; ++pass) {
                const int kr = (tid >> 4) + pass * 32, c4 = (tid & 15) * 4;
                const int k = k0 + sub * 64 + kr, R = R0 + c4;
                v[sub][pass] = (f32x4){0.f, 0.f, 0.f, 0.f};
                if (k < K && R < N) {
                    const float* s; int col;
                    if (mode == 1) { const int g = R >> 5, wi = R & 31; s = wi < 16 ? src : src2; col = 16 * g + (wi & 15); }
                    else { s = src; col = R; }
                    v[sub][pass] = *(const f32x4*)(s + (size_t)k * ldsrc + col);
                }
            }
        __syncthreads();
#pragma unroll
        for (int sub = 0; sub < 4; ++sub)
#pragma unroll
            for (int pass = 0; pass < 2; ++pass) {
                const int kr = (tid >> 4) + pass * 32, c4 = (tid & 15) * 4;
                LAS float* t = tile + sub * (64 * 65) + kr * 65 + c4;
                t[0] = v[sub][pass][0]; t[1] = v[sub][pass][1]; t[2] = v[sub][pass][2]; t[3] = v[sub][pass][3];
            }
        __syncthreads();
        const int Rr = tid >> 3, k8 = (tid & 7) * 8;
#pragma unroll
        for (int sub = 0; sub < 4; ++sub) {
            float e[8];
#pragma unroll
            for (int i = 0; i < 8; ++i) e[i] = tile[sub * (64 * 65) + (k8 + i) * 65 + Rr];
            u32x4 o; o.x = cvt_pk_bf16(e[0], e[1]); o.y = cvt_pk_bf16(e[2], e[3]); o.z = cvt_pk_bf16(e[4], e[5]); o.w = cvt_pk_bf16(e[6], e[7]);
            *(u32x4*)(dst + (size_t)(R0 + Rr) * Kpad + k0 + sub * 64 + k8) = o;
        }
    }
}

struct CJ { int in0, in1, ldsrc, K, N, Kpad, Npad, mode; unsigned long long soff, doff; };
struct CJTab { CJ j[4][14]; int n[4]; };
constexpr CJ mkcj(int in0, int in1, unsigned long long soff, int ldsrc, unsigned long long doff, int K, int N, int Kpad, int Npad, int mode) {
    CJ c{}; c.in0 = in0; c.in1 = in1; c.ldsrc = ldsrc; c.K = K; c.N = N; c.Kpad = Kpad; c.Npad = Npad; c.mode = mode; c.soff = soff; c.doff = doff; return c;
}
constexpr CJTab make_cjtab() {
    CJTab t{};
    const unsigned long long DD = (unsigned long long)D * D, DF = (unsigned long long)D * FF;
    for (int layer = 0; layer < 4; ++layer) {
        int n = 0;
        if (layer < 2) {
            const unsigned long long i = layer;
            t.j[layer][n++] = mkcj(8, 8, i * DD, D, OFF_WA + WA_W0, D, D, D, D, 0);
            t.j[layer][n++] = mkcj(9, 9, i * DD, D, OFF_WA + WA_W1, D, D, D, D, 0);
            t.j[layer][n++] = mkcj(10, 10, i * DD, D, OFF_WA + WA_W2, D, D, D, D, 0);
            t.j[layer][n++] = mkcj(13, 13, i * D * 96, 96, OFF_WA + WA_L1 + 0 * WSLOT, D, 96, D, 256, 0);
            t.j[layer][n++] = mkcj(16, 16, i * D * 96, 96, OFF_WA + WA_L1 + 1 * WSLOT, D, 96, D, 256, 0);
            t.j[layer][n++] = mkcj(18, 18, i * D * 256, 256, OFF_WA + WA_L1 + 2 * WSLOT, D, 256, D, 256, 0);
            t.j[layer][n++] = mkcj(14, 14, i * 96 * D, D, OFF_WA + WA_L2 + 0 * WSLOT, 96, D, 256, D, 0);
            t.j[layer][n++] = mkcj(17, 17, i * 96 * D, D, OFF_WA + WA_L2 + 1 * WSLOT, 96, D, 256, D, 0);
            t.j[layer][n++] = mkcj(19, 19, i * 256 * D, D, OFF_WA + WA_L2 + 2 * WSLOT, 256, D, 256, D, 0);
            if (layer >= 1) {
                t.j[layer][n++] = mkcj(26, 26, (i - 1) * D * 64, 64, OFF_WA + WA_L1 + 3 * WSLOT, D, 64, D, 256, 0);
                t.j[layer][n++] = mkcj(27, 27, (i - 1) * 64 * D, D, OFF_WA + WA_L2 + 3 * WSLOT, 64, D, 256, D, 0);
            }
            t.j[layer][n++] = mkcj(11, 11, i * DD, D, OFF_WB + WB_WO, D, D, D, D, 0);
        } else {
            const unsigned long long jj = layer - 2;
            t.j[layer][n++] = mkcj(32, 32, jj * DD, D, OFF_WA + WA_W0, D, D, D, D, 0);
            if (layer == 2) {
                t.j[layer][n++] = mkcj(29, 29, 0, D, OFF_WA + WA_W1, D, D, D, D, 0);
                t.j[layer][n++] = mkcj(30, 30, 0, D, OFF_WA + WA_W2, D, D, D, D, 0);
            }
            t.j[layer][n++] = mkcj(34, 34, jj * DD, D, OFF_WB + WB_WO, D, D, D, D, 0);
        }
        t.j[layer][n++] = mkcj(4, 5, (unsigned long long)layer * DF, FF, OFF_WB + WB_F1, D, 2 * FF, D, 2 * FF, 1);
        t.j[layer][n++] = mkcj(6, 6, (unsigned long long)layer * DF, D, OFF_WB + WB_F2, FF, D, FF, D, 0);
        t.n[layer] = n;
    }
    return t;
}
__constant__ const CJTab CJT = make_cjtab();

__device__ void convert_layer(const Params& P, int layer, LAS unsigned char* lds) {
    LAS float* tile = (LAS float*)lds;
    const int nj = CJT.n[layer];
    for (int q = 0; q < nj; ++q) {
        const CJ* c = &CJT.j[layer][q];
        conv_T(P.in[c->in0] + c->soff, P.in[c->in1] + c->soff, c->ldsrc, (bf16_t*)(P.ws + c->doff), c->K, c->N, c->Kpad, c->Npad, c->mode, tile);
    }
}

__device__ void init_phase(const Params& P) {
    const f32x4* x = (const f32x4*)P.in[0]; f32x4* o = (f32x4*)P.out;
    const size_t n4 = (size_t)MMAIN * D / 4;
    for (size_t i = (size_t)obid() * NTHR + otid(); i < n4; i += (size_t)gridDim.x * NTHR) o[i] = x[i];
    const f32x4* mt = (const f32x4*)P.in[1]; f32x4* ht = (f32x4*)(P.ws + OFF_HT);
    const int m4 = NBATCH * NMETA * D / 4, per = NMETA * D / 4;
    for (int i = obid() * NTHR + otid(); i < m4; i += gridDim.x * NTHR) ht[i] = mt[i % per];
}

__device__ void mixprep_phase(const Params& P, int i) {
    const int tid_ = otid(); const int w = tid_ >> 6, lane = tid_ & 63;
    const float* g = P.in[2] + (size_t)i * D;
    const float* mu = P.in[7] + (size_t)i * 6 * D;
    bf16_t* const ob[6] = {(bf16_t*)(P.ws + OFF_MIX), (bf16_t*)(P.ws + OFF_DEC), (bf16_t*)(P.ws + OFF_MIX + SZB), (bf16_t*)(P.ws + OFF_MIX + 2 * SZB),
                           (bf16_t*)(P.ws + OFF_DEC + SZB), (bf16_t*)(P.ws + OFF_KF)};
    for (int idx = obid() * 8 + w; idx < M; idx += gridDim.x * 8) {
        const int b = idx / L, t = idx % L;
        const int r = rowof(b, t), rprev = rowof(b, t > 0 ? t - 1 : 0);
        const float* hc; const float* hp;
        if (i == 0) {
            hc = r < MMAIN ? P.in[0] + (size_t)r * D : P.in[1] + (size_t)((r - MMAIN) & 15) * D;
            hp = rprev < MMAIN ? P.in[0] + (size_t)rprev * D : P.in[1] + (size_t)((rprev - MMAIN) & 15) * D;
        } else { hc = hrow(P, r); hp = hrow(P, rprev); }
        float* hw = hrow(P, r);
        f32x4 c[8], p[8]; float sc = 0.f, sp = 0.f;
#pragma unroll
        for (int q = 0; q < 8; ++q) { c[q] = *(const f32x4*)(hc + 256 * q + 4 * lane); p[q] = *(const f32x4*)(hp + 256 * q + 4 * lane);
            sc += c[q][0] * c[q][0] + c[q][1] * c[q][1] + c[q][2] * c[q][2] + c[q][3] * c[q][3];
            sp += p[q][0] * p[q][0] + p[q][1] * p[q][1] + p[q][2] * p[q][2] + p[q][3] * p[q][3]; }
        if (i == 0) {
#pragma unroll
            for (int q = 0; q < 8; ++q) *(f32x4*)(hw + 256 * q + 4 * lane) = c[q];
        }
        sc = wavesum(sc); sp = wavesum(sp);
        const float rc = rsqrtf(sc * (1.0f / D) + 1e-6f);
        const float rp = t > 0 ? rsqrtf(sp * (1.0f / D) + 1e-6f) : 0.f;
#pragma unroll
        for (int q = 0; q < 8; ++q) {
            const int col = 256 * q + 4 * lane;
            const f32x4 gv = *(const f32x4*)(g + col);
            f32x4 hn, xx;
#pragma unroll
            for (int e = 0; e < 4; ++e) { hn[e] = c[q][e] * rc * gv[e]; xx[e] = p[q][e] * rp * gv[e] - hn[e]; }
#pragma unroll
            for (int j = 0; j < 6; ++j) {
                const f32x4 m = *(const f32x4*)(mu + j * D + col);
                u32x2 a; a.x = cvt_pk_bf16(hn[0] + xx[0] * m[0], hn[1] + xx[1] * m[1]); a.y = cvt_pk_bf16(hn[2] + xx[2] * m[2], hn[3] + xx[3] * m[3]);
                *(u32x2*)(ob[j] + (size_t)r * D + col) = a;
            }
        }
    }
}

__device__ void norm_phase(const Params& P, const float* g1, bf16_t* o1, const float* g2, bf16_t* o2) {
    const int tid_ = otid(); const int w = tid_ >> 6, lane = tid_ & 63;
    for (int r = obid() * 8 + w; r < M; r += gridDim.x * 8) {
        const float* hc = hrow(P, r);
        f32x4 c[8]; float sc = 0.f;
#pragma unroll
        for (int q = 0; q < 8; ++q) { c[q] = *(const f32x4*)(hc + 256 * q + 4 * lane); sc += c[q][0] * c[q][0] + c[q][1] * c[q][1] + c[q][2] * c[q][2] + c[q][3] * c[q][3]; }
        sc = wavesum(sc);
        const float rc = rsqrtf(sc * (1.0f / D) + 1e-6f);
#pragma unroll
        for (int q = 0; q < 8; ++q) {
            const int col = 256 * q + 4 * lane;
            const f32x4 gv = *(const f32x4*)(g1 + col);
            u32x2 a; a.x = cvt_pk_bf16(c[q][0] * rc * gv[0], c[q][1] * rc * gv[1]); a.y = cvt_pk_bf16(c[q][2] * rc * gv[2], c[q][3] * rc * gv[3]);
            *(u32x2*)(o1 + (size_t)r * D + col) = a;
            if (g2) { const f32x4 g2v = *(const f32x4*)(g2 + col);
                u32x2 bq; bq.x = cvt_pk_bf16(c[q][0] * rc * g2v[0], c[q][1] * rc * g2v[1]); bq.y = cvt_pk_bf16(c[q][2] * rc * g2v[2], c[q][3] * rc * g2v[3]);
                *(u32x2*)(o2 + (size_t)r * D + col) = bq; }
        }
    }
}

__device__ void scan_phase(const Params& P, int i, LAS unsigned char* lds) {
    const int tid = otid(), w = tid >> 6, lane = tid & 63;
    const bf16_t* RB = (const bf16_t*)(P.ws + OFF_RB); const float* KF = (const float*)(P.ws + OFF_KF);
    const float* VF = (const float*)(P.ws + OFF_VF); const float* DEC = (const float*)(P.ws + OFF_DEC);
    const bf16_t* AB = (const bf16_t*)(P.ws + OFF_MIX); bf16_t* YB = (bf16_t*)(P.ws + OFF_MIX + 2 * SZB);
    const float* k_k = P.in[20] + (size_t)i * D; const float* k_a = P.in[21] + (size_t)i * D; const float* r_k = P.in[22] + (size_t)i * D;
    float* SBON = (float*)(P.ws + OFF_LORA);
    LAS float* fl = (LAS float*)lds;
    constexpr int STG = 11264;
    LAS float* ybuf = fl + 2 * STG;
    typedef float f32x2 __attribute__((ext_vector_type(2)));
    const int wu = __builtin_amdgcn_readfirstlane(w);
    const int kg = lane & 15, rp = 4 * (wu & 3) + (lane >> 4);
    const int lt = tid & 255;
    const int lc = (lt & 15) * 4, vt = lt >> 3, vc = (lt & 7) * 4;
    constexpr int NCH = (L + 31) / 32;
    for (int u = obid(); u < 256; u += gridDim.x) {
        const int bh = u >> 1, rh = u & 1, b = bh >> 5, h = bh & 31;
        f32x4 kkp = (f32x4){0.f, 0.f, 0.f, 0.f}, kap = kkp, rkp = kkp;
        f32x4 gk[2], gd[2], gv; u32x2 gr[2], ga[2];
        __syncthreads();
#define SCAN_LOAD(cc) do { _Pragma("unroll") for (int q_ = 0; q_ < 2; ++q_) { const int t_ = 32 * (cc) + (lt >> 4) + 16 * q_; \
              gk[q_] = (f32x4){0.f, 0.f, 0.f, 0.f}; gd[q_] = gk[q_]; gr[q_] = (u32x2){0u, 0u}; ga[q_] = gr[q_]; \
              if (t_ < L) { const size_t o_ = (size_t)rowof(b, t_) * D + 64 * h + lc; gk[q_] = *(const f32x4*)(KF + o_); gd[q_] = *(const f32x4*)(DEC + o_); gr[q_] = *(const u32x2*)(RB + o_); ga[q_] = *(const u32x2*)(AB + o_); } } \
            { const int tv_ = 32 * (cc) + vt; gv = (f32x4){0.f, 0.f, 0.f, 0.f}; if (tv_ < L) gv = *(const f32x4*)(VF + (size_t)rowof(b, tv_) * D + 64 * h + 32 * rh + vc); } } while (0)
#define SCAN_STORE(st, cc) do { LAS float* s_ = fl + (st) * STG; _Pragma("unroll") for (int q_ = 0; q_ < 2; ++q_) { const int o_ = ((lt >> 4) + 16 * q_) * 64 + lc; \
              f32x4 kr_ = gk[q_] * kkp; float ss_ = kr_[0] * kr_[0] + kr_[1] * kr_[1] + kr_[2] * kr_[2] + kr_[3] * kr_[3]; ss_ = rowsum16(ss_); \
              const float inv_ = rsqrtf(fmaxf(ss_, 1e-24f)); \
              f32x4 av_; av_[0] = bf_lo(ga[q_].x); av_[1] = bf_hi(ga[q_].x); av_[2] = bf_lo(ga[q_].y); av_[3] = bf_hi(ga[q_].y); \
              f32x4 rv_; rv_[0] = bf_lo(gr[q_].x); rv_[1] = bf_hi(gr[q_].x); rv_[2] = bf_lo(gr[q_].y); rv_[3] = bf_hi(gr[q_].y); \
              const f32x4 kk_ = kr_ * inv_; f32x4 kp_; \
              for (int e_ = 0; e_ < 4; ++e_) kp_[e_] = gk[q_][e_] * (1.0f + (av_[e_] - 1.0f) * kap[e_]); \
              *(LAS f32x4*)(s_ + o_) = rv_; *(LAS f32x4*)(s_ + 2048 + o_) = gd[q_]; *(LAS f32x4*)(s_ + 4096 + o_) = kp_; \
              *(LAS f32x4*)(s_ + 6144 + o_) = kk_; *(LAS f32x4*)(s_ + 8192 + o_) = kk_ * av_; \
              float sb_ = rv_[0] * kp_[0] * rkp[0] + rv_[1] * kp_[1] * rkp[1] + rv_[2] * kp_[2] * rkp[2] + rv_[3] * kp_[3] * rkp[3]; sb_ = rowsum16(sb_); \
              { const int tb_ = 32 * (cc) + (lt >> 4) + 16 * q_; if (rh == 0 && (lt & 15) == 0 && tb_ < L) SBON[(size_t)rowof(b, tb_) * 32 + h] = sb_; } } \
            *(LAS f32x4*)(s_ + 10240 + vt * 32 + vc) = gv; } while (0)
#define SCAN_FLUSH(cc) do { const LAS float* yb_ = ybuf + ((cc) & 1) * 1024; _Pragma("unroll") for (int q_ = 0; q_ < 2; ++q_) { const int ft_ = (lt >> 4) + 16 * q_, fv_ = (lt & 15) * 2; const int tt_ = 32 * (cc) + ft_; \
              if (tt_ < L) { const unsigned pk_ = cvt_pk_bf16(yb_[ft_ * 32 + fv_], yb_[ft_ * 32 + fv_ + 1]); *(unsigned*)(YB + (size_t)rowof(b, tt_) * D + 64 * h + 32 * rh + fv_) = pk_; } } } while (0)
        if (wu >= 4) {
            kkp = *(const f32x4*)(k_k + 64 * h + lc); kap = *(const f32x4*)(k_a + 64 * h + lc); rkp = *(const f32x4*)(r_k + 64 * h + lc);
            SCAN_LOAD(0); SCAN_STORE(0, 0);
            SCAN_LOAD(1);
        }
        __syncthreads();
        f32x2 SA01 = {0.f, 0.f}, SA23 = SA01, SB01 = SA01, SB23 = SA01;
        for (int c = 0; c < NCH; ++c) {
            if (wu < 4) {
                const LAS float* s = fl + (c & 1) * STG;
                LAS float* yb = ybuf + (c & 1) * 1024;
                const int ns = (L - 32 * c) < 32 ? (L - 32 * c) : 32;
                for (int tb = 0; tb < ns; tb += 16) {
                    float ykA = 0.f, ykB = 0.f;
#pragma unroll
                    for (int j = 0; j < 16; ++j) {
                        const int t = tb + j;
                        const int o = t * 64 + 4 * kg;
                        const f32x4 r4 = *(const LAS f32x4*)(s + o), d4 = *(const LAS f32x4*)(s + 2048 + o), kp4 = *(const LAS f32x4*)(s + 4096 + o);
                        const f32x4 kk4 = *(const LAS f32x4*)(s + 6144 + o), ka4 = *(const LAS f32x4*)(s + 8192 + o);
                        const f32x2 vv = *(const LAS f32x2*)(s + 10240 + t * 32 + 2 * rp);
                        const f32x2 kk01 = {kk4[0], kk4[1]}, kk23 = {kk4[2], kk4[3]}, ka01 = {ka4[0], ka4[1]}, ka23 = {ka4[2], ka4[3]};
                        const f32x2 kp01 = {kp4[0], kp4[1]}, kp23 = {kp4[2], kp4[3]}, d01 = {d4[0], d4[1]}, d23 = {d4[2], d4[3]}, r01 = {r4[0], r4[1]}, r23 = {r4[2], r4[3]};
                        f32x2 pA = SA01 * kk01; pA = SA23 * kk23 + pA;
                        f32x2 pB = SB01 * kk01; pB = SB23 * kk23 + pB;
                        const float saA = -rowsum16(pA.x + pA.y), saB = -rowsum16(pB.x + pB.y);
                        f32x2 tA01 = kp01 * vv.x, tA23 = kp23 * vv.x, tB01 = kp01 * vv.y, tB23 = kp23 * vv.y;
                        tA01 = ka01 * saA + tA01; tA23 = ka23 * saA + tA23; tB01 = ka01 * saB + tB01; tB23 = ka23 * saB + tB23;
                        SA01 = SA01 * d01 + tA01; SA23 = SA23 * d23 + tA23; SB01 = SB01 * d01 + tB01; SB23 = SB23 * d23 + tB23;
                        f32x2 qA = SA01 * r01; qA = SA23 * r23 + qA;
                        f32x2 qB = SB01 * r01; qB = SB23 * r23 + qB;
                        const float yA = rowsum16(qA.x + qA.y), yB = rowsum16(qB.x + qB.y);
                        ykA = (kg == j) ? yA : ykA; ykB = (kg == j) ? yB : ykB;
                    }
                    { f32x2 yy = {ykA, ykB}; *(LAS f32x2*)(yb + (tb + kg) * 32 + 2 * rp) = yy; }
                }
            } else {
                if (c + 1 < NCH) SCAN_STORE((c + 1) & 1, c + 1);
                if (c + 2 < NCH) SCAN_LOAD(c + 2);
                if (c >= 1) SCAN_FLUSH(c - 1);
            }
            __syncthreads();
        }
        if (wu >= 4) SCAN_FLUSH(NCH - 1);
#undef SCAN_LOAD
#undef SCAN_STORE
#undef SCAN_FLUSH
    }
}

__device__ void post_phase(const Params& P, int i) {
    const int tid_ = otid(); const int w = tid_ >> 6, lane = tid_ & 63;
    const float* VF = (const float*)(P.ws + OFF_VF); const float* SBON = (const float*)(P.ws + OFF_LORA);
    const bf16_t* GB = (const bf16_t*)(P.ws + OFF_MIX + SZB); bf16_t* YB = (bf16_t*)(P.ws + OFF_MIX + 2 * SZB);
    const float* gn_w = P.in[23] + (size_t)i * D; const float* gn_b = P.in[24] + (size_t)i * D;
    for (int r = obid() * 8 + w; r < M; r += gridDim.x * 8) {
#pragma unroll
        for (int q = 0; q < 8; ++q) {
            const int col = 256 * q + 4 * lane; const size_t o = (size_t)r * D + col;
            const u32x2 yv = *(const u32x2*)(YB + o), gv = *(const u32x2*)(GB + o);
            const f32x4 vv = *(const f32x4*)(VF + o);
            const float sb = SBON[(size_t)r * 32 + 4 * q + (lane >> 4)];
            const f32x4 gw = *(const f32x4*)(gn_w + col), gb = *(const f32x4*)(gn_b + col);
            float y[4] = {bf_lo(yv.x), bf_hi(yv.x), bf_lo(yv.y), bf_hi(yv.y)};
            const float gg[4] = {bf_lo(gv.x), bf_hi(gv.x), bf_lo(gv.y), bf_hi(gv.y)};
            float sy = (y[0] + y[1]) + (y[2] + y[3]);
            sy = rowsum16(sy);
            const float mean = sy * (1.0f / 64.0f);
            float sv = 0.f;
#pragma unroll
            for (int e = 0; e < 4; ++e) { y[e] -= mean; sv += y[e] * y[e]; }
            sv = rowsum16(sv);
            const float rstd = rsqrtf(sv * (1.0f / 64.0f) + 64e-5f);
            float z[4];
#pragma unroll
            for (int e = 0; e < 4; ++e) z[e] = (y[e] * rstd * gw[e] + gb[e] + sb * vv[e]) * gg[e];
            u32x2 zo; zo.x = cvt_pk_bf16(z[0], z[1]); zo.y = cvt_pk_bf16(z[2], z[3]);
            *(u32x2*)(YB + o) = zo;
        }
    }
}

__device__ void headnorm_phase(const Params& P, LAS unsigned char* lds) {
    const int tid = otid(), w = tid >> 6, lane = tid & 63;
    const bf16_t* KR = (const bf16_t*)(P.ws + OFF_KF); const bf16_t* VR = (const bf16_t*)(P.ws + OFF_VF);
    bf16_t* KN = (bf16_t*)(P.ws + OFF_MIX + 2 * SZB); bf16_t* VT = (bf16_t*)(P.ws + OFF_DEC);
    const float* kg = P.in[31];
    for (int r = obid() * 8 + w; r < M; r += gridDim.x * 8) {
#pragma unroll
        for (int q = 0; q < 8; ++q) {
            const int col = 256 * q + 4 * lane; const size_t o = (size_t)r * D + col;
            const u32x2 kraw = *(const u32x2*)(KR + o); f32x4 kv; kv[0] = bf_lo(kraw.x); kv[1] = bf_hi(kraw.x); kv[2] = bf_lo(kraw.y); kv[3] = bf_hi(kraw.y);
            float ss = kv[0] * kv[0] + kv[1] * kv[1] + kv[2] * kv[2] + kv[3] * kv[3];
            ss = rowsum16(ss); ss += __shfl_xor(ss, 16);
            const float rs = rsqrtf(ss * (1.0f / 128.0f) + 1e-6f);
            const f32x4 gv = *(const f32x4*)(kg + (col & 127));
            u32x2 a; a.x = cvt_pk_bf16(kv[0] * rs * gv[0], kv[1] * rs * gv[1]); a.y = cvt_pk_bf16(kv[2] * rs * gv[2], kv[3] * rs * gv[3]);
            *(u32x2*)(KN + o) = a;
        }
    }
    LAS float* tile = (LAS float*)lds;
    for (int it = obid(); it < NBATCH * 66 * 16; it += gridDim.x) {
        const int h = it & 15, pt = (it >> 4) % 66, b = it / (16 * 66);
        __syncthreads();
#pragma unroll
        for (int pass = 0; pass < 4; ++pass) {
            const int key = (tid >> 5) + pass * 16, c4 = (tid & 31) * 4;
            const int t = 64 * pt + key - PPAD;
            f32x4 v = (f32x4){0.f, 0.f, 0.f, 0.f};
            if (t >= 0) { const u32x2 vraw = *(const u32x2*)(VR + (size_t)rowof(b, t) * D + 128 * h + c4); v[0] = bf_lo(vraw.x); v[1] = bf_hi(vraw.x); v[2] = bf_lo(vraw.y); v[3] = bf_hi(vraw.y); }
            tile[key * 129 + c4] = v[0]; tile[key * 129 + c4 + 1] = v[1]; tile[key * 129 + c4 + 2] = v[2]; tile[key * 129 + c4 + 3] = v[3];
        }
        __syncthreads();
        const int d = tid >> 2, k16 = (tid & 3) * 16;
        float e[16];
#pragma unroll
        for (int x = 0; x < 16; ++x) e[x] = tile[(k16 + x) * 129 + d];
        u32x4 o0, o1;
        o0.x = cvt_pk_bf16(e[0], e[1]); o0.y = cvt_pk_bf16(e[2], e[3]); o0.z = cvt_pk_bf16(e[4], e[5]); o0.w = cvt_pk_bf16(e[6], e[7]);
        o1.x = cvt_pk_bf16(e[8], e[9]); o1.y = cvt_pk_bf16(e[10], e[11]); o1.z = cvt_pk_bf16(e[12], e[13]); o1.w = cvt_pk_bf16(e[14], e[15]);
        bf16_t* dst = VT + ((size_t)((b * 16 + h) * 128 + d)) * PLEN + 64 * pt + k16;
        *(u32x4*)dst = o0; *(u32x4*)(dst + 8) = o1;
    }
}

__device__ void attn_phase(const Params& P, int j, LAS unsigned char* lds) {
    const int tid = otid(), w = tid >> 6, lane = tid & 63, fr = lane & 15, fq = lane >> 4;
    const bf16_t* QF = (const bf16_t*)(P.ws + OFF_RB);
    const bf16_t* KN = (const bf16_t*)(P.ws + OFF_MIX + 2 * SZB);
    const bf16_t* VT = (const bf16_t*)(P.ws + OFF_DEC);
    bf16_t* OB = (bf16_t*)(P.ws + OFF_MIX);
    const float* qg = P.in[33] + j * 128;
    constexpr int KSTR = 272, VSTR = 144, KBYTES = 64 * KSTR, VBYTES = 128 * VSTR, STGB = KBYTES + VBYTES;
#define ATT_LOADX(kt_, b_, h_, bh_, KR_, VR_) do { _Pragma("unroll") for (int i_ = 0; i_ < 2; ++i_) { const int id_ = tid + 512 * i_; \
            { const int row_ = id_ >> 4, c_ = id_ & 15; const int tk_ = 64 * (kt_) + row_ - PPAD; \
              KR_[i_] = *(const u32x4*)(KN + (size_t)rowof((b_), tk_ > 0 ? tk_ : 0) * D + 128 * (h_) + 8 * c_); } \
            { const int d_ = id_ >> 3, c_ = id_ & 7; VR_[i_] = *(const u32x4*)(VT + ((size_t)((bh_) * 128 + d_)) * PLEN + 64 * (kt_) + 8 * c_); } } } while (0)
#define ATT_PREFETCH(u_) do { const int qb_ = 32 - (u_) / 64, bh_ = (u_) % 64, b_ = bh_ >> 4, h_ = bh_ & 15; const int tq_ = 128 * qb_ + 16 * w + fr - PPAD; \
            const bf16_t* qp_ = QF + (size_t)rowof(b_, tq_ > 0 ? tq_ : 0) * D + 128 * h_ + 8 * fq; \
            _Pragma("unroll") for (int s_ = 0; s_ < 4; ++s_) nq[s_] = *(const u32x4*)(qp_ + 32 * s_); \
            ATT_LOADX(2 * qb_ + 1, b_, h_, bh_, nk, nv); } while (0)
    u32x4 nq[4], nk[2], nv[2];
    { const int u0 = obid(); if (u0 < 64 * 33) ATT_PREFETCH(u0); }
    for (int u = obid(); u < 64 * 33; u += gridDim.x) {
        const int qb = 32 - u / 64, bh = u % 64, b = bh >> 4, h = bh & 15;
        const int pq = 128 * qb + 16 * w + fr, tq = pq - PPAD;
        const int qrow = rowof(b, tq > 0 ? tq : 0);
        bf16x8 qf[4];
        u32x4 kr[2], vr[2];
        u32x4 cq[4];
#pragma unroll
        for (int s = 0; s < 4; ++s) cq[s] = nq[s];
        kr[0] = nk[0]; kr[1] = nk[1]; vr[0] = nv[0]; vr[1] = nv[1];
        { const int un = u + (int)gridDim.x; if (un < 64 * 33) ATT_PREFETCH(un); }
        {
            f32x4 qa[4], qc[4]; float ss = 0.f;
#pragma unroll
            for (int s = 0; s < 4; ++s) { const u32x4 qraw = cq[s];
                qa[s][0] = bf_lo(qraw.x); qa[s][1] = bf_hi(qraw.x); qa[s][2] = bf_lo(qraw.y); qa[s][3] = bf_hi(qraw.y); qc[s][0] = bf_lo(qraw.z); qc[s][1] = bf_hi(qraw.z); qc[s][2] = bf_lo(qraw.w); qc[s][3] = bf_hi(qraw.w);
                ss += qa[s][0] * qa[s][0] + qa[s][1] * qa[s][1] + qa[s][2] * qa[s][2] + qa[s][3] * qa[s][3] + qc[s][0] * qc[s][0] + qc[s][1] * qc[s][1] + qc[s][2] * qc[s][2] + qc[s][3] * qc[s][3]; }
            ss += __shfl_xor(ss, 16); ss += __shfl_xor(ss, 32);
            const float rs = rsqrtf(ss * (1.0f / 128.0f) + 1e-6f) * 0.08838834764831845f;
#pragma unroll
            for (int s = 0; s < 4; ++s) {
                const f32x4 g0 = *(const f32x4*)(qg + 32 * s + 8 * fq), g1 = *(const f32x4*)(qg + 32 * s + 8 * fq + 4);
                u32x4 pk; pk.x = cvt_pk_bf16(qa[s][0] * rs * g0[0], qa[s][1] * rs * g0[1]); pk.y = cvt_pk_bf16(qa[s][2] * rs * g0[2], qa[s][3] * rs * g0[3]);
                pk.z = cvt_pk_bf16(qc[s][0] * rs * g1[0], qc[s][1] * rs * g1[1]); pk.w = cvt_pk_bf16(qc[s][2] * rs * g1[2], qc[s][3] * rs * g1[3]);
                qf[s] = __builtin_bit_cast(bf16x8, pk);
            }
        }
        f32x4 oacc[8];
#pragma unroll
        for (int x = 0; x < 8; ++x) oacc[x] = (f32x4){0.f, 0.f, 0.f, 0.f};
        float carry = 1.0f;
#define ATT_LOAD(kt_) do { _Pragma("unroll") for (int i_ = 0; i_ < 2; ++i_) { const int id_ = tid + 512 * i_; \
            { const int row_ = id_ >> 4, c_ = id_ & 15; const int tk_ = 64 * (kt_) + row_ - PPAD; \
              kr[i_] = *(const u32x4*)(KN + (size_t)rowof(b, tk_ > 0 ? tk_ : 0) * D + 128 * h + 8 * c_); } \
            { const int d_ = id_ >> 3, c_ = id_ & 7; vr[i_] = *(const u32x4*)(VT + ((size_t)(bh * 128 + d_)) * PLEN + 64 * (kt_) + 8 * c_); } } } while (0)
#define ATT_WRITE(st_) do { _Pragma("unroll") for (int i_ = 0; i_ < 2; ++i_) { const int id_ = tid + 512 * i_; \
            *(LAS u32x4*)(lds + (st_) * STGB + (id_ >> 4) * KSTR + 16 * (id_ & 15)) = kr[i_]; \
            *(LAS u32x4*)(lds + (st_) * STGB + KBYTES + (id_ >> 3) * VSTR + 16 * (id_ & 7)) = vr[i_]; } } while (0)
        const int nti = 2 * qb + 1;
        __syncthreads();
        ATT_WRITE(0);
        __syncthreads();
        for (int it = 0; it < nti; ++it) {
            const int kt = nti - it;
            if (it + 1 < nti) ATT_LOAD(kt - 1);
            const LAS unsigned char* Ks = lds + (it & 1) * STGB; const LAS unsigned char* Vs = Ks + KBYTES;
            f32x4 st[4];
#pragma unroll
            for (int n = 0; n < 4; ++n) { st[n] = (f32x4){0.f, 0.f, 0.f, 0.f};
#pragma unroll
                for (int s = 0; s < 4; ++s) { const bf16x8 a = *(const LAS bf16x8*)(Ks + (16 * n + fr) * KSTR + 64 * s + 16 * fq);
                    st[n] = __builtin_amdgcn_mfma_f32_16x16x32_bf16(a, qf[s], st[n], 0, 0, 0); } }
            const bool need_mask = (kt >= 2 * qb) || (kt == 1);
            float kp[4][4], sg[4][4];
#pragma unroll
            for (int n = 0; n < 4; ++n)
#pragma unroll
                for (int e = 0; e < 4; ++e) { const float z = st[n][e]; const float ex = __expf(-fabsf(z)); const float r = __builtin_amdgcn_rcpf(1.0f + ex);
                    const bool pos = z >= 0.f; sg[n][e] = (pos ? 1.0f : ex) * r; kp[n][e] = (pos ? ex : 1.0f) * r; }
            if (need_mask) {
#pragma unroll
                for (int n = 0; n < 4; ++n)
#pragma unroll
                    for (int e = 0; e < 4; ++e) { const int pk = 64 * kt + 16 * n + 4 * fq + e; const bool valid = (pk < pq) && (pk >= PPAD);
                        if (!valid) { kp[n][e] = 1.0f; sg[n][e] = 0.f; } }
            }
            float X[4], Bt[4];
            {
                LAS f32x4* xch = (LAS f32x4*)(lds + 2 * STGB) + w * 64;
                f32x4 Tv;
#pragma unroll
                for (int n = 0; n < 4; ++n) Tv[n] = (kp[n][0] * kp[n][1]) * (kp[n][2] * kp[n][3]);
                xch[lane] = Tv;
                const f32x4 t0 = xch[fr], t1 = xch[fr + 16], t2 = xch[fr + 32], t3 = xch[fr + 48];
#pragma unroll
                for (int n = 0; n < 4; ++n) {
                    X[n] = (fq < 1 ? t1[n] : 1.0f) * (fq < 2 ? t2[n] : 1.0f) * (fq < 3 ? t3[n] : 1.0f);
                    Bt[n] = (t0[n] * t1[n]) * (t2[n] * t3[n]);
                }
            }
            float wgt[4][4]; float run = carry;
#pragma unroll
            for (int n = 3; n >= 0; --n) { const float s3 = run * X[n]; const float s2 = s3 * kp[n][3]; const float s1 = s2 * kp[n][2]; const float s0 = s1 * kp[n][1];
                wgt[n][3] = sg[n][3] * s3; wgt[n][2] = sg[n][2] * s2; wgt[n][1] = sg[n][1] * s1; wgt[n][0] = sg[n][0] * s0;
                run *= Bt[n]; }
            carry = run;
#pragma unroll
            for (int s2 = 0; s2 < 2; ++s2) {
                u32x4 pk; pk.x = cvt_pk_bf16(wgt[2 * s2][0], wgt[2 * s2][1]); pk.y = cvt_pk_bf16(wgt[2 * s2][2], wgt[2 * s2][3]);
                pk.z = cvt_pk_bf16(wgt[2 * s2 + 1][0], wgt[2 * s2 + 1][1]); pk.w = cvt_pk_bf16(wgt[2 * s2 + 1][2], wgt[2 * s2 + 1][3]);
                const bf16x8 pf = __builtin_bit_cast(bf16x8, pk);
#pragma unroll
                for (int db = 0; db < 8; ++db) {
                    const LAS unsigned char* vp = Vs + (16 * db + fr) * VSTR + 64 * s2 + 8 * fq;
                    const u32x2 v0 = *(const LAS u32x2*)vp, v1 = *(const LAS u32x2*)(vp + 32);
                    u32x4 vv; vv.x = v0.x; vv.y = v0.y; vv.z = v1.x; vv.w = v1.y;
                    oacc[db] = __builtin_amdgcn_mfma_f32_16x16x32_bf16(__builtin_bit_cast(bf16x8, vv), pf, oacc[db], 0, 0, 0);
                }
            }
            if (it + 1 < nti) ATT_WRITE((it + 1) & 1);
#ifndef NO_EARLY_EXIT
            LAS int* flg = (LAS int*)(lds + 2 * STGB + 8192) + (it & 1) * 8;
            { const int dead = __all(carry == 0.f); if (lane == 0) flg[w] = dead; }
            __syncthreads();
            { int alld = 1;
#pragma unroll
              for (int x = 0; x < 8; ++x) alld &= flg[x];
              if (alld) break; }
#else
            __syncthreads();
#endif
        }
#undef ATT_LOAD
#undef ATT_WRITE
        if (tq >= 0) {
#pragma unroll
            for (int db = 0; db < 8; ++db) { u32x2 o; o.x = cvt_pk_bf16(oacc[db][0], oacc[db][1]); o.y = cvt_pk_bf16(oacc[db][2], oacc[db][3]);
                *(u32x2*)(OB + (size_t)qrow * D + 128 * h + 16 * db + 4 * fq) = o; }
        }
    }
}

#define XB_TMO      128
#define XB_XCNT(j)  (256  + 64 * (j))
#define XB_XSUB(j)  (1280 + 64 * (j))
#define XB_XGEN(j)  (2304 + 64 * (j))
#define XB_TOP      3328
#define XB_TOPGEN   3392
#define XCD_BAR_WORDS 3456
#define XB_SPIN_CAP (1u << 18)

__device__ __forceinline__ unsigned xb_ld(unsigned* p)              { return __hip_atomic_load(p, __ATOMIC_RELAXED, __HIP_MEMORY_SCOPE_AGENT); }
__device__ __forceinline__ unsigned xb_add(unsigned* p, unsigned v) { return __hip_atomic_fetch_add(p, v, __ATOMIC_RELAXED, __HIP_MEMORY_SCOPE_AGENT); }
__device__ __forceinline__ unsigned xb_xcc_id() { return (unsigned)__builtin_amdgcn_s_getreg((3 << 11) | 20) & 0xFu; }
#define XB_SPIN(cond, bar) do { unsigned _sp = 0; while (cond) { __builtin_amdgcn_s_sleep(1); \
    if ((++_sp & 255u) == 0u) { if (xb_ld(&(bar)[XB_TMO])) break; if (_sp > XB_SPIN_CAP) { atomicAdd(&(bar)[XB_TMO], 1u); break; } } } } while (0)

struct XcdBarrier {
    unsigned* bar; unsigned x;
    volatile LAS unsigned* st;
};

__device__ __forceinline__ XcdBarrier xcd_barrier_post(unsigned* bar, volatile LAS unsigned* st) {
    XcdBarrier b; b.bar = bar; b.x = xb_xcc_id(); b.st = st;
    if (threadIdx.x == 0) (void)xb_add(&bar[XB_XCNT(b.x)], 1u);
    return b;
}
__device__ __forceinline__ void xcd_barrier_complete(unsigned* bar, unsigned x, unsigned& nloc, unsigned& nx) {
    const unsigned G = gridDim.x * gridDim.y * gridDim.z;
    unsigned sum, cnt, mine, sp = 0u;
    for (;;) {
        sum = 0u; cnt = 0u; mine = 0u;
#pragma unroll
        for (unsigned j = 0; j < 16; ++j) { const unsigned c = xb_ld(&bar[XB_XCNT(j)]); sum += c; cnt += (c > 0u) ? 1u : 0u; mine = (j == x) ? c : mine; }
        if (sum == G) break;
        __builtin_amdgcn_s_sleep(1);
        if ((++sp & 255u) == 0u) { if (xb_ld(&bar[XB_TMO])) break; if (sp > XB_SPIN_CAP) { atomicAdd(&bar[XB_TMO], 1u); break; } }
    }
    nloc = mine > 0u ? mine : 1u; nx = cnt > 0u ? cnt : 1u;
}

__device__ __forceinline__ void xcd_barrier(const XcdBarrier& b) {
    asm volatile("s_waitcnt vmcnt(0)" ::: "memory");
    __syncthreads();
    if (threadIdx.x == 0) {
        unsigned* bar = b.bar;
        __builtin_amdgcn_s_waitcnt(0);
        unsigned nloc = b.st[0], nx = b.st[1];
        if (nloc == 0u) { xcd_barrier_complete(bar, b.x, nloc, nx); b.st[0] = nloc; b.st[1] = nx; }
        const unsigned old = xb_add(&bar[XB_XSUB(b.x)], 1u);
        const unsigned gen = old / nloc;
        if (old + 1u == (gen + 1u) * nloc) {
            __builtin_amdgcn_fence(__ATOMIC_RELEASE, "agent");
            asm volatile("s_waitcnt vmcnt(0)" ::: "memory");
            const unsigned og = xb_add(&bar[XB_TOP], 1u);
            const unsigned tg = og / nx;
            if (og + 1u == (tg + 1u) * nx) xb_add(&bar[XB_TOPGEN], 1u);
            else XB_SPIN(xb_ld(&bar[XB_TOPGEN]) == tg, bar);
            __builtin_amdgcn_fence(__ATOMIC_ACQUIRE, "agent");
            xb_add(&bar[XB_XGEN(b.x)], 1u);
            asm volatile("s_waitcnt vmcnt(0)" ::: "memory");
        } else {
            XB_SPIN(xb_ld(&bar[XB_XGEN(b.x)]) == gen, bar);
            __builtin_amdgcn_fence(__ATOMIC_ACQUIRE, "agent");
            asm volatile("s_waitcnt vmcnt(0)" ::: "memory");
        }
    }
    __syncthreads();
}


__device__ __forceinline__ void grid_barrier(unsigned* ctr, unsigned target) {
    asm volatile("s_waitcnt vmcnt(0) lgkmcnt(0)" ::: "memory");
    __syncthreads();
    if (threadIdx.x == 0) {
        __builtin_amdgcn_fence(__ATOMIC_RELEASE, "agent");
        asm volatile("s_waitcnt vmcnt(0)" ::: "memory");
        __hip_atomic_fetch_add(ctr, 1u, __ATOMIC_RELAXED, __HIP_MEMORY_SCOPE_AGENT);
        while (__hip_atomic_load(ctr, __ATOMIC_RELAXED, __HIP_MEMORY_SCOPE_AGENT) < target) __builtin_amdgcn_s_sleep(2);
        __builtin_amdgcn_fence(__ATOMIC_ACQUIRE, "agent");
        asm volatile("s_waitcnt vmcnt(0)" ::: "memory");
    }
    __syncthreads();
}

#ifndef DUP_ATTN
#define DUP_ATTN 0
#endif
#ifndef DUP_FFN1
#define DUP_FFN1 0
#endif
#ifndef DUP_SCAN
#define DUP_SCAN 0
#endif
constexpr int NPHASE = 35 + 2 * DUP_ATTN + 4 * DUP_FFN1 + 2 * DUP_SCAN;
enum { K_INIT = 0, K_MIXPREP, K_GEMM, K_SCAN, K_POST, K_NORMF, K_NORMSB, K_HEADNORM, K_ATTN };
struct Tab { PE e[NPHASE]; };
constexpr GD mkgd(size_t A, size_t Bt, int N, int mode, size_t o0, size_t o1, int bin, int boff, int ldo) {
    GD g{}; g.A = A; g.Bt = Bt; g.o0 = o0; g.o1 = o1; g.N = N; g.mode = mode; g.bin = bin; g.boff = boff; g.ldo = ldo; g.pad = 0; return g;
}
constexpr PE mkgemm(int layer, int sub) {
    PE p{}; p.kind = K_GEMM; p.layer = layer; p.sub = sub; p.ng = 1; p.K = D; p.pad = 0;
    const int i = layer;
    for (int q = 0; q < 4; ++q) p.g[q] = mkgd(0, 0, 256, 0, 0, 0, 0, 0, D);
    if (sub == 0) {
        p.g[0] = mkgd(OFF_MIX, OFF_WA + WA_W0, D, 0, OFF_RB, 0, 0, 0, D);
        p.g[1] = mkgd(OFF_MIX + SZB, OFF_WA + WA_W1, D, 1, OFF_KF, 0, 0, 0, D);
        p.g[2] = mkgd(OFF_MIX + 2 * SZB, OFF_WA + WA_W2, D, i == 0 ? 2 : 1, OFF_VF, OFF_VFIRST, 0, 0, D);
        p.ng = 3;
    } else if (sub == 1) {
        p.g[0] = mkgd(OFF_DEC, OFF_WA + WA_L1 + 0 * WSLOT, 256, 3, OFF_LORA + 0 * SZLORA, 0, 0, 0, 256);
        p.g[1] = mkgd(OFF_DEC + SZB, OFF_WA + WA_L1 + 1 * WSLOT, 256, 0, OFF_LORA + 1 * SZLORA, 0, 0, 0, 256);
        p.g[2] = mkgd(OFF_KF, OFF_WA + WA_L1 + 2 * WSLOT, 256, 4, OFF_LORA + 2 * SZLORA, 0, 0, 0, 256);
        p.ng = 3;
        if (i >= 1) { p.g[3] = mkgd(OFF_MIX + 2 * SZB, OFF_WA + WA_L1 + 3 * WSLOT, 256, 0, OFF_LORA + 3 * SZLORA, 0, 0, 0, 256); p.ng = 4; }
    } else if (sub == 2) {
        p.K = 256;
        p.g[0] = mkgd(OFF_LORA + 0 * SZLORA, OFF_WA + WA_L2 + 0 * WSLOT, D, 5, OFF_DEC, 0, 12, i * D, D);
        p.g[1] = mkgd(OFF_LORA + 1 * SZLORA, OFF_WA + WA_L2 + 1 * WSLOT, D, 6, OFF_MIX, 0, 15, i * D, D);
        p.g[2] = mkgd(OFF_LORA + 2 * SZLORA, OFF_WA + WA_L2 + 2 * WSLOT, D, 0, OFF_MIX + SZB, 0, 0, 0, D);
        p.ng = 3;
        if (i >= 1) { p.g[3] = mkgd(OFF_LORA + 3 * SZLORA, OFF_WA + WA_L2 + 3 * WSLOT, D, 7, OFF_VF, OFF_VFIRST, 25, (i - 1) * D, D); p.ng = 4; }
    } else if (sub == 3) {
        p.g[0] = mkgd(OFF_MIX + 2 * SZB, OFF_WB + WB_WO, D, 8, 0, 0, 0, 0, D);
    } else if (sub == 4) {
        p.g[0] = mkgd(OFF_HN2, OFF_WB + WB_F1, 2 * FF, 9, OFF_ACT, 0, 0, 0, FF);
    } else if (sub == 5) {
        p.K = FF;
        p.g[0] = mkgd(OFF_ACT, OFF_WB + WB_F2, D, 8, 0, 0, 0, 0, D);
    } else if (sub == 6) {
        p.g[0] = mkgd(OFF_MIX, OFF_WA + WA_W0, D, 0, OFF_RB, 0, 0, 0, D);
        if (layer == 2) {
            p.g[1] = mkgd(OFF_MIX + SZB, OFF_WA + WA_W1, D, 0, OFF_KF, 0, 0, 0, D);
            p.g[2] = mkgd(OFF_MIX + SZB, OFF_WA + WA_W2, D, 0, OFF_VF, 0, 0, 0, D);
            p.ng = 3;
        }
    } else {
        p.g[0] = mkgd(OFF_MIX, OFF_WB + WB_WO, D, 8, 0, 0, 0, 0, D);
    }
    return p;
}
constexpr PE mkother(int kind, int layer, int sub) { PE p{}; p.kind = kind; p.layer = layer; p.sub = sub; p.ng = 0; p.K = D; p.pad = 0; for (int q = 0; q < 4; ++q) p.g[q] = mkgd(0, 0, 256, 0, 0, 0, 0, 0, D); return p; }
constexpr Tab make_tab() {
    Tab t{};
    int n = 0;
    for (int i = 0; i < 2; ++i) {
        t.e[n++] = mkother(K_MIXPREP, i, 0);
        t.e[n++] = mkgemm(i, 1);
        t.e[n++] = mkgemm(i, 0);
        t.e[n++] = mkgemm(i, 2);
        t.e[n++] = mkother(K_SCAN, i, 0);
        if (DUP_SCAN) t.e[n++] = mkother(K_SCAN, i, 0);
        t.e[n++] = mkother(K_POST, i, 0);
        t.e[n++] = mkgemm(i, 3);
        t.e[n++] = mkother(K_NORMF, i, 0);
        t.e[n++] = mkgemm(i, 4);
        if (DUP_FFN1) t.e[n++] = mkgemm(i, 4);
        t.e[n++] = mkgemm(i, 5);
    }
    for (int j = 0; j < 2; ++j) {
        const int layer = 2 + j;
        t.e[n++] = mkother(K_NORMSB, layer, 0);
        t.e[n++] = mkgemm(layer, 6);
        if (j == 0) t.e[n++] = mkother(K_HEADNORM, layer, 0);
        t.e[n++] = mkother(K_ATTN, layer, 0);
        if (DUP_ATTN) t.e[n++] = mkother(K_ATTN, layer, 0);
        t.e[n++] = mkgemm(layer, 7);
        t.e[n++] = mkother(K_NORMF, layer, 0);
        t.e[n++] = mkgemm(layer, 4);
        if (DUP_FFN1) t.e[n++] = mkgemm(layer, 4);
        t.e[n++] = mkgemm(layer, 5);
    }
    return t;
}
__constant__ const Tab TAB = make_tab();

#ifndef ONLY
#define ONLY -1
#endif
#define EN(k) (ONLY < 0 || ONLY == (k))

__global__ void __launch_bounds__(512, 2) mk_forward(Params P, int ph_lo, int ph_hi) {
    extern __shared__ __attribute__((aligned(16))) unsigned char shm[];
    LAS unsigned char* lds = (LAS unsigned char*)shm;
    cg::grid_group grid = cg::this_grid();
    __shared__ uint4 xb_words;
    if (threadIdx.x == 0) xb_words = make_uint4(0u, 0u, 0u, 0u);
    unsigned* const xbar = (unsigned*)(P.ws + WS_END);
    XcdBarrier xb; xb.bar = xbar; xb.x = 0; xb.st = (volatile LAS unsigned*)&xb_words;
    for (int ph = ph_lo; ph < ph_hi; ++ph) {
        const PE* pe = &TAB.e[ph];
        const int kind = pe->kind, layer = pe->layer, sub = pe->sub;
        if (kind == K_GEMM) { if (EN(K_GEMM)) {
            const bool tail_first = (blockIdx.x & 1) != 0;
            if (tail_first) { tail_gemm(lds, pe, P); __syncthreads(); }
            gemm_phase(lds, pe, P);
            if (!tail_first) tail_gemm(lds, pe, P); } }
        else if (!EN(kind)) {}
        else if (kind == K_MIXPREP) { mixprep_phase(P, layer); convert_layer(P, layer, lds); }
        else if (kind == K_SCAN) scan_phase(P, layer, lds);
        else if (kind == K_POST) post_phase(P, layer);
        else if (kind == K_NORMF) norm_phase(P, P.in[3] + (size_t)layer * D, (bf16_t*)(P.ws + OFF_HN2), nullptr, nullptr);
        else if (kind == K_NORMSB) {
            norm_phase(P, P.in[2] + (size_t)layer * D, (bf16_t*)(P.ws + OFF_MIX), layer == 2 ? P.in[28] : nullptr, (bf16_t*)(P.ws + OFF_MIX + SZB));
            convert_layer(P, layer, lds);
        }
        else if (kind == K_HEADNORM) { if (layer == 2) headnorm_phase(P, lds); }
        else if (kind == K_ATTN) attn_phase(P, layer - 2, lds);
        if (ph + 1 < ph_hi) {
#ifdef USE_CG_SYNC
            grid.sync();
#else
            if (ph == ph_lo) {
                if (blockIdx.x == 0) for (int q = threadIdx.x; q < XCD_BAR_WORDS; q += NTHR) __hip_atomic_store(xbar + q, 0u, __ATOMIC_RELAXED, __HIP_MEMORY_SCOPE_AGENT);
                grid.sync();
                xb = xcd_barrier_post(xbar, (volatile LAS unsigned*)&xb_words);
            }
            else xcd_barrier(xb);
#endif
        }
    }
}

__global__ void dbg_copy(Params P, size_t off_bf16a, size_t off_bf16b, size_t off_f32) {
    const size_t n = (size_t)MMAIN * D;
    for (size_t i = (size_t)blockIdx.x * blockDim.x + threadIdx.x; i < n; i += (size_t)gridDim.x * blockDim.x) {
        float v = 0.f;
        if (off_bf16a) v += __uint_as_float(((unsigned)((const bf16_t*)(P.ws + off_bf16a))[i]) << 16);
        if (off_bf16b) v += __uint_as_float(((unsigned)((const bf16_t*)(P.ws + off_bf16b))[i]) << 16);
        if (off_f32) v += ((const float*)(P.ws + off_f32))[i];
        P.out[i] = v;
    }
}
extern "C" void kernel_launch(void* const* d_in, const int* in_sizes, int n_in, void* d_out, int out_size, void* d_ws, size_t ws_size, hipStream_t stream) {
    constexpr size_t kDynLds = 131072;
    static int grid_blocks = 0;
    if (!grid_blocks) {
        hipFuncSetAttribute((const void*)mk_forward, hipFuncAttributeMaxDynamicSharedMemorySize, (int)kDynLds);
        int dev = 0, cus = 0, per_cu = 0;
        hipGetDevice(&dev);
        hipDeviceGetAttribute(&cus, hipDeviceAttributeMultiprocessorCount, dev);
        hipOccupancyMaxActiveBlocksPerMultiprocessor(&per_cu, mk_forward, NTHR, kDynLds);
        if (per_cu < 1) per_cu = 1;
        grid_blocks = cus * per_cu;
        if (ws_size < WS_END) fprintf(stderr, "workspace too small: %zu < %zu\n", ws_size, (size_t)WS_END);
    }
    Params p{};
    for (int i = 0; i < 35; ++i) p.in[i] = (const float*)d_in[i];
    p.out = (float*)d_out; p.ws = (unsigned char*)d_ws;
#ifdef MULTI_LAUNCH
    for (int ph = 0; ph < NPHASE; ++ph) hipLaunchKernelGGL(mk_forward, dim3(grid_blocks), dim3(NTHR), kDynLds, stream, p, ph, ph + 1);
#ifdef DBG_A
    hipLaunchKernelGGL(dbg_copy, dim3(2048), dim3(256), 0, stream, p, (size_t)DBG_A, (size_t)DBG_B, (size_t)DBG_F);
#endif
#else
    int lo = 0, hi = NPHASE;
    void* args[] = {&p, &lo, &hi};
    hipError_t e = hipLaunchCooperativeKernel((void*)mk_forward, dim3(grid_blocks), dim3(NTHR), args, kDynLds, stream);
    if (e != hipSuccess) fprintf(stderr, "cooperative launch failed: %s (grid %d)\n", hipGetErrorString(e), grid_blocks);
#endif
}
```

```cpp
#include <hip/hip_runtime.h>
#include <hip/hip_cooperative_groups.h>
#include <cstdio>
namespace cg = cooperative_groups;

#define LAS __attribute__((address_space(3)))
typedef unsigned short bf16_t;
typedef short bf16x8 __attribute__((ext_vector_type(8)));
typedef float f32x4 __attribute__((ext_vector_type(4)));
typedef unsigned u32x2 __attribute__((ext_vector_type(2)));
typedef unsigned u32x4 __attribute__((ext_vector_type(4)));

constexpr int D = 2048, FF = 5632, NBATCH = 4, SEQ = 4096, NMETA = 16, L = SEQ + NMETA;
constexpr int M = NBATCH * L;
constexpr int MMAIN = NBATCH * SEQ;
constexpr int MP = 16640;
constexpr int NTHR = 512;
constexpr int PPAD = 112, PLEN = 4224;

constexpr size_t SZB = (size_t)MP * D * 2, SZF = 2 * SZB;
constexpr size_t OFF_WA = 0;
constexpr size_t OFF_WB = 37748736;
constexpr size_t OFF_HT = OFF_WB + 83886080;
constexpr size_t OFF_RB = OFF_HT + 1048576;
constexpr size_t OFF_VFIRST = OFF_RB + SZB;
constexpr size_t OFF_KF = OFF_VFIRST + SZB;
constexpr size_t OFF_VF = OFF_KF + SZF;
constexpr size_t OFF_DEC = OFF_VF + SZF;
constexpr size_t OFF_MIX = OFF_DEC + SZF;
constexpr size_t OFF_LORA = OFF_MIX + 3 * SZB;
constexpr size_t SZLORA = (size_t)MP * 256 * 2;
constexpr size_t WS_END = OFF_LORA + 4 * SZLORA;
constexpr size_t OFF_HN2 = OFF_KF, OFF_ACT = OFF_KF + SZB;
constexpr size_t WA_W0 = 0, WA_W1 = 8388608, WA_W2 = 16777216, WA_L1 = 25165824, WA_L2 = 29360128, WSLOT = 1048576;
constexpr size_t WB_WO = 0, WB_F1 = 8388608, WB_F2 = WB_F1 + (size_t)2 * FF * D * 2;

struct Params {
    const float* in[35];
    float* out;
    unsigned char* ws;
};

__device__ __forceinline__ int rowof(int b, int t) { return t < NMETA ? MMAIN + b * NMETA + t : b * SEQ + (t - NMETA); }
__device__ __forceinline__ float* hrow(const Params& P, int r) {
    return r < MMAIN ? P.out + (size_t)r * D : (float*)(P.ws + OFF_HT) + (size_t)(r - MMAIN) * D;
}
__device__ __forceinline__ unsigned cvt_pk_bf16(float lo, float hi) { unsigned r; asm volatile("v_cvt_pk_bf16_f32 %0, %1, %2" : "=v"(r) : "v"(lo), "v"(hi)); return r; }
__device__ __forceinline__ float bf_lo(unsigned x) { return __uint_as_float(x << 16); }
__device__ __forceinline__ float bf_hi(unsigned x) { return __uint_as_float(x & 0xffff0000u); }
template <int CTRL> __device__ __forceinline__ float dpp_mov(float x) {
    return __int_as_float(__builtin_amdgcn_update_dpp(0, __float_as_int(x), CTRL, 0xF, 0xF, true));
}
__device__ __forceinline__ float rowsum16(float x) {
    x += dpp_mov<0x128>(x); x += dpp_mov<0x124>(x); x += dpp_mov<0x122>(x); x += dpp_mov<0x121>(x); return x;
}
__device__ __forceinline__ float wavesum(float x) { x = rowsum16(x); x += __shfl_xor(x, 16); x += __shfl_xor(x, 32); return x; }
__device__ __forceinline__ int otid() { int t = threadIdx.x; asm volatile("" : "+v"(t)); return t; }
__device__ __forceinline__ int obid() { int t = blockIdx.x; asm volatile("" : "+s"(t)); return t; }
__device__ __forceinline__ float sigmoidf_(float x) { return 1.0f / (1.0f + __expf(-x)); }

constexpr int BM = 256, BK = 64, HALF = 128, HTB = HALF * BK * 2, NXCD = 8, WGM = 8, NMT = MMAIN / BM;
__device__ __forceinline__ int lds_byte(int r, int c) { const int st = (r >> 4) * 2 + (c >> 5), rr = r & 15, cc = c & 31, ob = rr * 64 + cc * 2; return st * 1024 + (ob ^ (((ob >> 9) & 1) << 5)); }
__device__ __forceinline__ void stage_rc(int b, int& R, int& C) { const int st = b / 1024, sb = b % 1024, swz = sb ^ (((sb >> 9) & 1) << 5); R = (st >> 1) * 16 + swz / 64; C = (st & 1) * 32 + (swz % 64) / 2; }

struct GD { unsigned long long A, Bt, o0, o1; int N, mode, bin, boff, ldo, pad; };
struct PE { int kind, layer, sub, ng, K, pad; GD g[4]; };
struct Unit { int pm, pn, gi; };

__device__ __forceinline__ bool sched_next(const int Lx, const int c1, const int c2, const int c3, const int c4, Unit& u) {
    if (Lx >= c4) return false;
    int gi = 0, base = 0, top = c1;
    if (Lx >= c1) { gi = 1; base = c1; top = c2; }
    if (Lx >= c2) { gi = 2; base = c2; top = c3; }
    if (Lx >= c3) { gi = 3; base = c3; top = c4; }
    const int nM = NMT, nwg = top - base, nN = nwg / NMT;
    int wgid = Lx - base; { const int q = nwg / NXCD, r = nwg % NXCD, xcd = wgid % NXCD, off = wgid / NXCD; wgid = (xcd < r ? xcd * (q + 1) : r * (q + 1) + (xcd - r) * q) + off; }
    const int nig = WGM * nN, gid = wgid / nig, fm = gid * WGM, gsz = (nM - fm) < WGM ? (nM - fm) : WGM;
    u.pm = fm + ((wgid % nig) % gsz); u.pn = (wgid % nig) / gsz; u.gi = gi; return true;
}

template <int MODE>
__device__ __forceinline__ void epi_elem(const int r, const int c, f32x4 v, void* g_o0, void* g_o1, const f32x4 bv, const int ldo, float* outp, float* htp) {
    if constexpr (MODE == 8) {
        float* p = (r < MMAIN ? outp + (size_t)r * D : htp + (size_t)(r - MMAIN) * D) + c; f32x4 hv = *(f32x4*)p; *(f32x4*)p = hv + v;
    } else if constexpr (MODE == 1) {
        *(f32x4*)((float*)g_o0 + (size_t)r * ldo + c) = v;
    } else if constexpr (MODE == 2) {
        *(f32x4*)((float*)g_o0 + (size_t)r * ldo + c) = v;
        u32x2 wv; wv.x = cvt_pk_bf16(v[0], v[1]); wv.y = cvt_pk_bf16(v[2], v[3]);
        *(u32x2*)((bf16_t*)g_o1 + (size_t)r * ldo + c) = wv;
    } else if constexpr (MODE == 5) {
        f32x4 o;
#pragma unroll
        for (int e = 0; e < 4; ++e) { const float x = -(bv[e] + v[e]); const float sp = fmaxf(x, 0.f) + __logf(1.0f + __expf(-fabsf(x))); const float wl = -sp - 0.5f; o[e] = __expf(-__expf(wl)); }
        *(f32x4*)((float*)g_o0 + (size_t)r * ldo + c) = o;
    } else if constexpr (MODE == 7) {
        bf16_t* vp = (bf16_t*)g_o0 + (size_t)r * ldo + c; const u32x2 vr_ = *(const u32x2*)vp; f32x4 vv; vv[0] = bf_lo(vr_.x); vv[1] = bf_hi(vr_.x); vv[2] = bf_lo(vr_.y); vv[3] = bf_hi(vr_.y);
        const u32x2 vf = *(const u32x2*)((const bf16_t*)g_o1 + (size_t)r * ldo + c);
        const float f0 = bf_lo(vf.x), f1 = bf_hi(vf.x), f2 = bf_lo(vf.y), f3 = bf_hi(vf.y);
        f32x4 o;
        o[0] = vv[0] + (f0 - vv[0]) * sigmoidf_(bv[0] + v[0]); o[1] = vv[1] + (f1 - vv[1]) * sigmoidf_(bv[1] + v[1]);
        o[2] = vv[2] + (f2 - vv[2]) * sigmoidf_(bv[2] + v[2]); o[3] = vv[3] + (f3 - vv[3]) * sigmoidf_(bv[3] + v[3]);
        u32x2 ow; ow.x = cvt_pk_bf16(o[0], o[1]); ow.y = cvt_pk_bf16(o[2], o[3]); *(u32x2*)vp = ow;
    } else {
        if constexpr (MODE == 3) {
#pragma unroll
            for (int e = 0; e < 4; ++e) { const float ax = fminf(fabsf(v[e]), 15.0f); const float t = 1.0f - 2.0f / (__expf(2.0f * ax) + 1.0f); v[e] = v[e] < 0.f ? -t : t; } }
        else if constexpr (MODE == 4) { v[0] = sigmoidf_(v[0]); v[1] = sigmoidf_(v[1]); v[2] = sigmoidf_(v[2]); v[3] = sigmoidf_(v[3]); }
        else if constexpr (MODE == 6) { v[0] = sigmoidf_(bv[0] + v[0]); v[1] = sigmoidf_(bv[1] + v[1]); v[2] = sigmoidf_(bv[2] + v[2]); v[3] = sigmoidf_(bv[3] + v[3]); }
        u32x2 wv; wv.x = cvt_pk_bf16(v[0], v[1]); wv.y = cvt_pk_bf16(v[2], v[3]);
        *(u32x2*)((bf16_t*)g_o0 + (size_t)r * ldo + c) = wv;
    }
}
__device__ __forceinline__ void epi_swiglu(const int r, const int oc, const f32x4 g, const f32x4 up, void* g_o0, const int ldo) {
    float o[4];
#pragma unroll
    for (int e = 0; e < 4; ++e) o[e] = g[e] * __builtin_amdgcn_rcpf(1.0f + __expf(-g[e])) * up[e];
    u32x2 wv; wv.x = cvt_pk_bf16(o[0], o[1]); wv.y = cvt_pk_bf16(o[2], o[3]);
    *(u32x2*)((bf16_t*)g_o0 + (size_t)r * ldo + oc) = wv;
}
template <int MODE>
__device__ __forceinline__ void epi_t(const f32x4 (&acc)[2][2][4][2], void* g_o0, void* g_o1, const float* g_bias, const int ldo, const int u_pm, const int u_pn, int wr, int wc, int fr, int fq, float* outp, float* htp) {
    const int row0 = u_pm * BM + wr * 64 + fr, col0 = u_pn * BM + wc * 32 + 4 * fq;
    f32x4 bvv[2][2];
#pragma unroll
    for (int bj = 0; bj < 2; ++bj)
#pragma unroll
        for (int n = 0; n < 2; ++n) bvv[bj][n] = (MODE == 5 || MODE == 6 || MODE == 7) ? *(const f32x4*)(g_bias + col0 + bj * HALF + n * 16) : (f32x4){0.f, 0.f, 0.f, 0.f};
    if constexpr (MODE == 7) {
#pragma unroll
        for (int ai = 0; ai < 2; ++ai) {
#pragma unroll
            for (int mh = 0; mh < 2; ++mh) {
                f32x4 vv[2][2][2]; u32x2 vf[2][2][2];
#pragma unroll
                for (int ml = 0; ml < 2; ++ml) { const size_t o = (size_t)(row0 + ai * HALF + (2 * mh + ml) * 16) * ldo + col0;
#pragma unroll
                    for (int bj = 0; bj < 2; ++bj)
#pragma unroll
                        for (int n = 0; n < 2; ++n) { const u32x2 vr_ = *(const u32x2*)((const bf16_t*)g_o0 + o + bj * HALF + n * 16);
                            vv[ml][bj][n][0] = bf_lo(vr_.x); vv[ml][bj][n][1] = bf_hi(vr_.x); vv[ml][bj][n][2] = bf_lo(vr_.y); vv[ml][bj][n][3] = bf_hi(vr_.y);
                            vf[ml][bj][n] = *(const u32x2*)((const bf16_t*)g_o1 + o + bj * HALF + n * 16); } }
#pragma unroll
                for (int ml = 0; ml < 2; ++ml) { const size_t o = (size_t)(row0 + ai * HALF + (2 * mh + ml) * 16) * ldo + col0;
#pragma unroll
                    for (int bj = 0; bj < 2; ++bj)
#pragma unroll
                        for (int n = 0; n < 2; ++n) { const f32x4 a = acc[ai][bj][2 * mh + ml][n], x = vv[ml][bj][n], bb = bvv[bj][n]; const u32x2 f = vf[ml][bj][n];
                            f32x4 ov;
                            ov[0] = x[0] + (bf_lo(f.x) - x[0]) * sigmoidf_(bb[0] + a[0]); ov[1] = x[1] + (bf_hi(f.x) - x[1]) * sigmoidf_(bb[1] + a[1]);
                            ov[2] = x[2] + (bf_lo(f.y) - x[2]) * sigmoidf_(bb[2] + a[2]); ov[3] = x[3] + (bf_hi(f.y) - x[3]) * sigmoidf_(bb[3] + a[3]);
                            u32x2 ow; ow.x = cvt_pk_bf16(ov[0], ov[1]); ow.y = cvt_pk_bf16(ov[2], ov[3]);
                            *(u32x2*)((bf16_t*)g_o0 + o + bj * HALF + n * 16) = ow; } }
            }
        }
        return;
    }
    if constexpr (MODE == 8) {
#pragma unroll
        for (int ai = 0; ai < 2; ++ai) {
            f32x4 hv[4][2][2];
#pragma unroll
            for (int m = 0; m < 4; ++m) { const int r = row0 + ai * HALF + m * 16; float* p = (r < MMAIN ? outp + (size_t)r * D : htp + (size_t)(r - MMAIN) * D) + col0;
#pragma unroll
                for (int bj = 0; bj < 2; ++bj)
#pragma unroll
                    for (int n = 0; n < 2; ++n) hv[m][bj][n] = *(const f32x4*)(p + bj * HALF + n * 16); }
#pragma unroll
            for (int m = 0; m < 4; ++m) { const int r = row0 + ai * HALF + m * 16; float* p = (r < MMAIN ? outp + (size_t)r * D : htp + (size_t)(r - MMAIN) * D) + col0;
#pragma unroll
                for (int bj = 0; bj < 2; ++bj)
#pragma unroll
                    for (int n = 0; n < 2; ++n) *(f32x4*)(p + bj * HALF + n * 16) = hv[m][bj][n] + acc[ai][bj][m][n]; }
        }
        return;
    }
#pragma unroll
    for (int ai = 0; ai < 2; ++ai) {
#pragma unroll
        for (int m = 0; m < 4; ++m) {
            const int r = row0 + ai * HALF + m * 16;
            if constexpr (MODE == 9) {
#pragma unroll
                for (int bj = 0; bj < 2; ++bj)
                    epi_swiglu(r, 16 * (u_pn * 8 + bj * 4 + wc) + 4 * fq, acc[ai][bj][m][0], acc[ai][bj][m][1], g_o0, ldo);
            } else if constexpr (MODE == 8 || MODE == 7) {
            } else {
#pragma unroll
                for (int bj = 0; bj < 2; ++bj) {
#pragma unroll
                    for (int n = 0; n < 2; ++n)
                        epi_elem<MODE>(r, col0 + bj * HALF + n * 16, acc[ai][bj][m][n], g_o0, g_o1, bvv[bj][n], ldo, outp, htp);
                }
            }
        }
    }
}
#define EPI_CALL(MD) epi_t<MD>(acc, g_o0, g_o1, g_bias, ldo, u_pm, u_pn, wr, wc, fr, fq, outp, htp)
__device__ __forceinline__ void epilogue(const f32x4 (&acc)[2][2][4][2], const int mode, void* g_o0, void* g_o1, const float* g_bias, const int ldo, const int u_pm, const int u_pn, int wr, int wc, int fr, int fq, float* outp, float* htp) {
    switch (mode) {
        case 0: EPI_CALL(0); break;
        case 1: EPI_CALL(1); break;
        case 2: EPI_CALL(2); break;
        case 3: EPI_CALL(3); break;
        case 4: EPI_CALL(4); break;
        case 5: EPI_CALL(5); break;
        case 6: EPI_CALL(6); break;
        case 7: EPI_CALL(7); break;
        case 8: EPI_CALL(8); break;
        default: EPI_CALL(9); break;
    }
}

__device__ __forceinline__ void gemm_phase(LAS unsigned char* lds, const PE* pe, const Params& P) {
    const int tid = threadIdx.x, wid = __builtin_amdgcn_readfirstlane(tid >> 6), lane = tid & 63, wr = wid >> 2, wc = wid & 3, fr = lane & 15, fq = lane >> 4;
    const int K = pe->K, nt = K / BK;
    const int sG = (int)gridDim.x, sC = (int)blockIdx.x, s_ng = pe->ng;
    const int sc1 = NMT * (pe->g[0].N / BM);
    const int sc2 = sc1 + (s_ng > 1 ? NMT * (pe->g[1].N / BM) : 0);
    const int sc3 = sc2 + (s_ng > 2 ? NMT * (pe->g[2].N / BM) : 0);
    const int sc4 = sc3 + (s_ng > 3 ? NMT * (pe->g[3].N / BM) : 0);
    unsigned char* const ws = P.ws;
    unsigned voff[2];
#pragma unroll
    for (int i = 0; i < 2; ++i) { int R, C; stage_rc(tid * 16 + i * 8192, R, C); voff[i] = (unsigned)(R * K + C) * 2u; }
    const size_t kstep = (size_t)(BK * 2);
    const size_t hstep = (size_t)HALF * K * 2;
    const size_t tstep = 2 * hstep;
    const unsigned ldsw = (unsigned)wid * 1024u;
    const int aoff = lds_byte(wr * 64 + fr, fq * 8), boff = lds_byte(wc * 32 + fr, fq * 8);
#define PG8_SA(b, h) (((b) * 2 + (h)) * HTB)
#define PG8_SB(b, h) ((4 + (b) * 2 + (h)) * HTB)
#define PG8_STAGE(bufoff, gbase) do { _Pragma("unroll") for (int _i = 0; _i < 2; ++_i) \
        __builtin_amdgcn_global_load_lds((const unsigned*)((const char*)(gbase) + voff[_i]), (LAS unsigned*)(lds + (bufoff) + ldsw + _i * 8192), 16, 0, 0); } while (0)
#define PG8_LDA(dst, b, h) do { _Pragma("unroll") for (int m = 0; m < 4; ++m) _Pragma("unroll") for (int k = 0; k < 2; ++k) dst[m][k] = *(const LAS bf16x8*)(lds + PG8_SA(b, h) + aoff + m * 2048 + k * 1024); } while (0)
#define PG8_LDB(dst, b, h) do { _Pragma("unroll") for (int n = 0; n < 2; ++n) _Pragma("unroll") for (int k = 0; k < 2; ++k) dst[n][k] = *(const LAS bf16x8*)(lds + PG8_SB(b, h) + boff + n * 2048 + k * 1024); } while (0)
#define PG8_MMA(ai, bj, At, Bt) do { __builtin_amdgcn_s_setprio(1); _Pragma("unroll") for (int m = 0; m < 4; ++m) _Pragma("unroll") for (int n = 0; n < 2; ++n) _Pragma("unroll") for (int k = 0; k < 2; ++k) \
        acc[ai][bj][m][n] = __builtin_amdgcn_mfma_f32_16x16x32_bf16(Bt[n][k], At[m][k], acc[ai][bj][m][n], 0, 0, 0); __builtin_amdgcn_s_setprio(0); } while (0)
#define PG8_WAIT_V(n) asm volatile("s_waitcnt vmcnt(" #n ")" ::: "memory")
#define PG8_WAIT_L(n) asm volatile("s_waitcnt lgkmcnt(" #n ")" ::: "memory")
#define PG8_BAR __builtin_amdgcn_s_barrier()
#define PG8_SCHED __builtin_amdgcn_sched_barrier(0)
    Unit cur, nxt; int ui = 0;
    if (!sched_next(sC, sc1, sc2, sc3, sc4, cur)) return;
    f32x4 acc[2][2][4][2];
#pragma unroll
    for (int a = 0; a < 2; ++a)
#pragma unroll
        for (int b = 0; b < 2; ++b)
#pragma unroll
            for (int m = 0; m < 4; ++m)
#pragma unroll
                for (int n = 0; n < 2; ++n) acc[a][b][m][n] = (f32x4){0.f, 0.f, 0.f, 0.f};
    bf16x8 At[4][2], B0[2][2], B1[2][2];
    const char* cA = (const char*)ws + pe->g[cur.gi].A + (size_t)cur.pm * tstep; const char* cB = (const char*)ws + pe->g[cur.gi].Bt + (size_t)cur.pn * tstep;
    PG8_STAGE(PG8_SB(0, 0), cB); PG8_STAGE(PG8_SA(0, 0), cA); PG8_STAGE(PG8_SB(0, 1), cB + hstep); PG8_STAGE(PG8_SA(0, 1), cA + hstep);
    if (wr == 1) PG8_BAR;
    PG8_WAIT_V(4); PG8_BAR;
    PG8_STAGE(PG8_SB(1, 0), cB + kstep); PG8_STAGE(PG8_SA(1, 0), cA + kstep); PG8_STAGE(PG8_SB(1, 1), cB + hstep + kstep);
    PG8_WAIT_V(6); PG8_BAR;
    for (;;) {
        const bool has_next = sched_next((ui + 1) * sG + sC, sc1, sc2, sc3, sc4, nxt);
        const char* nA = cA; const char* nB = cB;
        if (has_next) { nA = (const char*)ws + pe->g[nxt.gi].A + (size_t)nxt.pm * tstep; nB = (const char*)ws + pe->g[nxt.gi].Bt + (size_t)nxt.pn * tstep; }
        for (int t = 0; t < nt; t += 2) {
            const bool last = (t == nt - 2);
            const char* a1 = cA + (size_t)(t + 1) * kstep;
            const char* a2 = last ? nA : cA + (size_t)(t + 2) * kstep; const char* b2 = last ? nB : cB + (size_t)(t + 2) * kstep;
            const char* a3 = a2 + kstep; const char* b3 = b2 + kstep;
            PG8_LDB(B0, 0, 0); PG8_SCHED; PG8_LDA(At, 0, 0); PG8_STAGE(PG8_SA(1, 1), a1 + hstep);
            PG8_WAIT_L(8); PG8_BAR; PG8_WAIT_L(0); PG8_MMA(0, 0, At, B0); PG8_BAR; PG8_SCHED;
            PG8_LDB(B1, 0, 1); PG8_STAGE(PG8_SB(0, 0), b2);
            PG8_BAR; PG8_WAIT_L(0); PG8_MMA(0, 1, At, B1); PG8_BAR;
            PG8_LDA(At, 0, 1); PG8_STAGE(PG8_SA(0, 0), a2);
            PG8_BAR; PG8_WAIT_L(0); PG8_MMA(1, 0, At, B0); PG8_BAR; PG8_SCHED;
            PG8_STAGE(PG8_SB(0, 1), b2 + hstep);
            PG8_WAIT_V(6); PG8_BAR; PG8_MMA(1, 1, At, B1); PG8_BAR;
            PG8_LDB(B0, 1, 0); PG8_SCHED; PG8_LDA(At, 1, 0); PG8_STAGE(PG8_SA(0, 1), a2 + hstep);
            PG8_WAIT_L(8); PG8_BAR; PG8_WAIT_L(0); PG8_MMA(0, 0, At, B0); PG8_BAR; PG8_SCHED;
            PG8_LDB(B1, 1, 1); PG8_STAGE(PG8_SB(1, 0), b3);
            PG8_BAR; PG8_WAIT_L(0); PG8_MMA(0, 1, At, B1); PG8_BAR;
            PG8_LDA(At, 1, 1); PG8_STAGE(PG8_SA(1, 0), a3);
            PG8_BAR; PG8_WAIT_L(0); PG8_MMA(1, 0, At, B0); PG8_BAR; PG8_SCHED;
            PG8_STAGE(PG8_SB(1, 1), b3 + hstep);
            PG8_WAIT_V(6); PG8_BAR; PG8_MMA(1, 1, At, B1); PG8_BAR;
        }
        { const GD* gd = &pe->g[cur.gi];
          epilogue(acc, gd->mode, ws + gd->o0, ws + gd->o1, P.in[gd->bin] + gd->boff, gd->ldo, cur.pm, cur.pn, wr, wc, fr, fq, P.out, (float*)(ws + OFF_HT)); }
        if (!has_next) break;
#pragma unroll
        for (int a = 0; a < 2; ++a)
#pragma unroll
            for (int b = 0; b < 2; ++b)
#pragma unroll
                for (int m = 0; m < 4; ++m)
#pragma unroll
                    for (int n = 0; n < 2; ++n) acc[a][b][m][n] = (f32x4){0.f, 0.f, 0.f, 0.f};
        cur = nxt; cA = nA; cB = nB; ++ui;
    }
    PG8_WAIT_V(0);
    if (wr == 0) PG8_BAR;
    PG8_BAR;
#undef PG8_SA
#undef PG8_SB
#undef PG8_STAGE
#undef PG8_LDA
#undef PG8_LDB
#undef PG8_MMA
#undef PG8_WAIT_V
#undef PG8_WAIT_L
#undef PG8_BAR
#undef PG8_SCHED
}

#define TE_CALL(MD) epi_elem<MD>(r, c, v, o0, o1, bvt, ldo, P.out, (float*)(ws + OFF_HT))
__device__ void tail_gemm(LAS unsigned char* lds, const PE* pe, const Params& P) {
    const int tid = otid(), w = tid >> 6, lane = tid & 63, fr = lane & 15, fq = lane >> 4;
    unsigned char* const ws = P.ws;
    const int K = pe->K, ks = K >> 3, nstep = ks >> 5, ng = pe->ng;
    const int t1 = pe->g[0].N >> 4;
    const int t2 = t1 + (ng > 1 ? pe->g[1].N >> 4 : 0);
    const int t3 = t2 + (ng > 2 ? pe->g[2].N >> 4 : 0);
    const int t4 = t3 + (ng > 3 ? pe->g[3].N >> 4 : 0);
    LAS f32x4* part = (LAS f32x4*)lds;
    const int bid_ = obid();
    const int rank_ = (bid_ & 1) ? (bid_ >> 1) : ((int)(gridDim.x >> 1) + (bid_ >> 1));
    for (int item = rank_; item < t4; item += gridDim.x) {
        int gi = 0, base = 0;
        if (item >= t1) { gi = 1; base = t1; }
        if (item >= t2) { gi = 2; base = t2; }
        if (item >= t3) { gi = 3; base = t3; }
        const int cb = (item - base) >> 1, mh = (item - base) & 1;
        const GD* gd = &pe->g[gi];
        const bf16_t* A = (const bf16_t*)(ws + gd->A) + (size_t)(MMAIN + 32 * mh + fr) * K + (size_t)w * ks + 8 * fq;
        const bf16_t* Bt = (const bf16_t*)(ws + gd->Bt) + (size_t)(32 * cb + fr) * K + (size_t)w * ks + 8 * fq;
        const size_t r16 = (size_t)16 * K;
        f32x4 acc[2][2];
#pragma unroll
        for (int m = 0; m < 2; ++m) { acc[m][0] = (f32x4){0.f, 0.f, 0.f, 0.f}; acc[m][1] = acc[m][0]; }
        for (int s0 = 0; s0 < nstep; s0 += 8) {
            bf16x8 af[8][2], bfr[8][2];
#pragma unroll
            for (int s = 0; s < 8; ++s) if (s0 + s < nstep) {
                const int k0 = (s0 + s) * 32;
                af[s][0] = *(const bf16x8*)(A + k0); af[s][1] = *(const bf16x8*)(A + r16 + k0);
                bfr[s][0] = *(const bf16x8*)(Bt + k0); bfr[s][1] = *(const bf16x8*)(Bt + r16 + k0);
            }
#pragma unroll
            for (int s = 0; s < 8; ++s) if (s0 + s < nstep) {
#pragma unroll
                for (int m = 0; m < 2; ++m)
#pragma unroll
                    for (int nb = 0; nb < 2; ++nb) acc[m][nb] = __builtin_amdgcn_mfma_f32_16x16x32_bf16(bfr[s][nb], af[s][m], acc[m][nb], 0, 0, 0);
            }
        }
        __syncthreads();
#pragma unroll
        for (int m = 0; m < 2; ++m)
#pragma unroll
            for (int nb = 0; nb < 2; ++nb) part[(w * 4 + m * 2 + nb) * 64 + lane] = acc[m][nb];
        __syncthreads();
        if (tid < 256) {
            const int ml = tid >> 7, nb2 = (tid >> 6) & 1;
            f32x4 v = part[(ml * 2 + nb2) * 64 + lane];
#pragma unroll
            for (int x = 1; x < 8; ++x) v += part[(x * 4 + ml * 2 + nb2) * 64 + lane];
            const int r = MMAIN + 32 * mh + 16 * ml + fr, c = 32 * cb + 16 * nb2 + 4 * fq;
            const int mode = gd->mode, ldo = gd->ldo;
            void* o0 = ws + gd->o0; void* o1 = ws + gd->o1; const float* bias = P.in[gd->bin] + gd->boff;
            const f32x4 bvt = (mode == 5 || mode == 6 || mode == 7) ? *(const f32x4*)(bias + c) : (f32x4){0.f, 0.f, 0.f, 0.f};
            if (mode == 9) {
                if (nb2 == 0) { f32x4 up = part[(ml * 2 + 1) * 64 + lane];
#pragma unroll
                    for (int x = 1; x < 8; ++x) up += part[(x * 4 + ml * 2 + 1) * 64 + lane];
                    epi_swiglu(r, 16 * cb + 4 * fq, v, up, o0, ldo); }
            } else {
                switch (mode) {
                    case 0: TE_CALL(0); break;
                    case 1: TE_CALL(1); break;
                    case 2: TE_CALL(2); break;
                    case 3: TE_CALL(3); break;
                    case 4: TE_CALL(4); break;
                    case 5: TE_CALL(5); break;
                    case 6: TE_CALL(6); break;
                    case 7: TE_CALL(7); break;
                    default: TE_CALL(8); break;
                }
            }
        }
    }
}

__device__ void conv_T(const float* src, const float* src2, int ldsrc, bf16_t* dst, int K, int N, int Kpad, int Npad, int mode, LAS float* tile) {
    const int tid = otid();
    const int tk = Kpad / 256, tn = Npad / 64, ntile = tk * tn;
    for (int ti = obid(); ti < ntile; ti += gridDim.x) {
        const int R0 = (ti / tk) * 64, k0 = (ti % tk) * 256;
        f32x4 v[4][2];
#pragma unroll
        for (int sub = 0; sub < 4; ++sub)
#pragma unroll
            for (int pass = 0; pass < 2; ++pass) {
                const int kr = (tid >> 4) + pass * 32, c4 = (tid & 15) * 4;
                const int k = k0 + sub * 64 + kr, R = R0 + c4;
                v[sub][pass] = (f32x4){0.f, 0.f, 0.f, 0.f};
                if (k < K && R < N) {
                    const float* s; int col;
                    if (mode == 1) { const int g = R >> 5, wi = R & 31; s = wi < 16 ? src : src2; col = 16 * g + (wi & 15); }
                    else { s = src; col = R; }
                    v[sub][pass] = *(const f32x4*)(s + (size_t)k * ldsrc + col);
                }
            }
        __syncthreads();
#pragma unroll
        for (int sub = 0; sub < 4; ++sub)
#pragma unroll
            for (int pass = 0; pass < 2; ++pass) {
                const int kr = (tid >> 4) + pass * 32, c4 = (tid & 15) * 4;
                LAS float* t = tile + sub * (64 * 65) + kr * 65 + c4;
                t[0] = v[sub][pass][0]; t[1] = v[sub][pass][1]; t[2] = v[sub][pass][2]; t[3] = v[sub][pass][3];
            }
        __syncthreads();
        const int Rr = tid >> 3, k8 = (tid & 7) * 8;
#pragma unroll
        for (int sub = 0; sub < 4; ++sub) {
            float e[8];
#pragma unroll
            for (int i = 0; i < 8; ++i) e[i] = tile[sub * (64 * 65) + (k8 + i) * 65 + Rr];
            u32x4 o; o.x = cvt_pk_bf16(e[0], e[1]); o.y = cvt_pk_bf16(e[2], e[3]); o.z = cvt_pk_bf16(e[4], e[5]); o.w = cvt_pk_bf16(e[6], e[7]);
            *(u32x4*)(dst + (size_t)(R0 + Rr) * Kpad + k0 + sub * 64 + k8) = o;
        }
    }
}

struct CJ { int in0, in1, ldsrc, K, N, Kpad, Npad, mode; unsigned long long soff, doff; };
struct CJTab { CJ j[4][14]; int n[4]; };
constexpr CJ mkcj(int in0, int in1, unsigned long long soff, int ldsrc, unsigned long long doff, int K, int N, int Kpad, int Npad, int mode) {
    CJ c{}; c.in0 = in0; c.in1 = in1; c.ldsrc = ldsrc; c.K = K; c.N = N; c.Kpad = Kpad; c.Npad = Npad; c.mode = mode; c.soff = soff; c.doff = doff; return c;
}
constexpr CJTab make_cjtab() {
    CJTab t{};
    const unsigned long long DD = (unsigned long long)D * D, DF = (unsigned long long)D * FF;
    for (int layer = 0; layer < 4; ++layer) {
        int n = 0;
        if (layer < 2) {
            const unsigned long long i = layer;
            t.j[layer][n++] = mkcj(8, 8, i * DD, D, OFF_WA + WA_W0, D, D, D, D, 0);
            t.j[layer][n++] = mkcj(9, 9, i * DD, D, OFF_WA + WA_W1, D, D, D, D, 0);
            t.j[layer][n++] = mkcj(10, 10, i * DD, D, OFF_WA + WA_W2, D, D, D, D, 0);
            t.j[layer][n++] = mkcj(13, 13, i * D * 96, 96, OFF_WA + WA_L1 + 0 * WSLOT, D, 96, D, 256, 0);
            t.j[layer][n++] = mkcj(16, 16, i * D * 96, 96, OFF_WA + WA_L1 + 1 * WSLOT, D, 96, D, 256, 0);
            t.j[layer][n++] = mkcj(18, 18, i * D * 256, 256, OFF_WA + WA_L1 + 2 * WSLOT, D, 256, D, 256, 0);
            t.j[layer][n++] = mkcj(14, 14, i * 96 * D, D, OFF_WA + WA_L2 + 0 * WSLOT, 96, D, 256, D, 0);
            t.j[layer][n++] = mkcj(17, 17, i * 96 * D, D, OFF_WA + WA_L2 + 1 * WSLOT, 96, D, 256, D, 0);
            t.j[layer][n++] = mkcj(19, 19, i * 256 * D, D, OFF_WA + WA_L2 + 2 * WSLOT, 256, D, 256, D, 0);
            if (layer >= 1) {
                t.j[layer][n++] = mkcj(26, 26, (i - 1) * D * 64, 64, OFF_WA + WA_L1 + 3 * WSLOT, D, 64, D, 256, 0);
                t.j[layer][n++] = mkcj(27, 27, (i - 1) * 64 * D, D, OFF_WA + WA_L2 + 3 * WSLOT, 64, D, 256, D, 0);
            }
            t.j[layer][n++] = mkcj(11, 11, i * DD, D, OFF_WB + WB_WO, D, D, D, D, 0);
        } else {
            const unsigned long long jj = layer - 2;
            t.j[layer][n++] = mkcj(32, 32, jj * DD, D, OFF_WA + WA_W0, D, D, D, D, 0);
            if (layer == 2) {
                t.j[layer][n++] = mkcj(29, 29, 0, D, OFF_WA + WA_W1, D, D, D, D, 0);
                t.j[layer][n++] = mkcj(30, 30, 0, D, OFF_WA + WA_W2, D, D, D, D, 0);
            }
            t.j[layer][n++] = mkcj(34, 34, jj * DD, D, OFF_WB + WB_WO, D, D, D, D, 0);
        }
        t.j[layer][n++] = mkcj(4, 5, (unsigned long long)layer * DF, FF, OFF_WB + WB_F1, D, 2 * FF, D, 2 * FF, 1);
        t.j[layer][n++] = mkcj(6, 6, (unsigned long long)layer * DF, D, OFF_WB + WB_F2, FF, D, FF, D, 0);
        t.n[layer] = n;
    }
    return t;
}
__constant__ const CJTab CJT = make_cjtab();

__device__ void convert_layer(const Params& P, int layer, LAS unsigned char* lds) {
    LAS float* tile = (LAS float*)lds;
    const int nj = CJT.n[layer];
    for (int q = 0; q < nj; ++q) {
        const CJ* c = &CJT.j[layer][q];
        conv_T(P.in[c->in0] + c->soff, P.in[c->in1] + c->soff, c->ldsrc, (bf16_t*)(P.ws + c->doff), c->K, c->N, c->Kpad, c->Npad, c->mode, tile);
    }
}

__device__ void init_phase(const Params& P) {
    const f32x4* x = (const f32x4*)P.in[0]; f32x4* o = (f32x4*)P.out;
    const size_t n4 = (size_t)MMAIN * D / 4;
    for (size_t i = (size_t)obid() * NTHR + otid(); i < n4; i += (size_t)gridDim.x * NTHR) o[i] = x[i];
    const f32x4* mt = (const f32x4*)P.in[1]; f32x4* ht = (f32x4*)(P.ws + OFF_HT);
    const int m4 = NBATCH * NMETA * D / 4, per = NMETA * D / 4;
    for (int i = obid() * NTHR + otid(); i < m4; i += gridDim.x * NTHR) ht[i] = mt[i % per];
}

__device__ void mixprep_phase(const Params& P, int i) {
    const int tid_ = otid(); const int w = tid_ >> 6, lane = tid_ & 63;
    const float* g = P.in[2] + (size_t)i * D;
    const float* mu = P.in[7] + (size_t)i * 6 * D;
    bf16_t* const ob[6] = {(bf16_t*)(P.ws + OFF_MIX), (bf16_t*)(P.ws + OFF_DEC), (bf16_t*)(P.ws + OFF_MIX + SZB), (bf16_t*)(P.ws + OFF_MIX + 2 * SZB),
                           (bf16_t*)(P.ws + OFF_DEC + SZB), (bf16_t*)(P.ws + OFF_KF)};
    for (int idx = obid() * 8 + w; idx < M; idx += gridDim.x * 8) {
        const int b = idx / L, t = idx % L;
        const int r = rowof(b, t), rprev = rowof(b, t > 0 ? t - 1 : 0);
        const float* hc; const float* hp;
        if (i == 0) {
            hc = r < MMAIN ? P.in[0] + (size_t)r * D : P.in[1] + (size_t)((r - MMAIN) & 15) * D;
            hp = rprev < MMAIN ? P.in[0] + (size_t)rprev * D : P.in[1] + (size_t)((rprev - MMAIN) & 15) * D;
        } else { hc = hrow(P, r); hp = hrow(P, rprev); }
        float* hw = hrow(P, r);
        f32x4 c[8], p[8]; float sc = 0.f, sp = 0.f;
#pragma unroll
        for (int q = 0; q < 8; ++q) { c[q] = *(const f32x4*)(hc + 256 * q + 4 * lane); p[q] = *(const f32x4*)(hp + 256 * q + 4 * lane);
            sc += c[q][0] * c[q][0] + c[q][1] * c[q][1] + c[q][2] * c[q][2] + c[q][3] * c[q][3];
            sp += p[q][0] * p[q][0] + p[q][1] * p[q][1] + p[q][2] * p[q][2] + p[q][3] * p[q][3]; }
        if (i == 0) {
#pragma unroll
            for (int q = 0; q < 8; ++q) *(f32x4*)(hw + 256 * q + 4 * lane) = c[q];
        }
        sc = wavesum(sc); sp = wavesum(sp);
        const float rc = rsqrtf(sc * (1.0f / D) + 1e-6f);
        const float rp = t > 0 ? rsqrtf(sp * (1.0f / D) + 1e-6f) : 0.f;
#pragma unroll
        for (int q = 0; q < 8; ++q) {
            const int col = 256 * q + 4 * lane;
            const f32x4 gv = *(const f32x4*)(g + col);
            f32x4 hn, xx;
#pragma unroll
            for (int e = 0; e < 4; ++e) { hn[e] = c[q][e] * rc * gv[e]; xx[e] = p[q][e] * rp * gv[e] - hn[e]; }
#pragma unroll
            for (int j = 0; j < 6; ++j) {
                const f32x4 m = *(const f32x4*)(mu + j * D + col);
                u32x2 a; a.x = cvt_pk_bf16(hn[0] + xx[0] * m[0], hn[1] + xx[1] * m[1]); a.y = cvt_pk_bf16(hn[2] + xx[2] * m[2], hn[3] + xx[3] * m[3]);
                *(u32x2*)(ob[j] + (size_t)r * D + col) = a;
            }
        }
    }
}

__device__ void norm_phase(const Params& P, const float* g1, bf16_t* o1, const float* g2, bf16_t* o2) {
    const int tid_ = otid(); const int w = tid_ >> 6, lane = tid_ & 63;
    for (int r = obid() * 8 + w; r < M; r += gridDim.x * 8) {
        const float* hc = hrow(P, r);
        f32x4 c[8]; float sc = 0.f;
#pragma unroll
        for (int q = 0; q < 8; ++q) { c[q] = *(const f32x4*)(hc + 256 * q + 4 * lane); sc += c[q][0] * c[q][0] + c[q][1] * c[q][1] + c[q][2] * c[q][2] + c[q][3] * c[q][3]; }
        sc = wavesum(sc);
        const float rc = rsqrtf(sc * (1.0f / D) + 1e-6f);
#pragma unroll
        for (int q = 0; q < 8; ++q) {
            const int col = 256 * q + 4 * lane;
            const f32x4 gv = *(const f32x4*)(g1 + col);
            u32x2 a; a.x = cvt_pk_bf16(c[q][0] * rc * gv[0], c[q][1] * rc * gv[1]); a.y = cvt_pk_bf16(c[q][2] * rc * gv[2], c[q][3] * rc * gv[3]);
            *(u32x2*)(o1 + (size_t)r * D + col) = a;
            if (g2) { const f32x4 g2v = *(const f32x4*)(g2 + col);
                u32x2 bq; bq.x = cvt_pk_bf16(c[q][0] * rc * g2v[0], c[q][1] * rc * g2v[1]); bq.y = cvt_pk_bf16(c[q][2] * rc * g2v[2], c[q][3] * rc * g2v[3]);
                *(u32x2*)(o2 + (size_t)r * D + col) = bq; }
        }
    }
}

__device__ void scan_phase(const Params& P, int i, LAS unsigned char* lds) {
    const int tid = otid(), w = tid >> 6, lane = tid & 63;
    const bf16_t* RB = (const bf16_t*)(P.ws + OFF_RB); const bf16_t* KF = (const bf16_t*)(P.ws + OFF_KF);
    const bf16_t* VF = (const bf16_t*)(P.ws + (i == 0 ? OFF_VFIRST : OFF_VF)); const float* DEC = (const float*)(P.ws + OFF_DEC);
    const bf16_t* AB = (const bf16_t*)(P.ws + OFF_MIX); bf16_t* YB = (bf16_t*)(P.ws + OFF_MIX + 2 * SZB);
    const float* k_k = P.in[20] + (size_t)i * D; const float* k_a = P.in[21] + (size_t)i * D; const float* r_k = P.in[22] + (size_t)i * D;
    float* SBON = (float*)(P.ws + OFF_LORA);
    LAS float* fl = (LAS float*)lds;
    constexpr int STG = 11264;
    LAS float* ybuf = fl + 2 * STG;
    typedef float f32x2 __attribute__((ext_vector_type(2)));
    const int wu = __builtin_amdgcn_readfirstlane(w);
    const int kg = lane & 15, rp = 4 * (wu & 3) + (lane >> 4);
    const int lt = tid & 255;
    const int lc = (lt & 15) * 4, vt = lt >> 3, vc = (lt & 7) * 4;
    constexpr int NCH = (L + 31) / 32;
    for (int u = obid(); u < 256; u += gridDim.x) {
        const int bh = u >> 1, rh = u & 1, b = bh >> 5, h = bh & 31;
        f32x4 kkp = (f32x4){0.f, 0.f, 0.f, 0.f}, kap = kkp, rkp = kkp;
        f32x4 gk[2], gd[2], gv; u32x2 gr[2], ga[2];
        __syncthreads();
#define SCAN_LOAD(cc) do { _Pragma("unroll") for (int q_ = 0; q_ < 2; ++q_) { const int t_ = 32 * (cc) + (lt >> 4) + 16 * q_; \
              gk[q_] = (f32x4){0.f, 0.f, 0.f, 0.f}; gd[q_] = gk[q_]; gr[q_] = (u32x2){0u, 0u}; ga[q_] = gr[q_]; \
              if (t_ < L) { const size_t o_ = (size_t)rowof(b, t_) * D + 64 * h + lc; { const u32x2 kr_ = *(const u32x2*)(KF + o_); gk[q_][0] = bf_lo(kr_.x); gk[q_][1] = bf_hi(kr_.x); gk[q_][2] = bf_lo(kr_.y); gk[q_][3] = bf_hi(kr_.y); } gd[q_] = *(const f32x4*)(DEC + o_); gr[q_] = *(const u32x2*)(RB + o_); ga[q_] = *(const u32x2*)(AB + o_); } } \
            { const int tv_ = 32 * (cc) + vt; gv = (f32x4){0.f, 0.f, 0.f, 0.f}; if (tv_ < L) { const u32x2 vr_ = *(const u32x2*)(VF + (size_t)rowof(b, tv_) * D + 64 * h + 32 * rh + vc); gv[0] = bf_lo(vr_.x); gv[1] = bf_hi(vr_.x); gv[2] = bf_lo(vr_.y); gv[3] = bf_hi(vr_.y); } } } while (0)
#define SCAN_STORE(st, cc) do { LAS float* s_ = fl + (st) * STG; _Pragma("unroll") for (int q_ = 0; q_ < 2; ++q_) { const int o_ = ((lt >> 4) + 16 * q_) * 64 + lc; \
              f32x4 kr_ = gk[q_] * kkp; float ss_ = kr_[0] * kr_[0] + kr_[1] * kr_[1] + kr_[2] * kr_[2] + kr_[3] * kr_[3]; ss_ = rowsum16(ss_); \
              const float inv_ = rsqrtf(fmaxf(ss_, 1e-24f)); \
              f32x4 av_; av_[0] = bf_lo(ga[q_].x); av_[1] = bf_hi(ga[q_].x); av_[2] = bf_lo(ga[q_].y); av_[3] = bf_hi(ga[q_].y); \
              f32x4 rv_; rv_[0] = bf_lo(gr[q_].x); rv_[1] = bf_hi(gr[q_].x); rv_[2] = bf_lo(gr[q_].y); rv_[3] = bf_hi(gr[q_].y); \
              const f32x4 kk_ = kr_ * inv_; f32x4 kp_; \
              for (int e_ = 0; e_ < 4; ++e_) kp_[e_] = gk[q_][e_] * (1.0f + (av_[e_] - 1.0f) * kap[e_]); \
              *(LAS f32x4*)(s_ + o_) = rv_; *(LAS f32x4*)(s_ + 2048 + o_) = gd[q_]; *(LAS f32x4*)(s_ + 4096 + o_) = kp_; \
              *(LAS f32x4*)(s_ + 6144 + o_) = kk_; *(LAS f32x4*)(s_ + 8192 + o_) = kk_ * av_; \
              float sb_ = rv_[0] * kp_[0] * rkp[0] + rv_[1] * kp_[1] * rkp[1] + rv_[2] * kp_[2] * rkp[2] + rv_[3] * kp_[3] * rkp[3]; sb_ = rowsum16(sb_); \
              { const int tb_ = 32 * (cc) + (lt >> 4) + 16 * q_; if (rh == 0 && (lt & 15) == 0 && tb_ < L) SBON[(size_t)rowof(b, tb_) * 32 + h] = sb_; } } \
            *(LAS f32x4*)(s_ + 10240 + vt * 32 + vc) = gv; } while (0)
#define SCAN_FLUSH(cc) do { const LAS float* yb_ = ybuf + ((cc) & 1) * 1024; _Pragma("unroll") for (int q_ = 0; q_ < 2; ++q_) { const int ft_ = (lt >> 4) + 16 * q_, fv_ = (lt & 15) * 2; const int tt_ = 32 * (cc) + ft_; \
              if (tt_ < L) { const unsigned pk_ = cvt_pk_bf16(yb_[ft_ * 32 + fv_], yb_[ft_ * 32 + fv_ + 1]); *(unsigned*)(YB + (size_t)rowof(b, tt_) * D + 64 * h + 32 * rh + fv_) = pk_; } } } while (0)
        if (wu >= 4) {
            kkp = *(const f32x4*)(k_k + 64 * h + lc); kap = *(const f32x4*)(k_a + 64 * h + lc); rkp = *(const f32x4*)(r_k + 64 * h + lc);
            SCAN_LOAD(0); SCAN_STORE(0, 0);
            SCAN_LOAD(1);
        }
        __syncthreads();
        f32x2 SA01 = {0.f, 0.f}, SA23 = SA01, SB01 = SA01, SB23 = SA01;
        for (int c = 0; c < NCH; ++c) {
            if (wu < 4) {
                const LAS float* s = fl + (c & 1) * STG;
                LAS float* yb = ybuf + (c & 1) * 1024;
                const int ns = (L - 32 * c) < 32 ? (L - 32 * c) : 32;
                for (int tb = 0; tb < ns; tb += 16) {
                    float ykA = 0.f, ykB = 0.f;
#pragma unroll
                    for (int j = 0; j < 16; ++j) {
                        const int t = tb + j;
                        const int o = t * 64 + 4 * kg;
                        const f32x4 r4 = *(const LAS f32x4*)(s + o), d4 = *(const LAS f32x4*)(s + 2048 + o), kp4 = *(const LAS f32x4*)(s + 4096 + o);
                        const f32x4 kk4 = *(const LAS f32x4*)(s + 6144 + o), ka4 = *(const LAS f32x4*)(s + 8192 + o);
                        const f32x2 vv = *(const LAS f32x2*)(s + 10240 + t * 32 + 2 * rp);
                        const f32x2 kk01 = {kk4[0], kk4[1]}, kk23 = {kk4[2], kk4[3]}, ka01 = {ka4[0], ka4[1]}, ka23 = {ka4[2], ka4[3]};
                        const f32x2 kp01 = {kp4[0], kp4[1]}, kp23 = {kp4[2], kp4[3]}, d01 = {d4[0], d4[1]}, d23 = {d4[2], d4[3]}, r01 = {r4[0], r4[1]}, r23 = {r4[2], r4[3]};
                        f32x2 pA = SA01 * kk01; pA = SA23 * kk23 + pA;
                        f32x2 pB = SB01 * kk01; pB = SB23 * kk23 + pB;
                        const float saA = -rowsum16(pA.x + pA.y), saB = -rowsum16(pB.x + pB.y);
                        f32x2 tA01 = kp01 * vv.x, tA23 = kp23 * vv.x, tB01 = kp01 * vv.y, tB23 = kp23 * vv.y;
                        tA01 = ka01 * saA + tA01; tA23 = ka23 * saA + tA23; tB01 = ka01 * saB + tB01; tB23 = ka23 * saB + tB23;
                        SA01 = SA01 * d01 + tA01; SA23 = SA23 * d23 + tA23; SB01 = SB01 * d01 + tB01; SB23 = SB23 * d23 + tB23;
                        f32x2 qA = SA01 * r01; qA = SA23 * r23 + qA;
                        f32x2 qB = SB01 * r01; qB = SB23 * r23 + qB;
                        const float yA = rowsum16(qA.x + qA.y), yB = rowsum16(qB.x + qB.y);
                        ykA = (kg == j) ? yA : ykA; ykB = (kg == j) ? yB : ykB;
                    }
                    { f32x2 yy = {ykA, ykB}; *(LAS f32x2*)(yb + (tb + kg) * 32 + 2 * rp) = yy; }
                }
            } else {
                if (c + 1 < NCH) SCAN_STORE((c + 1) & 1, c + 1);
                if (c + 2 < NCH) SCAN_LOAD(c + 2);
                if (c >= 1) SCAN_FLUSH(c - 1);
            }
            __syncthreads();
        }
        if (wu >= 4) SCAN_FLUSH(NCH - 1);
#undef SCAN_LOAD
#undef SCAN_STORE
#undef SCAN_FLUSH
    }
}

__device__ void post_phase(const Params& P, int i) {
    const int tid_ = otid(); const int w = tid_ >> 6, lane = tid_ & 63;
    const bf16_t* VF = (const bf16_t*)(P.ws + (i == 0 ? OFF_VFIRST : OFF_VF)); const float* SBON = (const float*)(P.ws + OFF_LORA);
    const bf16_t* GB = (const bf16_t*)(P.ws + OFF_MIX + SZB); bf16_t* YB = (bf16_t*)(P.ws + OFF_MIX + 2 * SZB);
    const float* gn_w = P.in[23] + (size_t)i * D; const float* gn_b = P.in[24] + (size_t)i * D;
    for (int r = obid() * 8 + w; r < M; r += gridDim.x * 8) {
#pragma unroll
        for (int q = 0; q < 8; ++q) {
            const int col = 256 * q + 4 * lane; const size_t o = (size_t)r * D + col;
            const u32x2 yv = *(const u32x2*)(YB + o), gv = *(const u32x2*)(GB + o);
            const u32x2 vr_ = *(const u32x2*)(VF + o); f32x4 vv; vv[0] = bf_lo(vr_.x); vv[1] = bf_hi(vr_.x); vv[2] = bf_lo(vr_.y); vv[3] = bf_hi(vr_.y);
            const float sb = SBON[(size_t)r * 32 + 4 * q + (lane >> 4)];
            const f32x4 gw = *(const f32x4*)(gn_w + col), gb = *(const f32x4*)(gn_b + col);
            float y[4] = {bf_lo(yv.x), bf_hi(yv.x), bf_lo(yv.y), bf_hi(yv.y)};
            const float gg[4] = {bf_lo(gv.x), bf_hi(gv.x), bf_lo(gv.y), bf_hi(gv.y)};
            float sy = (y[0] + y[1]) + (y[2] + y[3]);
            sy = rowsum16(sy);
            const float mean = sy * (1.0f / 64.0f);
            float sv = 0.f;
#pragma unroll
            for (int e = 0; e < 4; ++e) { y[e] -= mean; sv += y[e] * y[e]; }
            sv = rowsum16(sv);
            const float rstd = rsqrtf(sv * (1.0f / 64.0f) + 64e-5f);
            float z[4];
#pragma unroll
            for (int e = 0; e < 4; ++e) z[e] = (y[e] * rstd * gw[e] + gb[e] + sb * vv[e]) * gg[e];
            u32x2 zo; zo.x = cvt_pk_bf16(z[0], z[1]); zo.y = cvt_pk_bf16(z[2], z[3]);
            *(u32x2*)(YB + o) = zo;
        }
    }
}

__device__ void headnorm_phase(const Params& P, LAS unsigned char* lds) {
    const int tid = otid(), w = tid >> 6, lane = tid & 63;
    const bf16_t* KR = (const bf16_t*)(P.ws + OFF_KF); const bf16_t* VR = (const bf16_t*)(P.ws + OFF_VF);
    bf16_t* KN = (bf16_t*)(P.ws + OFF_MIX + 2 * SZB); bf16_t* VT = (bf16_t*)(P.ws + OFF_DEC);
    const float* kg = P.in[31];
    for (int r = obid() * 8 + w; r < M; r += gridDim.x * 8) {
#pragma unroll
        for (int q = 0; q < 8; ++q) {
            const int col = 256 * q + 4 * lane; const size_t o = (size_t)r * D + col;
            const u32x2 kraw = *(const u32x2*)(KR + o); f32x4 kv; kv[0] = bf_lo(kraw.x); kv[1] = bf_hi(kraw.x); kv[2] = bf_lo(kraw.y); kv[3] = bf_hi(kraw.y);
            float ss = kv[0] * kv[0] + kv[1] * kv[1] + kv[2] * kv[2] + kv[3] * kv[3];
            ss = rowsum16(ss); ss += __shfl_xor(ss, 16);
            const float rs = rsqrtf(ss * (1.0f / 128.0f) + 1e-6f);
            const f32x4 gv = *(const f32x4*)(kg + (col & 127));
            u32x2 a; a.x = cvt_pk_bf16(kv[0] * rs * gv[0], kv[1] * rs * gv[1]); a.y = cvt_pk_bf16(kv[2] * rs * gv[2], kv[3] * rs * gv[3]);
            *(u32x2*)(KN + o) = a;
        }
    }
    LAS float* tile = (LAS float*)lds;
    for (int it = obid(); it < NBATCH * 66 * 16; it += gridDim.x) {
        const int h = it & 15, pt = (it >> 4) % 66, b = it / (16 * 66);
        __syncthreads();
#pragma unroll
        for (int pass = 0; pass < 4; ++pass) {
            const int key = (tid >> 5) + pass * 16, c4 = (tid & 31) * 4;
            const int t = 64 * pt + key - PPAD;
            f32x4 v = (f32x4){0.f, 0.f, 0.f, 0.f};
            if (t >= 0) { const u32x2 vraw = *(const u32x2*)(VR + (size_t)rowof(b, t) * D + 128 * h + c4); v[0] = bf_lo(vraw.x); v[1] = bf_hi(vraw.x); v[2] = bf_lo(vraw.y); v[3] = bf_hi(vraw.y); }
            tile[key * 129 + c4] = v[0]; tile[key * 129 + c4 + 1] = v[1]; tile[key * 129 + c4 + 2] = v[2]; tile[key * 129 + c4 + 3] = v[3];
        }
        __syncthreads();
        const int d = tid >> 2, k16 = (tid & 3) * 16;
        float e[16];
#pragma unroll
        for (int x = 0; x < 16; ++x) e[x] = tile[(k16 + x) * 129 + d];
        u32x4 o0, o1;
        o0.x = cvt_pk_bf16(e[0], e[1]); o0.y = cvt_pk_bf16(e[2], e[3]); o0.z = cvt_pk_bf16(e[4], e[5]); o0.w = cvt_pk_bf16(e[6], e[7]);
        o1.x = cvt_pk_bf16(e[8], e[9]); o1.y = cvt_pk_bf16(e[10], e[11]); o1.z = cvt_pk_bf16(e[12], e[13]); o1.w = cvt_pk_bf16(e[14], e[15]);
        bf16_t* dst = VT + ((size_t)((b * 16 + h) * 128 + d)) * PLEN + 64 * pt + k16;
        *(u32x4*)dst = o0; *(u32x4*)(dst + 8) = o1;
    }
}

__device__ void attn_phase(const Params& P, int j, LAS unsigned char* lds) {
    const int tid = otid(), w = tid >> 6, lane = tid & 63, fr = lane & 15, fq = lane >> 4;
    const bf16_t* QF = (const bf16_t*)(P.ws + OFF_RB);
    const bf16_t* KN = (const bf16_t*)(P.ws + OFF_MIX + 2 * SZB);
    const bf16_t* VT = (const bf16_t*)(P.ws + OFF_DEC);
    bf16_t* OB = (bf16_t*)(P.ws + OFF_MIX);
    const float* qg = P.in[33] + j * 128;
    constexpr int KSTR = 272, VSTR = 144, KBYTES = 64 * KSTR, VBYTES = 128 * VSTR, STGB = KBYTES + VBYTES;
#define ATT_LOADX(kt_, b_, h_, bh_, KR_, VR_) do { _Pragma("unroll") for (int i_ = 0; i_ < 2; ++i_) { const int id_ = tid + 512 * i_; \
            { const int row_ = id_ >> 4, c_ = id_ & 15; const int tk_ = 64 * (kt_) + row_ - PPAD; \
              KR_[i_] = *(const u32x4*)(KN + (size_t)rowof((b_), tk_ > 0 ? tk_ : 0) * D + 128 * (h_) + 8 * c_); } \
            { const int d_ = id_ >> 3, c_ = id_ & 7; VR_[i_] = *(const u32x4*)(VT + ((size_t)((bh_) * 128 + d_)) * PLEN + 64 * (kt_) + 8 * c_); } } } while (0)
#define ATT_PREFETCH(u_) do { const int qb_ = 32 - (u_) / 64, bh_ = (u_) % 64, b_ = bh_ >> 4, h_ = bh_ & 15; const int tq_ = 128 * qb_ + 16 * w + fr - PPAD; \
            const bf16_t* qp_ = QF + (size_t)rowof(b_, tq_ > 0 ? tq_ : 0) * D + 128 * h_ + 8 * fq; \
            _Pragma("unroll") for (int s_ = 0; s_ < 4; ++s_) nq[s_] = *(const u32x4*)(qp_ + 32 * s_); \
            ATT_LOADX(2 * qb_ + 1, b_, h_, bh_, nk, nv); } while (0)
    u32x4 nq[4], nk[2], nv[2];
    { const int u0 = obid(); if (u0 < 64 * 33) ATT_PREFETCH(u0); }
    for (int u = obid(); u < 64 * 33; u += gridDim.x) {
        const int qb = 32 - u / 64, bh = u % 64, b = bh >> 4, h = bh & 15;
        const int pq = 128 * qb + 16 * w + fr, tq = pq - PPAD;
        const int qrow = rowof(b, tq > 0 ? tq : 0);
        bf16x8 qf[4];
        u32x4 kr[2], vr[2];
        u32x4 cq[4];
#pragma unroll
        for (int s = 0; s < 4; ++s) cq[s] = nq[s];
        kr[0] = nk[0]; kr[1] = nk[1]; vr[0] = nv[0]; vr[1] = nv[1];
        { const int un = u + (int)gridDim.x; if (un < 64 * 33) ATT_PREFETCH(un); }
        {
            f32x4 qa[4], qc[4]; float ss = 0.f;
#pragma unroll
            for (int s = 0; s < 4; ++s) { const u32x4 qraw = cq[s];
                qa[s][0] = bf_lo(qraw.x); qa[s][1] = bf_hi(qraw.x); qa[s][2] = bf_lo(qraw.y); qa[s][3] = bf_hi(qraw.y); qc[s][0] = bf_lo(qraw.z); qc[s][1] = bf_hi(qraw.z); qc[s][2] = bf_lo(qraw.w); qc[s][3] = bf_hi(qraw.w);
                ss += qa[s][0] * qa[s][0] + qa[s][1] * qa[s][1] + qa[s][2] * qa[s][2] + qa[s][3] * qa[s][3] + qc[s][0] * qc[s][0] + qc[s][1] * qc[s][1] + qc[s][2] * qc[s][2] + qc[s][3] * qc[s][3]; }
            ss += __shfl_xor(ss, 16); ss += __shfl_xor(ss, 32);
            const float rs = rsqrtf(ss * (1.0f / 128.0f) + 1e-6f) * 0.08838834764831845f;
#pragma unroll
            for (int s = 0; s < 4; ++s) {
                const f32x4 g0 = *(const f32x4*)(qg + 32 * s + 8 * fq), g1 = *(const f32x4*)(qg + 32 * s + 8 * fq + 4);
                u32x4 pk; pk.x = cvt_pk_bf16(qa[s][0] * rs * g0[0], qa[s][1] * rs * g0[1]); pk.y = cvt_pk_bf16(qa[s][2] * rs * g0[2], qa[s][3] * rs * g0[3]);
                pk.z = cvt_pk_bf16(qc[s][0] * rs * g1[0], qc[s][1] * rs * g1[1]); pk.w = cvt_pk_bf16(qc[s][2] * rs * g1[2], qc[s][3] * rs * g1[3]);
                qf[s] = __builtin_bit_cast(bf16x8, pk);
            }
        }
        f32x4 oacc[8];
#pragma unroll
        for (int x = 0; x < 8; ++x) oacc[x] = (f32x4){0.f, 0.f, 0.f, 0.f};
        float carry = 1.0f;
#define ATT_LOAD(kt_) do { _Pragma("unroll") for (int i_ = 0; i_ < 2; ++i_) { const int id_ = tid + 512 * i_; \
            { const int row_ = id_ >> 4, c_ = id_ & 15; const int tk_ = 64 * (kt_) + row_ - PPAD; \
              kr[i_] = *(const u32x4*)(KN + (size_t)rowof(b, tk_ > 0 ? tk_ : 0) * D + 128 * h + 8 * c_); } \
            { const int d_ = id_ >> 3, c_ = id_ & 7; vr[i_] = *(const u32x4*)(VT + ((size_t)(bh * 128 + d_)) * PLEN + 64 * (kt_) + 8 * c_); } } } while (0)
#define ATT_WRITE(st_) do { _Pragma("unroll") for (int i_ = 0; i_ < 2; ++i_) { const int id_ = tid + 512 * i_; \
            *(LAS u32x4*)(lds + (st_) * STGB + (id_ >> 4) * KSTR + 16 * (id_ & 15)) = kr[i_]; \
            *(LAS u32x4*)(lds + (st_) * STGB + KBYTES + (id_ >> 3) * VSTR + 16 * (id_ & 7)) = vr[i_]; } } while (0)
        const int nti = 2 * qb + 1;
        __syncthreads();
        ATT_WRITE(0);
        __syncthreads();
        for (int it = 0; it < nti; ++it) {
            const int kt = nti - it;
            if (it + 1 < nti) ATT_LOAD(kt - 1);
            const LAS unsigned char* Ks = lds + (it & 1) * STGB; const LAS unsigned char* Vs = Ks + KBYTES;
            f32x4 st[4];
#pragma unroll
            for (int n = 0; n < 4; ++n) { st[n] = (f32x4){0.f, 0.f, 0.f, 0.f};
#pragma unroll
                for (int s = 0; s < 4; ++s) { const bf16x8 a = *(const LAS bf16x8*)(Ks + (16 * n + fr) * KSTR + 64 * s + 16 * fq);
                    st[n] = __builtin_amdgcn_mfma_f32_16x16x32_bf16(a, qf[s], st[n], 0, 0, 0); } }
            const bool need_mask = (kt >= 2 * qb) || (kt == 1);
            float kp[4][4], sg[4][4];
#pragma unroll
            for (int n = 0; n < 4; ++n)
#pragma unroll
                for (int e = 0; e < 4; ++e) { const float z = st[n][e]; const float ex = __expf(-fabsf(z)); const float r = __builtin_amdgcn_rcpf(1.0f + ex);
                    const bool pos = z >= 0.f; sg[n][e] = (pos ? 1.0f : ex) * r; kp[n][e] = (pos ? ex : 1.0f) * r; }
            if (need_mask) {
#pragma unroll
                for (int n = 0; n < 4; ++n)
#pragma unroll
                    for (int e = 0; e < 4; ++e) { const int pk = 64 * kt + 16 * n + 4 * fq + e; const bool valid = (pk < pq) && (pk >= PPAD);
                        if (!valid) { kp[n][e] = 1.0f; sg[n][e] = 0.f; } }
            }
            float X[4], Bt[4];
            {
                LAS f32x4* xch = (LAS f32x4*)(lds + 2 * STGB) + w * 64;
                f32x4 Tv;
#pragma unroll
                for (int n = 0; n < 4; ++n) Tv[n] = (kp[n][0] * kp[n][1]) * (kp[n][2] * kp[n][3]);
                xch[lane] = Tv;
                const f32x4 t0 = xch[fr], t1 = xch[fr + 16], t2 = xch[fr + 32], t3 = xch[fr + 48];
#pragma unroll
                for (int n = 0; n < 4; ++n) {
                    X[n] = (fq < 1 ? t1[n] : 1.0f) * (fq < 2 ? t2[n] : 1.0f) * (fq < 3 ? t3[n] : 1.0f);
                    Bt[n] = (t0[n] * t1[n]) * (t2[n] * t3[n]);
                }
            }
            float wgt[4][4]; float run = carry;
#pragma unroll
            for (int n = 3; n >= 0; --n) { const float s3 = run * X[n]; const float s2 = s3 * kp[n][3]; const float s1 = s2 * kp[n][2]; const float s0 = s1 * kp[n][1];
                wgt[n][3] = sg[n][3] * s3; wgt[n][2] = sg[n][2] * s2; wgt[n][1] = sg[n][1] * s1; wgt[n][0] = sg[n][0] * s0;
                run *= Bt[n]; }
            carry = run;
#pragma unroll
            for (int s2 = 0; s2 < 2; ++s2) {
                u32x4 pk; pk.x = cvt_pk_bf16(wgt[2 * s2][0], wgt[2 * s2][1]); pk.y = cvt_pk_bf16(wgt[2 * s2][2], wgt[2 * s2][3]);
                pk.z = cvt_pk_bf16(wgt[2 * s2 + 1][0], wgt[2 * s2 + 1][1]); pk.w = cvt_pk_bf16(wgt[2 * s2 + 1][2], wgt[2 * s2 + 1][3]);
                const bf16x8 pf = __builtin_bit_cast(bf16x8, pk);
#pragma unroll
                for (int db = 0; db < 8; ++db) {
                    const LAS unsigned char* vp = Vs + (16 * db + fr) * VSTR + 64 * s2 + 8 * fq;
                    const u32x2 v0 = *(const LAS u32x2*)vp, v1 = *(const LAS u32x2*)(vp + 32);
                    u32x4 vv; vv.x = v0.x; vv.y = v0.y; vv.z = v1.x; vv.w = v1.y;
                    oacc[db] = __builtin_amdgcn_mfma_f32_16x16x32_bf16(__builtin_bit_cast(bf16x8, vv), pf, oacc[db], 0, 0, 0);
                }
            }
            if (it + 1 < nti) ATT_WRITE((it + 1) & 1);
#ifndef NO_EARLY_EXIT
            LAS int* flg = (LAS int*)(lds + 2 * STGB + 8192) + (it & 1) * 8;
            { const int dead = __all(carry == 0.f); if (lane == 0) flg[w] = dead; }
            __syncthreads();
            { int alld = 1;
#pragma unroll
              for (int x = 0; x < 8; ++x) alld &= flg[x];
              if (alld) break; }
#else
            __syncthreads();
#endif
        }
#undef ATT_LOAD
#undef ATT_WRITE
        if (tq >= 0) {
#pragma unroll
            for (int db = 0; db < 8; ++db) { u32x2 o; o.x = cvt_pk_bf16(oacc[db][0], oacc[db][1]); o.y = cvt_pk_bf16(oacc[db][2], oacc[db][3]);
                *(u32x2*)(OB + (size_t)qrow * D + 128 * h + 16 * db + 4 * fq) = o; }
        }
    }
}

#define XB_TMO      128
#define XB_XCNT(j)  (256  + 64 * (j))
#define XB_XSUB(j)  (1280 + 64 * (j))
#define XB_XGEN(j)  (2304 + 64 * (j))
#define XB_TOP      3328
#define XB_TOPGEN   3392
#define XCD_BAR_WORDS 3456
#define XB_SPIN_CAP (1u << 18)

__device__ __forceinline__ unsigned xb_ld(unsigned* p)              { return __hip_atomic_load(p, __ATOMIC_RELAXED, __HIP_MEMORY_SCOPE_AGENT); }
__device__ __forceinline__ unsigned xb_add(unsigned* p, unsigned v) { return __hip_atomic_fetch_add(p, v, __ATOMIC_RELAXED, __HIP_MEMORY_SCOPE_AGENT); }
__device__ __forceinline__ unsigned xb_xcc_id() { return (unsigned)__builtin_amdgcn_s_getreg((3 << 11) | 20) & 0xFu; }
#define XB_SPIN(cond, bar) do { unsigned _sp = 0; while (cond) { __builtin_amdgcn_s_sleep(1); \
    if ((++_sp & 255u) == 0u) { if (xb_ld(&(bar)[XB_TMO])) break; if (_sp > XB_SPIN_CAP) { atomicAdd(&(bar)[XB_TMO], 1u); break; } } } } while (0)

struct XcdBarrier {
    unsigned* bar; unsigned x;
    volatile LAS unsigned* st;
};

__device__ __forceinline__ XcdBarrier xcd_barrier_post(unsigned* bar, volatile LAS unsigned* st) {
    XcdBarrier b; b.bar = bar; b.x = xb_xcc_id(); b.st = st;
    if (threadIdx.x == 0) (void)xb_add(&bar[XB_XCNT(b.x)], 1u);
    return b;
}
__device__ __forceinline__ void xcd_barrier_complete(unsigned* bar, unsigned x, unsigned& nloc, unsigned& nx) {
    const unsigned G = gridDim.x * gridDim.y * gridDim.z;
    unsigned sum, cnt, mine, sp = 0u;
    for (;;) {
        sum = 0u; cnt = 0u; mine = 0u;
#pragma unroll
        for (unsigned j = 0; j < 16; ++j) { const unsigned c = xb_ld(&bar[XB_XCNT(j)]); sum += c; cnt += (c > 0u) ? 1u : 0u; mine = (j == x) ? c : mine; }
        if (sum == G) break;
        __builtin_amdgcn_s_sleep(1);
        if ((++sp & 255u) == 0u) { if (xb_ld(&bar[XB_TMO])) break; if (sp > XB_SPIN_CAP) { atomicAdd(&bar[XB_TMO], 1u); break; } }
    }
    nloc = mine > 0u ? mine : 1u; nx = cnt > 0u ? cnt : 1u;
}

__device__ __forceinline__ void xcd_barrier(const XcdBarrier& b) {
    asm volatile("s_waitcnt vmcnt(0)" ::: "memory");
    __syncthreads();
    if (threadIdx.x == 0) {
        unsigned* bar = b.bar;
        __builtin_amdgcn_s_waitcnt(0);
        unsigned nloc = b.st[0], nx = b.st[1];
        if (nloc == 0u) { xcd_barrier_complete(bar, b.x, nloc, nx); b.st[0] = nloc; b.st[1] = nx; }
        const unsigned old = xb_add(&bar[XB_XSUB(b.x)], 1u);
        const unsigned gen = old / nloc;
        if (old + 1u == (gen + 1u) * nloc) {
            __builtin_amdgcn_fence(__ATOMIC_RELEASE, "agent");
            asm volatile("s_waitcnt vmcnt(0)" ::: "memory");
            const unsigned og = xb_add(&bar[XB_TOP], 1u);
            const unsigned tg = og / nx;
            if (og + 1u == (tg + 1u) * nx) xb_add(&bar[XB_TOPGEN], 1u);
            else XB_SPIN(xb_ld(&bar[XB_TOPGEN]) == tg, bar);
            __builtin_amdgcn_fence(__ATOMIC_ACQUIRE, "agent");
            xb_add(&bar[XB_XGEN(b.x)], 1u);
            asm volatile("s_waitcnt vmcnt(0)" ::: "memory");
        } else {
            XB_SPIN(xb_ld(&bar[XB_XGEN(b.x)]) == gen, bar);
            __builtin_amdgcn_fence(__ATOMIC_ACQUIRE, "agent");
            asm volatile("s_waitcnt vmcnt(0)" ::: "memory");
        }
    }
    __syncthreads();
}


__device__ __forceinline__ void grid_barrier(unsigned* ctr, unsigned target) {
    asm volatile("s_waitcnt vmcnt(0) lgkmcnt(0)" ::: "memory");
    __syncthreads();
    if (threadIdx.x == 0) {
        __builtin_amdgcn_fence(__ATOMIC_RELEASE, "agent");
        asm volatile("s_waitcnt vmcnt(0)" ::: "memory");
        __hip_atomic_fetch_add(ctr, 1u, __ATOMIC_RELAXED, __HIP_MEMORY_SCOPE_AGENT);
        while (__hip_atomic_load(ctr, __ATOMIC_RELAXED, __HIP_MEMORY_SCOPE_AGENT) < target) __builtin_amdgcn_s_sleep(2);
        __builtin_amdgcn_fence(__ATOMIC_ACQUIRE, "agent");
        asm volatile("s_waitcnt vmcnt(0)" ::: "memory");
    }
    __syncthreads();
}

#ifndef DUP_ATTN
#define DUP_ATTN 0
#endif
#ifndef DUP_FFN1
#define DUP_FFN1 0
#endif
#ifndef DUP_SCAN
#define DUP_SCAN 0
#endif
constexpr int NPHASE = 35 + 2 * DUP_ATTN + 4 * DUP_FFN1 + 2 * DUP_SCAN;
enum { K_INIT = 0, K_MIXPREP, K_GEMM, K_SCAN, K_POST, K_NORMF, K_NORMSB, K_HEADNORM, K_ATTN };
struct Tab { PE e[NPHASE]; };
constexpr GD mkgd(size_t A, size_t Bt, int N, int mode, size_t o0, size_t o1, int bin, int boff, int ldo) {
    GD g{}; g.A = A; g.Bt = Bt; g.o0 = o0; g.o1 = o1; g.N = N; g.mode = mode; g.bin = bin; g.boff = boff; g.ldo = ldo; g.pad = 0; return g;
}
constexpr PE mkgemm(int layer, int sub) {
    PE p{}; p.kind = K_GEMM; p.layer = layer; p.sub = sub; p.ng = 1; p.K = D; p.pad = 0;
    const int i = layer;
    for (int q = 0; q < 4; ++q) p.g[q] = mkgd(0, 0, 256, 0, 0, 0, 0, 0, D);
    if (sub == 0) {
        p.g[0] = mkgd(OFF_MIX, OFF_WA + WA_W0, D, 0, OFF_RB, 0, 0, 0, D);
        p.g[1] = mkgd(OFF_MIX + SZB, OFF_WA + WA_W1, D, 0, OFF_KF, 0, 0, 0, D);
        p.g[2] = mkgd(OFF_MIX + 2 * SZB, OFF_WA + WA_W2, D, 0, i == 0 ? OFF_VFIRST : OFF_VF, 0, 0, 0, D);
        p.ng = 3;
    } else if (sub == 1) {
        p.g[0] = mkgd(OFF_DEC, OFF_WA + WA_L1 + 0 * WSLOT, 256, 3, OFF_LORA + 0 * SZLORA, 0, 0, 0, 256);
        p.g[1] = mkgd(OFF_DEC + SZB, OFF_WA + WA_L1 + 1 * WSLOT, 256, 0, OFF_LORA + 1 * SZLORA, 0, 0, 0, 256);
        p.g[2] = mkgd(OFF_KF, OFF_WA + WA_L1 + 2 * WSLOT, 256, 4, OFF_LORA + 2 * SZLORA, 0, 0, 0, 256);
        p.ng = 3;
        if (i >= 1) { p.g[3] = mkgd(OFF_MIX + 2 * SZB, OFF_WA + WA_L1 + 3 * WSLOT, 256, 0, OFF_LORA + 3 * SZLORA, 0, 0, 0, 256); p.ng = 4; }
    } else if (sub == 2) {
        p.K = 256;
        p.g[0] = mkgd(OFF_LORA + 0 * SZLORA, OFF_WA + WA_L2 + 0 * WSLOT, D, 5, OFF_DEC, 0, 12, i * D, D);
        p.g[1] = mkgd(OFF_LORA + 1 * SZLORA, OFF_WA + WA_L2 + 1 * WSLOT, D, 6, OFF_MIX, 0, 15, i * D, D);
        p.g[2] = mkgd(OFF_LORA + 2 * SZLORA, OFF_WA + WA_L2 + 2 * WSLOT, D, 0, OFF_MIX + SZB, 0, 0, 0, D);
        p.ng = 3;
        if (i >= 1) { p.g[3] = mkgd(OFF_LORA + 3 * SZLORA, OFF_WA + WA_L2 + 3 * WSLOT, D, 7, OFF_VF, OFF_VFIRST, 25, (i - 1) * D, D); p.ng = 4; }
    } else if (sub == 3) {
        p.g[0] = mkgd(OFF_MIX + 2 * SZB, OFF_WB + WB_WO, D, 8, 0, 0, 0, 0, D);
    } else if (sub == 4) {
        p.g[0] = mkgd(OFF_HN2, OFF_WB + WB_F1, 2 * FF, 9, OFF_ACT, 0, 0, 0, FF);
    } else if (sub == 5) {
        p.K = FF;
        p.g[0] = mkgd(OFF_ACT, OFF_WB + WB_F2, D, 8, 0, 0, 0, 0, D);
    } else if (sub == 6) {
        p.g[0] = mkgd(OFF_MIX, OFF_WA + WA_W0, D, 0, OFF_RB, 0, 0, 0, D);
        if (layer == 2) {
            p.g[1] = mkgd(OFF_MIX + SZB, OFF_WA + WA_W1, D, 0, OFF_KF, 0, 0, 0, D);
            p.g[2] = mkgd(OFF_MIX + SZB, OFF_WA + WA_W2, D, 0, OFF_VF, 0, 0, 0, D);
            p.ng = 3;
        }
    } else {
        p.g[0] = mkgd(OFF_MIX, OFF_WB + WB_WO, D, 8, 0, 0, 0, 0, D);
    }
    return p;
}
constexpr PE mkother(int kind, int layer, int sub) { PE p{}; p.kind = kind; p.layer = layer; p.sub = sub; p.ng = 0; p.K = D; p.pad = 0; for (int q = 0; q < 4; ++q) p.g[q] = mkgd(0, 0, 256, 0, 0, 0, 0, 0, D); return p; }
constexpr Tab make_tab() {
    Tab t{};
    int n = 0;
    for (int i = 0; i < 2; ++i) {
        t.e[n++] = mkother(K_MIXPREP, i, 0);
        t.e[n++] = mkgemm(i, 1);
        t.e[n++] = mkgemm(i, 0);
        t.e[n++] = mkgemm(i, 2);
        t.e[n++] = mkother(K_SCAN, i, 0);
        if (DUP_SCAN) t.e[n++] = mkother(K_SCAN, i, 0);
        t.e[n++] = mkother(K_POST, i, 0);
        t.e[n++] = mkgemm(i, 3);
        t.e[n++] = mkother(K_NORMF, i, 0);
        t.e[n++] = mkgemm(i, 4);
        if (DUP_FFN1) t.e[n++] = mkgemm(i, 4);
        t.e[n++] = mkgemm(i, 5);
    }
    for (int j = 0; j < 2; ++j) {
        const int layer = 2 + j;
        t.e[n++] = mkother(K_NORMSB, layer, 0);
        t.e[n++] = mkgemm(layer, 6);
        if (j == 0) t.e[n++] = mkother(K_HEADNORM, layer, 0);
        t.e[n++] = mkother(K_ATTN, layer, 0);
        if (DUP_ATTN) t.e[n++] = mkother(K_ATTN, layer, 0);
        t.e[n++] = mkgemm(layer, 7);
        t.e[n++] = mkother(K_NORMF, layer, 0);
        t.e[n++] = mkgemm(layer, 4);
        if (DUP_FFN1) t.e[n++] = mkgemm(layer, 4);
        t.e[n++] = mkgemm(layer, 5);
    }
    return t;
}
__constant__ const Tab TAB = make_tab();

#ifndef ONLY
#define ONLY -1
#endif
#define EN(k) (ONLY < 0 || ONLY == (k))

__global__ void __launch_bounds__(512, 2) mk_forward(Params P, int ph_lo, int ph_hi) {
    extern __shared__ __attribute__((aligned(16))) unsigned char shm[];
    LAS unsigned char* lds = (LAS unsigned char*)shm;
    cg::grid_group grid = cg::this_grid();
    __shared__ uint4 xb_words;
    if (threadIdx.x == 0) xb_words = make_uint4(0u, 0u, 0u, 0u);
    unsigned* const xbar = (unsigned*)(P.ws + WS_END);
    XcdBarrier xb; xb.bar = xbar; xb.x = 0; xb.st = (volatile LAS unsigned*)&xb_words;
    for (int ph = ph_lo; ph < ph_hi; ++ph) {
        const PE* pe = &TAB.e[ph];
        const int kind = pe->kind, layer = pe->layer, sub = pe->sub;
        if (kind == K_GEMM) { if (EN(K_GEMM)) {
            const bool tail_first = (blockIdx.x & 1) != 0;
            if (tail_first) { tail_gemm(lds, pe, P); __syncthreads(); }
            gemm_phase(lds, pe, P);
            if (!tail_first) tail_gemm(lds, pe, P); } }
        else if (!EN(kind)) {}
        else if (kind == K_MIXPREP) { mixprep_phase(P, layer); convert_layer(P, layer, lds); }
        else if (kind == K_SCAN) scan_phase(P, layer, lds);
        else if (kind == K_POST) post_phase(P, layer);
        else if (kind == K_NORMF) norm_phase(P, P.in[3] + (size_t)layer * D, (bf16_t*)(P.ws + OFF_HN2), nullptr, nullptr);
        else if (kind == K_NORMSB) {
            norm_phase(P, P.in[2] + (size_t)layer * D, (bf16_t*)(P.ws + OFF_MIX), layer == 2 ? P.in[28] : nullptr, (bf16_t*)(P.ws + OFF_MIX + SZB));
            convert_layer(P, layer, lds);
        }
        else if (kind == K_HEADNORM) { if (layer == 2) headnorm_phase(P, lds); }
        else if (kind == K_ATTN) attn_phase(P, layer - 2, lds);
        if (ph + 1 < ph_hi) {
#ifdef USE_CG_SYNC
            grid.sync();
#else
            if (ph == ph_lo) {
                if (blockIdx.x == 0) for (int q = threadIdx.x; q < XCD_BAR_WORDS; q += NTHR) __hip_atomic_store(xbar + q, 0u, __ATOMIC_RELAXED, __HIP_MEMORY_SCOPE_AGENT);
                grid.sync();
                xb = xcd_barrier_post(xbar, (volatile LAS unsigned*)&xb_words);
            }
            else xcd_barrier(xb);
#endif
        }
    }
}

__global__ void dbg_copy(Params P, size_t off_bf16a, size_t off_bf16b, size_t off_f32) {
    const size_t n = (size_t)MMAIN * D;
    for (size_t i = (size_t)blockIdx.x * blockDim.x + threadIdx.x; i < n; i += (size_t)gridDim.x * blockDim.x) {
        float v = 0.f;
        if (off_bf16a) v += __uint_as_float(((unsigned)((const bf16_t*)(P.ws + off_bf16a))[i]) << 16);
        if (off_bf16b) v += __uint_as_float(((unsigned)((const bf16_t*)(P.ws + off_bf16b))[i]) << 16);
        if (off_f32) v += ((const float*)(P.ws + off_f32))[i];
        P.out[i] = v;
    }
}
extern "C" void kernel_launch(void* const* d_in, const int* in_sizes, int n_in, void* d_out, int out_size, void* d_ws, size_t ws_size, hipStream_t stream) {
    constexpr size_t kDynLds = 131072;
    static int grid_blocks = 0;
    if (!grid_blocks) {
        hipFuncSetAttribute((const void*)mk_forward, hipFuncAttributeMaxDynamicSharedMemorySize, (int)kDynLds);
        int dev = 0, cus = 0, per_cu = 0;
        hipGetDevice(&dev);
        hipDeviceGetAttribute(&cus, hipDeviceAttributeMultiprocessorCount, dev);
        hipOccupancyMaxActiveBlocksPerMultiprocessor(&per_cu, mk_forward, NTHR, kDynLds);
        if (per_cu < 1) per_cu = 1;
        grid_blocks = cus * per_cu;
        if (ws_size < WS_END) fprintf(stderr, "workspace too small: %zu < %zu\n", ws_size, (size_t)WS_END);
    }
    Params p{};
    for (int i = 0; i < 35; ++i) p.in[i] = (const float*)d_in[i];
    p.out = (float*)d_out; p.ws = (unsigned char*)d_ws;
#ifdef MULTI_LAUNCH
    for (int ph = 0; ph < NPHASE; ++ph) hipLaunchKernelGGL(mk_forward, dim3(grid_blocks), dim3(NTHR), kDynLds, stream, p, ph, ph + 1);
#ifdef DBG_A
    hipLaunchKernelGGL(dbg_copy, dim3(2048), dim3(256), 0, stream, p, (size_t)DBG_A, (size_t)DBG_B, (size_t)DBG_F);
#endif
#else
    int lo = 0, hi = NPHASE;
    void* args[] = {&p, &lo, &hi};
    hipError_t e = hipLaunchCooperativeKernel((void*)mk_forward, dim3(grid_blocks), dim3(NTHR), args, kDynLds, stream);
    if (e != hipSuccess) fprintf(stderr, "cooperative launch failed: %s (grid %d)\n", hipGetErrorString(e), grid_blocks);
#endif
}
```

```cpp
#include <hip/hip_runtime.h>
#include <hip/hip_cooperative_groups.h>
#include <cstdio>
namespace cg = cooperative_groups;

#define LAS __attribute__((address_space(3)))
typedef unsigned short bf16_t;
typedef short bf16x8 __attribute__((ext_vector_type(8)));
typedef float f32x4 __attribute__((ext_vector_type(4)));
typedef unsigned u32x2 __attribute__((ext_vector_type(2)));
typedef unsigned u32x4 __attribute__((ext_vector_type(4)));

constexpr int D = 2048, FF = 5632, NBATCH = 4, SEQ = 4096, NMETA = 16, L = SEQ + NMETA;
constexpr int M = NBATCH * L;
constexpr int MMAIN = NBATCH * SEQ;
constexpr int MP = 16640;
constexpr int NTHR = 512;
constexpr int PPAD = 112, PLEN = 4224;

constexpr size_t SZB = (size_t)MP * D * 2, SZF = 2 * SZB;
constexpr size_t OFF_WA = 0;
constexpr size_t OFF_WB = 37748736;
constexpr size_t OFF_HT = OFF_WB + 83886080;
constexpr size_t OFF_RB = OFF_HT + 1048576;
constexpr size_t OFF_VFIRST = OFF_RB + SZB;
constexpr size_t OFF_KF = OFF_VFIRST + SZB;
constexpr size_t OFF_VF = OFF_KF + SZF;
constexpr size_t OFF_DEC = OFF_VF + SZF;
constexpr size_t OFF_MIX = OFF_DEC + SZF;
constexpr size_t OFF_LORA = OFF_MIX + 3 * SZB;
constexpr size_t SZLORA = (size_t)MP * 256 * 2;
constexpr size_t WS_END = OFF_LORA + 4 * SZLORA;
constexpr size_t OFF_HN2 = OFF_KF, OFF_ACT = OFF_KF + SZB;
constexpr size_t WA_W0 = 0, WA_W1 = 8388608, WA_W2 = 16777216, WA_L1 = 25165824, WA_L2 = 29360128, WSLOT = 1048576;
constexpr size_t WB_WO = 0, WB_F1 = 8388608, WB_F2 = WB_F1 + (size_t)2 * FF * D * 2;

struct Params {
    const float* in[35];
    float* out;
    unsigned char* ws;
};

__device__ __forceinline__ int rowof(int b, int t) { return t < NMETA ? MMAIN + b * NMETA + t : b * SEQ + (t - NMETA); }
__device__ __forceinline__ float* hrow(const Params& P, int r) {
    return r < MMAIN ? P.out + (size_t)r * D : (float*)(P.ws + OFF_HT) + (size_t)(r - MMAIN) * D;
}
__device__ __forceinline__ unsigned cvt_pk_bf16(float lo, float hi) { unsigned r; asm volatile("v_cvt_pk_bf16_f32 %0, %1, %2" : "=v"(r) : "v"(lo), "v"(hi)); return r; }
__device__ __forceinline__ float bf_lo(unsigned x) { return __uint_as_float(x << 16); }
__device__ __forceinline__ float bf_hi(unsigned x) { return __uint_as_float(x & 0xffff0000u); }
template <int CTRL> __device__ __forceinline__ float dpp_mov(float x) {
    return __int_as_float(__builtin_amdgcn_update_dpp(0, __float_as_int(x), CTRL, 0xF, 0xF, true));
}
__device__ __forceinline__ float rowsum16(float x) {
    x += dpp_mov<0x128>(x); x += dpp_mov<0x124>(x); x += dpp_mov<0x122>(x); x += dpp_mov<0x121>(x); return x;
}
__device__ __forceinline__ float wavesum(float x) { x = rowsum16(x); x += __shfl_xor(x, 16); x += __shfl_xor(x, 32); return x; }
__device__ __forceinline__ int otid() { int t = threadIdx.x; asm volatile("" : "+v"(t)); return t; }
__device__ __forceinline__ int obid() { int t = blockIdx.x; asm volatile("" : "+s"(t)); return t; }
__device__ __forceinline__ float sigmoidf_(float x) { return 1.0f / (1.0f + __expf(-x)); }

constexpr int BM = 256, BK = 64, HALF = 128, HTB = HALF * BK * 2, NXCD = 8, WGM = 8, NMT = MMAIN / BM;
__device__ __forceinline__ int lds_byte(int r, int c) { const int st = (r >> 4) * 2 + (c >> 5), rr = r & 15, cc = c & 31, ob = rr * 64 + cc * 2; return st * 1024 + (ob ^ (((ob >> 9) & 1) << 5)); }
__device__ __forceinline__ void stage_rc(int b, int& R, int& C) { const int st = b / 1024, sb = b % 1024, swz = sb ^ (((sb >> 9) & 1) << 5); R = (st >> 1) * 16 + swz / 64; C = (st & 1) * 32 + (swz % 64) / 2; }

struct GD { unsigned long long A, Bt, o0, o1; int N, mode, bin, boff, ldo, pad; };
struct PE { int kind, layer, sub, ng, K, pad; GD g[4]; };
struct Unit { int pm, pn, gi; };

__device__ __forceinline__ bool sched_next(const int Lx, const int c1, const int c2, const int c3, const int c4, Unit& u) {
    if (Lx >= c4) return false;
    int gi = 0, base = 0, top = c1;
    if (Lx >= c1) { gi = 1; base = c1; top = c2; }
    if (Lx >= c2) { gi = 2; base = c2; top = c3; }
    if (Lx >= c3) { gi = 3; base = c3; top = c4; }
    const int nM = NMT, nwg = top - base, nN = nwg / NMT;
    int wgid = Lx - base; { const int q = nwg / NXCD, r = nwg % NXCD, xcd = wgid % NXCD, off = wgid / NXCD; wgid = (xcd < r ? xcd * (q + 1) : r * (q + 1) + (xcd - r) * q) + off; }
    const int nig = WGM * nN, gid = wgid / nig, fm = gid * WGM, gsz = (nM - fm) < WGM ? (nM - fm) : WGM;
    u.pm = fm + ((wgid % nig) % gsz); u.pn = (wgid % nig) / gsz; u.gi = gi; return true;
}

template <int MODE>
__device__ __forceinline__ void epi_elem(const int r, const int c, f32x4 v, void* g_o0, void* g_o1, const f32x4 bv, const int ldo, float* outp, float* htp) {
    if constexpr (MODE == 8) {
        float* p = (r < MMAIN ? outp + (size_t)r * D : htp + (size_t)(r - MMAIN) * D) + c; f32x4 hv = *(f32x4*)p; *(f32x4*)p = hv + v;
    } else if constexpr (MODE == 1) {
        *(f32x4*)((float*)g_o0 + (size_t)r * ldo + c) = v;
    } else if constexpr (MODE == 2) {
        *(f32x4*)((float*)g_o0 + (size_t)r * ldo + c) = v;
        u32x2 wv; wv.x = cvt_pk_bf16(v[0], v[1]); wv.y = cvt_pk_bf16(v[2], v[3]);
        *(u32x2*)((bf16_t*)g_o1 + (size_t)r * ldo + c) = wv;
    } else if constexpr (MODE == 5) {
        f32x4 o;
#pragma unroll
        for (int e = 0; e < 4; ++e) { const float x = -(bv[e] + v[e]); const float sp = fmaxf(x, 0.f) + __logf(1.0f + __expf(-fabsf(x))); const float wl = -sp - 0.5f; o[e] = __expf(-__expf(wl)); }
        *(f32x4*)((float*)g_o0 + (size_t)r * ldo + c) = o;
    } else if constexpr (MODE == 7) {
        bf16_t* vp = (bf16_t*)g_o0 + (size_t)r * ldo + c; const u32x2 vr_ = *(const u32x2*)vp; f32x4 vv; vv[0] = bf_lo(vr_.x); vv[1] = bf_hi(vr_.x); vv[2] = bf_lo(vr_.y); vv[3] = bf_hi(vr_.y);
        const u32x2 vf = *(const u32x2*)((const bf16_t*)g_o1 + (size_t)r * ldo + c);
        const float f0 = bf_lo(vf.x), f1 = bf_hi(vf.x), f2 = bf_lo(vf.y), f3 = bf_hi(vf.y);
        f32x4 o;
        o[0] = vv[0] + (f0 - vv[0]) * sigmoidf_(bv[0] + v[0]); o[1] = vv[1] + (f1 - vv[1]) * sigmoidf_(bv[1] + v[1]);
        o[2] = vv[2] + (f2 - vv[2]) * sigmoidf_(bv[2] + v[2]); o[3] = vv[3] + (f3 - vv[3]) * sigmoidf_(bv[3] + v[3]);
        u32x2 ow; ow.x = cvt_pk_bf16(o[0], o[1]); ow.y = cvt_pk_bf16(o[2], o[3]); *(u32x2*)vp = ow;
    } else {
        if constexpr (MODE == 3) {
#pragma unroll
            for (int e = 0; e < 4; ++e) { const float ax = fminf(fabsf(v[e]), 15.0f); const float t = 1.0f - 2.0f / (__expf(2.0f * ax) + 1.0f); v[e] = v[e] < 0.f ? -t : t; } }
        else if constexpr (MODE == 4) { v[0] = sigmoidf_(v[0]); v[1] = sigmoidf_(v[1]); v[2] = sigmoidf_(v[2]); v[3] = sigmoidf_(v[3]); }
        else if constexpr (MODE == 6) { v[0] = sigmoidf_(bv[0] + v[0]); v[1] = sigmoidf_(bv[1] + v[1]); v[2] = sigmoidf_(bv[2] + v[2]); v[3] = sigmoidf_(bv[3] + v[3]); }
        u32x2 wv; wv.x = cvt_pk_bf16(v[0], v[1]); wv.y = cvt_pk_bf16(v[2], v[3]);
        *(u32x2*)((bf16_t*)g_o0 + (size_t)r * ldo + c) = wv;
    }
}
__device__ __forceinline__ void epi_swiglu(const int r, const int oc, const f32x4 g, const f32x4 up, void* g_o0, const int ldo) {
    float o[4];
#pragma unroll
    for (int e = 0; e < 4; ++e) o[e] = g[e] * __builtin_amdgcn_rcpf(1.0f + __expf(-g[e])) * up[e];
    u32x2 wv; wv.x = cvt_pk_bf16(o[0], o[1]); wv.y = cvt_pk_bf16(o[2], o[3]);
    *(u32x2*)((bf16_t*)g_o0 + (size_t)r * ldo + oc) = wv;
}
template <int MODE>
__device__ __forceinline__ void epi_t(const f32x4 (&acc)[2][2][4][2], void* g_o0, void* g_o1, const float* g_bias, const int ldo, const int u_pm, const int u_pn, int wr, int wc, int fr, int fq, float* outp, float* htp) {
    const int row0 = u_pm * BM + wr * 64 + fr, col0 = u_pn * BM + wc * 32 + 4 * fq;
    f32x4 bvv[2][2];
#pragma unroll
    for (int bj = 0; bj < 2; ++bj)
#pragma unroll
        for (int n = 0; n < 2; ++n) bvv[bj][n] = (MODE == 5 || MODE == 6 || MODE == 7) ? *(const f32x4*)(g_bias + col0 + bj * HALF + n * 16) : (f32x4){0.f, 0.f, 0.f, 0.f};
    if constexpr (MODE == 7) {
#pragma unroll
        for (int ai = 0; ai < 2; ++ai) {
#pragma unroll
            for (int mh = 0; mh < 2; ++mh) {
                f32x4 vv[2][2][2]; u32x2 vf[2][2][2];
#pragma unroll
                for (int ml = 0; ml < 2; ++ml) { const size_t o = (size_t)(row0 + ai * HALF + (2 * mh + ml) * 16) * ldo + col0;
#pragma unroll
                    for (int bj = 0; bj < 2; ++bj)
#pragma unroll
                        for (int n = 0; n < 2; ++n) { const u32x2 vr_ = *(const u32x2*)((const bf16_t*)g_o0 + o + bj * HALF + n * 16);
                            vv[ml][bj][n][0] = bf_lo(vr_.x); vv[ml][bj][n][1] = bf_hi(vr_.x); vv[ml][bj][n][2] = bf_lo(vr_.y); vv[ml][bj][n][3] = bf_hi(vr_.y);
                            vf[ml][bj][n] = *(const u32x2*)((const bf16_t*)g_o1 + o + bj * HALF + n * 16); } }
#pragma unroll
                for (int ml = 0; ml < 2; ++ml) { const size_t o = (size_t)(row0 + ai * HALF + (2 * mh + ml) * 16) * ldo + col0;
#pragma unroll
                    for (int bj = 0; bj < 2; ++bj)
#pragma unroll
                        for (int n = 0; n < 2; ++n) { const f32x4 a = acc[ai][bj][2 * mh + ml][n], x = vv[ml][bj][n], bb = bvv[bj][n]; const u32x2 f = vf[ml][bj][n];
                            f32x4 ov;
                            ov[0] = x[0] + (bf_lo(f.x) - x[0]) * sigmoidf_(bb[0] + a[0]); ov[1] = x[1] + (bf_hi(f.x) - x[1]) * sigmoidf_(bb[1] + a[1]);
                            ov[2] = x[2] + (bf_lo(f.y) - x[2]) * sigmoidf_(bb[2] + a[2]); ov[3] = x[3] + (bf_hi(f.y) - x[3]) * sigmoidf_(bb[3] + a[3]);
                            u32x2 ow; ow.x = cvt_pk_bf16(ov[0], ov[1]); ow.y = cvt_pk_bf16(ov[2], ov[3]);
                            *(u32x2*)((bf16_t*)g_o0 + o + bj * HALF + n * 16) = ow; } }
            }
        }
        return;
    }
    if constexpr (MODE == 8) {
#pragma unroll
        for (int ai = 0; ai < 2; ++ai) {
            f32x4 hv[4][2][2];
#pragma unroll
            for (int m = 0; m < 4; ++m) { const int r = row0 + ai * HALF + m * 16; float* p = (r < MMAIN ? outp + (size_t)r * D : htp + (size_t)(r - MMAIN) * D) + col0;
#pragma unroll
                for (int bj = 0; bj < 2; ++bj)
#pragma unroll
                    for (int n = 0; n < 2; ++n) hv[m][bj][n] = *(const f32x4*)(p + bj * HALF + n * 16); }
#pragma unroll
            for (int m = 0; m < 4; ++m) { const int r = row0 + ai * HALF + m * 16; float* p = (r < MMAIN ? outp + (size_t)r * D : htp + (size_t)(r - MMAIN) * D) + col0;
#pragma unroll
                for (int bj = 0; bj < 2; ++bj)
#pragma unroll
                    for (int n = 0; n < 2; ++n) *(f32x4*)(p + bj * HALF + n * 16) = hv[m][bj][n] + acc[ai][bj][m][n]; }
        }
        return;
    }
#pragma unroll
    for (int ai = 0; ai < 2; ++ai) {
#pragma unroll
        for (int m = 0; m < 4; ++m) {
            const int r = row0 + ai * HALF + m * 16;
            if constexpr (MODE == 9) {
#pragma unroll
                for (int bj = 0; bj < 2; ++bj)
                    epi_swiglu(r, 16 * (u_pn * 8 + bj * 4 + wc) + 4 * fq, acc[ai][bj][m][0], acc[ai][bj][m][1], g_o0, ldo);
            } else if constexpr (MODE == 8 || MODE == 7) {
            } else {
#pragma unroll
                for (int bj = 0; bj < 2; ++bj) {
#pragma unroll
                    for (int n = 0; n < 2; ++n)
                        epi_elem<MODE>(r, col0 + bj * HALF + n * 16, acc[ai][bj][m][n], g_o0, g_o1, bvv[bj][n], ldo, outp, htp);
                }
            }
        }
    }
}
#define EPI_CALL(MD) epi_t<MD>(acc, g_o0, g_o1, g_bias, ldo, u_pm, u_pn, wr, wc, fr, fq, outp, htp)
__device__ __forceinline__ void epilogue(const f32x4 (&acc)[2][2][4][2], const int mode, void* g_o0, void* g_o1, const float* g_bias, const int ldo, const int u_pm, const int u_pn, int wr, int wc, int fr, int fq, float* outp, float* htp) {
    switch (mode) {
        case 0: EPI_CALL(0); break;
        case 1: EPI_CALL(1); break;
        case 2: EPI_CALL(2); break;
        case 3: EPI_CALL(3); break;
        case 4: EPI_CALL(4); break;
        case 5: EPI_CALL(5); break;
        case 6: EPI_CALL(6); break;
        case 7: EPI_CALL(7); break;
        case 8: EPI_CALL(8); break;
        default: EPI_CALL(9); break;
    }
}

__device__ __forceinline__ void gemm_phase(LAS unsigned char* lds, const PE* pe, const Params& P) {
    const int tid = threadIdx.x, wid = __builtin_amdgcn_readfirstlane(tid >> 6), lane = tid & 63, wr = wid >> 2, wc = wid & 3, fr = lane & 15, fq = lane >> 4;
    const int K = pe->K, nt = K / BK;
    const int sG = (int)gridDim.x, sC = (int)blockIdx.x, s_ng = pe->ng;
    const int sc1 = NMT * (pe->g[0].N / BM);
    const int sc2 = sc1 + (s_ng > 1 ? NMT * (pe->g[1].N / BM) : 0);
    const int sc3 = sc2 + (s_ng > 2 ? NMT * (pe->g[2].N / BM) : 0);
    const int sc4 = sc3 + (s_ng > 3 ? NMT * (pe->g[3].N / BM) : 0);
    unsigned char* const ws = P.ws;
    unsigned voff[2];
#pragma unroll
    for (int i = 0; i < 2; ++i) { int R, C; stage_rc(tid * 16 + i * 8192, R, C); voff[i] = (unsigned)(R * K + C) * 2u; }
    const size_t kstep = (size_t)(BK * 2);
    const size_t hstep = (size_t)HALF * K * 2;
    const size_t tstep = 2 * hstep;
    const unsigned ldsw = (unsigned)wid * 1024u;
    const int aoff = lds_byte(wr * 64 + fr, fq * 8), boff = lds_byte(wc * 32 + fr, fq * 8);
#define PG8_SA(b, h) (((b) * 2 + (h)) * HTB)
#define PG8_SB(b, h) ((4 + (b) * 2 + (h)) * HTB)
#define PG8_STAGE(bufoff, gbase) do { _Pragma("unroll") for (int _i = 0; _i < 2; ++_i) \
        __builtin_amdgcn_global_load_lds((const unsigned*)((const char*)(gbase) + voff[_i]), (LAS unsigned*)(lds + (bufoff) + ldsw + _i * 8192), 16, 0, 0); } while (0)
#define PG8_LDA(dst, b, h) do { _Pragma("unroll") for (int m = 0; m < 4; ++m) _Pragma("unroll") for (int k = 0; k < 2; ++k) dst[m][k] = *(const LAS bf16x8*)(lds + PG8_SA(b, h) + aoff + m * 2048 + k * 1024); } while (0)
#define PG8_LDB(dst, b, h) do { _Pragma("unroll") for (int n = 0; n < 2; ++n) _Pragma("unroll") for (int k = 0; k < 2; ++k) dst[n][k] = *(const LAS bf16x8*)(lds + PG8_SB(b, h) + boff + n * 2048 + k * 1024); } while (0)
#define PG8_MMA(ai, bj, At, Bt) do { __builtin_amdgcn_s_setprio(1); _Pragma("unroll") for (int m = 0; m < 4; ++m) _Pragma("unroll") for (int n = 0; n < 2; ++n) _Pragma("unroll") for (int k = 0; k < 2; ++k) \
        acc[ai][bj][m][n] = __builtin_amdgcn_mfma_f32_16x16x32_bf16(Bt[n][k], At[m][k], acc[ai][bj][m][n], 0, 0, 0); __builtin_amdgcn_s_setprio(0); } while (0)
#define PG8_WAIT_V(n) asm volatile("s_waitcnt vmcnt(" #n ")" ::: "memory")
#define PG8_WAIT_L(n) asm volatile("s_waitcnt lgkmcnt(" #n ")" ::: "memory")
#define PG8_BAR __builtin_amdgcn_s_barrier()
#define PG8_SCHED __builtin_amdgcn_sched_barrier(0)
    Unit cur, nxt; int ui = 0;
    if (!sched_next(sC, sc1, sc2, sc3, sc4, cur)) return;
    f32x4 acc[2][2][4][2];
#pragma unroll
    for (int a = 0; a < 2; ++a)
#pragma unroll
        for (int b = 0; b < 2; ++b)
#pragma unroll
            for (int m = 0; m < 4; ++m)
#pragma unroll
                for (int n = 0; n < 2; ++n) acc[a][b][m][n] = (f32x4){0.f, 0.f, 0.f, 0.f};
    bf16x8 At[4][2], B0[2][2], B1[2][2];
    const char* cA = (const char*)ws + pe->g[cur.gi].A + (size_t)cur.pm * tstep; const char* cB = (const char*)ws + pe->g[cur.gi].Bt + (size_t)cur.pn * tstep;
    PG8_STAGE(PG8_SB(0, 0), cB); PG8_STAGE(PG8_SA(0, 0), cA); PG8_STAGE(PG8_SB(0, 1), cB + hstep); PG8_STAGE(PG8_SA(0, 1), cA + hstep);
    if (wr == 1) PG8_BAR;
    PG8_WAIT_V(4); PG8_BAR;
    PG8_STAGE(PG8_SB(1, 0), cB + kstep); PG8_STAGE(PG8_SA(1, 0), cA + kstep); PG8_STAGE(PG8_SB(1, 1), cB + hstep + kstep);
    PG8_WAIT_V(6); PG8_BAR;
    for (;;) {
        const bool has_next = sched_next((ui + 1) * sG + sC, sc1, sc2, sc3, sc4, nxt);
        const char* nA = cA; const char* nB = cB;
        if (has_next) { nA = (const char*)ws + pe->g[nxt.gi].A + (size_t)nxt.pm * tstep; nB = (const char*)ws + pe->g[nxt.gi].Bt + (size_t)nxt.pn * tstep; }
        for (int t = 0; t < nt; t += 2) {
            const bool last = (t == nt - 2);
            const char* a1 = cA + (size_t)(t + 1) * kstep;
            const char* a2 = last ? nA : cA + (size_t)(t + 2) * kstep; const char* b2 = last ? nB : cB + (size_t)(t + 2) * kstep;
            const char* a3 = a2 + kstep; const char* b3 = b2 + kstep;
            PG8_LDB(B0, 0, 0); PG8_SCHED; PG8_LDA(At, 0, 0); PG8_STAGE(PG8_SA(1, 1), a1 + hstep);
            PG8_WAIT_L(8); PG8_BAR; PG8_WAIT_L(0); PG8_MMA(0, 0, At, B0); PG8_BAR; PG8_SCHED;
            PG8_LDB(B1, 0, 1); PG8_STAGE(PG8_SB(0, 0), b2);
            PG8_BAR; PG8_WAIT_L(0); PG8_MMA(0, 1, At, B1); PG8_BAR;
            PG8_LDA(At, 0, 1); PG8_STAGE(PG8_SA(0, 0), a2);
            PG8_BAR; PG8_WAIT_L(0); PG8_MMA(1, 0, At, B0); PG8_BAR; PG8_SCHED;
            PG8_STAGE(PG8_SB(0, 1), b2 + hstep);
            PG8_WAIT_V(6); PG8_BAR; PG8_MMA(1, 1, At, B1); PG8_BAR;
            PG8_LDB(B0, 1, 0); PG8_SCHED; PG8_LDA(At, 1, 0); PG8_STAGE(PG8_SA(0, 1), a2 + hstep);
            PG8_WAIT_L(8); PG8_BAR; PG8_WAIT_L(0); PG8_MMA(0, 0, At, B0); PG8_BAR; PG8_SCHED;
            PG8_LDB(B1, 1, 1); PG8_STAGE(PG8_SB(1, 0), b3);
            PG8_BAR; PG8_WAIT_L(0); PG8_MMA(0, 1, At, B1); PG8_BAR;
            PG8_LDA(At, 1, 1); PG8_STAGE(PG8_SA(1, 0), a3);
            PG8_BAR; PG8_WAIT_L(0); PG8_MMA(1, 0, At, B0); PG8_BAR; PG8_SCHED;
            PG8_STAGE(PG8_SB(1, 1), b3 + hstep);
            PG8_WAIT_V(6); PG8_BAR; PG8_MMA(1, 1, At, B1); PG8_BAR;
        }
        { const GD* gd = &pe->g[cur.gi];
          epilogue(acc, gd->mode, ws + gd->o0, ws + gd->o1, P.in[gd->bin] + gd->boff, gd->ldo, cur.pm, cur.pn, wr, wc, fr, fq, P.out, (float*)(ws + OFF_HT)); }
        if (!has_next) break;
#pragma unroll
        for (int a = 0; a < 2; ++a)
#pragma unroll
            for (int b = 0; b < 2; ++b)
#pragma unroll
                for (int m = 0; m < 4; ++m)
#pragma unroll
                    for (int n = 0; n < 2; ++n) acc[a][b][m][n] = (f32x4){0.f, 0.f, 0.f, 0.f};
        cur = nxt; cA = nA; cB = nB; ++ui;
    }
    PG8_WAIT_V(0);
    if (wr == 0) PG8_BAR;
    PG8_BAR;
#undef PG8_SA
#undef PG8_SB
#undef PG8_STAGE
#undef PG8_LDA
#undef PG8_LDB
#undef PG8_MMA
#undef PG8_WAIT_V
#undef PG8_WAIT_L
#undef PG8_BAR
#undef PG8_SCHED
}

#define TE_CALL(MD) epi_elem<MD>(r, c, v, o0, o1, bvt, ldo, P.out, (float*)(ws + OFF_HT))
__device__ void tail_gemm(LAS unsigned char* lds, const PE* pe, const Params& P) {
    const int tid = otid(), w = tid >> 6, lane = tid & 63, fr = lane & 15, fq = lane >> 4;
    unsigned char* const ws = P.ws;
    const int K = pe->K, ks = K >> 3, nstep = ks >> 5, ng = pe->ng;
    const int t1 = pe->g[0].N >> 4;
    const int t2 = t1 + (ng > 1 ? pe->g[1].N >> 4 : 0);
    const int t3 = t2 + (ng > 2 ? pe->g[2].N >> 4 : 0);
    const int t4 = t3 + (ng > 3 ? pe->g[3].N >> 4 : 0);
    LAS f32x4* part = (LAS f32x4*)lds;
    const int bid_ = obid();
    const int rank_ = (bid_ & 1) ? (bid_ >> 1) : ((int)(gridDim.x >> 1) + (bid_ >> 1));
    for (int item = rank_; item < t4; item += gridDim.x) {
        int gi = 0, base = 0;
        if (item >= t1) { gi = 1; base = t1; }
        if (item >= t2) { gi = 2; base = t2; }
        if (item >= t3) { gi = 3; base = t3; }
        const int cb = (item - base) >> 1, mh = (item - base) & 1;
        const GD* gd = &pe->g[gi];
        const bf16_t* A = (const bf16_t*)(ws + gd->A) + (size_t)(MMAIN + 32 * mh + fr) * K + (size_t)w * ks + 8 * fq;
        const bf16_t* Bt = (const bf16_t*)(ws + gd->Bt) + (size_t)(32 * cb + fr) * K + (size_t)w * ks + 8 * fq;
        const size_t r16 = (size_t)16 * K;
        f32x4 acc[2][2];
#pragma unroll
        for (int m = 0; m < 2; ++m) { acc[m][0] = (f32x4){0.f, 0.f, 0.f, 0.f}; acc[m][1] = acc[m][0]; }
        for (int s0 = 0; s0 < nstep; s0 += 8) {
            bf16x8 af[8][2], bfr[8][2];
#pragma unroll
            for (int s = 0; s < 8; ++s) if (s0 + s < nstep) {
                const int k0 = (s0 + s) * 32;
                af[s][0] = *(const bf16x8*)(A + k0); af[s][1] = *(const bf16x8*)(A + r16 + k0);
                bfr[s][0] = *(const bf16x8*)(Bt + k0); bfr[s][1] = *(const bf16x8*)(Bt + r16 + k0);
            }
#pragma unroll
            for (int s = 0; s < 8; ++s) if (s0 + s < nstep) {
#pragma unroll
                for (int m = 0; m < 2; ++m)
#pragma unroll
                    for (int nb = 0; nb < 2; ++nb) acc[m][nb] = __builtin_amdgcn_mfma_f32_16x16x32_bf16(bfr[s][nb], af[s][m], acc[m][nb], 0, 0, 0);
            }
        }
        __syncthreads();
#pragma unroll
        for (int m = 0; m < 2; ++m)
#pragma unroll
            for (int nb = 0; nb < 2; ++nb) part[(w * 4 + m * 2 + nb) * 64 + lane] = acc[m][nb];
        __syncthreads();
        if (tid < 256) {
            const int ml = tid >> 7, nb2 = (tid >> 6) & 1;
            f32x4 v = part[(ml * 2 + nb2) * 64 + lane];
#pragma unroll
            for (int x = 1; x < 8; ++x) v += part[(x * 4 + ml * 2 + nb2) * 64 + lane];
            const int r = MMAIN + 32 * mh + 16 * ml + fr, c = 32 * cb + 16 * nb2 + 4 * fq;
            const int mode = gd->mode, ldo = gd->ldo;
            void* o0 = ws + gd->o0; void* o1 = ws + gd->o1; const float* bias = P.in[gd->bin] + gd->boff;
            const f32x4 bvt = (mode == 5 || mode == 6 || mode == 7) ? *(const f32x4*)(bias + c) : (f32x4){0.f, 0.f, 0.f, 0.f};
            if (mode == 9) {
                if (nb2 == 0) { f32x4 up = part[(ml * 2 + 1) * 64 + lane];
#pragma unroll
                    for (int x = 1; x < 8; ++x) up += part[(x * 4 + ml * 2 + 1) * 64 + lane];
                    epi_swiglu(r, 16 * cb + 4 * fq, v, up, o0, ldo); }
            } else {
                switch (mode) {
                    case 0: TE_CALL(0); break;
                    case 1: TE_CALL(1); break;
                    case 2: TE_CALL(2); break;
                    case 3: TE_CALL(3); break;
                    case 4: TE_CALL(4); break;
                    case 5: TE_CALL(5); break;
                    case 6: TE_CALL(6); break;
                    case 7: TE_CALL(7); break;
                    default: TE_CALL(8); break;
                }
            }
        }
    }
}

__device__ void conv_T(const float* src, const float* src2, int ldsrc, bf16_t* dst, int K, int N, int Kpad, int Npad, int mode, LAS float* tile) {
    const int tid = otid();
    const int tk = Kpad / 256, tn = Npad / 64, ntile = tk * tn;
    for (int ti = obid(); ti < ntile; ti += gridDim.x) {
        const int R0 = (ti / tk) * 64, k0 = (ti % tk) * 256;
        f32x4 v[4][2];
#pragma unroll
        for (int sub = 0; sub < 4; ++sub)
#pragma unroll
            for (int pass = 0; pass < 2; ++pass) {
                const int kr = (tid >> 4) + pass * 32, c4 = (tid & 15) * 4;
                const int k = k0 + sub * 64 + kr, R = R0 + c4;
                v[sub][pass] = (f32x4){0.f, 0.f, 0.f, 0.f};
                if (k < K && R < N) {
                    const float* s; int col;
                    if (mode == 1) { const int g = R >> 5, wi = R & 31; s = wi < 16 ? src : src2; col = 16 * g + (wi & 15); }
                    else { s = src; col = R; }
                    v[sub][pass] = __builtin_nontemporal_load((const f32x4*)(s + (size_t)k * ldsrc + col));
                }
            }
        __syncthreads();
#pragma unroll
        for (int sub = 0; sub < 4; ++sub)
#pragma unroll
            for (int pass = 0; pass < 2; ++pass) {
                const int kr = (tid >> 4) + pass * 32, c4 = (tid & 15) * 4;
                LAS float* t = tile + sub * (64 * 65) + kr * 65 + c4;
                t[0] = v[sub][pass][0]; t[1] = v[sub][pass][1]; t[2] = v[sub][pass][2]; t[3] = v[sub][pass][3];
            }
        __syncthreads();
        const int Rr = tid >> 3, k8 = (tid & 7) * 8;
#pragma unroll
        for (int sub = 0; sub < 4; ++sub) {
            float e[8];
#pragma unroll
            for (int i = 0; i < 8; ++i) e[i] = tile[sub * (64 * 65) + (k8 + i) * 65 + Rr];
            u32x4 o; o.x = cvt_pk_bf16(e[0], e[1]); o.y = cvt_pk_bf16(e[2], e[3]); o.z = cvt_pk_bf16(e[4], e[5]); o.w = cvt_pk_bf16(e[6], e[7]);
            *(u32x4*)(dst + (size_t)(R0 + Rr) * Kpad + k0 + sub * 64 + k8) = o;
        }
    }
}

struct CJ { int in0, in1, ldsrc, K, N, Kpad, Npad, mode; unsigned long long soff, doff; };
struct CJTab { CJ j[4][14]; int n[4]; };
constexpr CJ mkcj(int in0, int in1, unsigned long long soff, int ldsrc, unsigned long long doff, int K, int N, int Kpad, int Npad, int mode) {
    CJ c{}; c.in0 = in0; c.in1 = in1; c.ldsrc = ldsrc; c.K = K; c.N = N; c.Kpad = Kpad; c.Npad = Npad; c.mode = mode; c.soff = soff; c.doff = doff; return c;
}
constexpr CJTab make_cjtab() {
    CJTab t{};
    const unsigned long long DD = (unsigned long long)D * D, DF = (unsigned long long)D * FF;
    for (int layer = 0; layer < 4; ++layer) {
        int n = 0;
        if (layer < 2) {
            const unsigned long long i = layer;
            t.j[layer][n++] = mkcj(8, 8, i * DD, D, OFF_WA + WA_W0, D, D, D, D, 0);
            t.j[layer][n++] = mkcj(9, 9, i * DD, D, OFF_WA + WA_W1, D, D, D, D, 0);
            t.j[layer][n++] = mkcj(10, 10, i * DD, D, OFF_WA + WA_W2, D, D, D, D, 0);
            t.j[layer][n++] = mkcj(13, 13, i * D * 96, 96, OFF_WA + WA_L1 + 0 * WSLOT, D, 96, D, 256, 0);
            t.j[layer][n++] = mkcj(16, 16, i * D * 96, 96, OFF_WA + WA_L1 + 1 * WSLOT, D, 96, D, 256, 0);
            t.j[layer][n++] = mkcj(18, 18, i * D * 256, 256, OFF_WA + WA_L1 + 2 * WSLOT, D, 256, D, 256, 0);
            t.j[layer][n++] = mkcj(14, 14, i * 96 * D, D, OFF_WA + WA_L2 + 0 * WSLOT, 96, D, 256, D, 0);
            t.j[layer][n++] = mkcj(17, 17, i * 96 * D, D, OFF_WA + WA_L2 + 1 * WSLOT, 96, D, 256, D, 0);
            t.j[layer][n++] = mkcj(19, 19, i * 256 * D, D, OFF_WA + WA_L2 + 2 * WSLOT, 256, D, 256, D, 0);
            if (layer >= 1) {
                t.j[layer][n++] = mkcj(26, 26, (i - 1) * D * 64, 64, OFF_WA + WA_L1 + 3 * WSLOT, D, 64, D, 256, 0);
                t.j[layer][n++] = mkcj(27, 27, (i - 1) * 64 * D, D, OFF_WA + WA_L2 + 3 * WSLOT, 64, D, 256, D, 0);
            }
            t.j[layer][n++] = mkcj(11, 11, i * DD, D, OFF_WB + WB_WO, D, D, D, D, 0);
        } else {
            const unsigned long long jj = layer - 2;
            t.j[layer][n++] = mkcj(32, 32, jj * DD, D, OFF_WA + WA_W0, D, D, D, D, 0);
            if (layer == 2) {
                t.j[layer][n++] = mkcj(29, 29, 0, D, OFF_WA + WA_W1, D, D, D, D, 0);
                t.j[layer][n++] = mkcj(30, 30, 0, D, OFF_WA + WA_W2, D, D, D, D, 0);
            }
            t.j[layer][n++] = mkcj(34, 34, jj * DD, D, OFF_WB + WB_WO, D, D, D, D, 0);
        }
        t.j[layer][n++] = mkcj(4, 5, (unsigned long long)layer * DF, FF, OFF_WB + WB_F1, D, 2 * FF, D, 2 * FF, 1);
        t.j[layer][n++] = mkcj(6, 6, (unsigned long long)layer * DF, D, OFF_WB + WB_F2, FF, D, FF, D, 0);
        t.n[layer] = n;
    }
    return t;
}
__constant__ const CJTab CJT = make_cjtab();

__device__ void convert_layer(const Params& P, int layer, LAS unsigned char* lds) {
    LAS float* tile = (LAS float*)lds;
    const int nj = CJT.n[layer];
    for (int q = 0; q < nj; ++q) {
        const CJ* c = &CJT.j[layer][q];
        conv_T(P.in[c->in0] + c->soff, P.in[c->in1] + c->soff, c->ldsrc, (bf16_t*)(P.ws + c->doff), c->K, c->N, c->Kpad, c->Npad, c->mode, tile);
    }
}

__device__ void init_phase(const Params& P) {
    const f32x4* x = (const f32x4*)P.in[0]; f32x4* o = (f32x4*)P.out;
    const size_t n4 = (size_t)MMAIN * D / 4;
    for (size_t i = (size_t)obid() * NTHR + otid(); i < n4; i += (size_t)gridDim.x * NTHR) o[i] = x[i];
    const f32x4* mt = (const f32x4*)P.in[1]; f32x4* ht = (f32x4*)(P.ws + OFF_HT);
    const int m4 = NBATCH * NMETA * D / 4, per = NMETA * D / 4;
    for (int i = obid() * NTHR + otid(); i < m4; i += gridDim.x * NTHR) ht[i] = mt[i % per];
}

__device__ void mixprep_phase(const Params& P, int i) {
    const int tid_ = otid(); const int w = tid_ >> 6, lane = tid_ & 63;
    const float* g = P.in[2] + (size_t)i * D;
    const float* mu = P.in[7] + (size_t)i * 6 * D;
    bf16_t* const ob[6] = {(bf16_t*)(P.ws + OFF_MIX), (bf16_t*)(P.ws + OFF_DEC), (bf16_t*)(P.ws + OFF_MIX + SZB), (bf16_t*)(P.ws + OFF_MIX + 2 * SZB),
                           (bf16_t*)(P.ws + OFF_DEC + SZB), (bf16_t*)(P.ws + OFF_KF)};
    for (int idx = obid() * 8 + w; idx < M; idx += gridDim.x * 8) {
        const int b = idx / L, t = idx % L;
        const int r = rowof(b, t), rprev = rowof(b, t > 0 ? t - 1 : 0);
        const float* hc; const float* hp;
        if (i == 0) {
            hc = r < MMAIN ? P.in[0] + (size_t)r * D : P.in[1] + (size_t)((r - MMAIN) & 15) * D;
            hp = rprev < MMAIN ? P.in[0] + (size_t)rprev * D : P.in[1] + (size_t)((rprev - MMAIN) & 15) * D;
        } else { hc = hrow(P, r); hp = hrow(P, rprev); }
        float* hw = hrow(P, r);
        f32x4 c[8], p[8]; float sc = 0.f, sp = 0.f;
#pragma unroll
        for (int q = 0; q < 8; ++q) { c[q] = *(const f32x4*)(hc + 256 * q + 4 * lane); p[q] = *(const f32x4*)(hp + 256 * q + 4 * lane);
            sc += c[q][0] * c[q][0] + c[q][1] * c[q][1] + c[q][2] * c[q][2] + c[q][3] * c[q][3];
            sp += p[q][0] * p[q][0] + p[q][1] * p[q][1] + p[q][2] * p[q][2] + p[q][3] * p[q][3]; }
        if (i == 0) {
#pragma unroll
            for (int q = 0; q < 8; ++q) *(f32x4*)(hw + 256 * q + 4 * lane) = c[q];
        }
        sc = wavesum(sc); sp = wavesum(sp);
        const float rc = rsqrtf(sc * (1.0f / D) + 1e-6f);
        const float rp = t > 0 ? rsqrtf(sp * (1.0f / D) + 1e-6f) : 0.f;
#pragma unroll
        for (int q = 0; q < 8; ++q) {
            const int col = 256 * q + 4 * lane;
            const f32x4 gv = *(const f32x4*)(g + col);
            f32x4 hn, xx;
#pragma unroll
            for (int e = 0; e < 4; ++e) { hn[e] = c[q][e] * rc * gv[e]; xx[e] = p[q][e] * rp * gv[e] - hn[e]; }
#pragma unroll
            for (int j = 0; j < 6; ++j) {
                const f32x4 m = *(const f32x4*)(mu + j * D + col);
                u32x2 a; a.x = cvt_pk_bf16(hn[0] + xx[0] * m[0], hn[1] + xx[1] * m[1]); a.y = cvt_pk_bf16(hn[2] + xx[2] * m[2], hn[3] + xx[3] * m[3]);
                *(u32x2*)(ob[j] + (size_t)r * D + col) = a;
            }
        }
    }
}

__device__ void norm_phase(const Params& P, const float* g1, bf16_t* o1, const float* g2, bf16_t* o2) {
    const int tid_ = otid(); const int w = tid_ >> 6, lane = tid_ & 63;
    for (int r = obid() * 8 + w; r < M; r += gridDim.x * 8) {
        const float* hc = hrow(P, r);
        f32x4 c[8]; float sc = 0.f;
#pragma unroll
        for (int q = 0; q < 8; ++q) { c[q] = *(const f32x4*)(hc + 256 * q + 4 * lane); sc += c[q][0] * c[q][0] + c[q][1] * c[q][1] + c[q][2] * c[q][2] + c[q][3] * c[q][3]; }
        sc = wavesum(sc);
        const float rc = rsqrtf(sc * (1.0f / D) + 1e-6f);
#pragma unroll
        for (int q = 0; q < 8; ++q) {
            const int col = 256 * q + 4 * lane;
            const f32x4 gv = *(const f32x4*)(g1 + col);
            u32x2 a; a.x = cvt_pk_bf16(c[q][0] * rc * gv[0], c[q][1] * rc * gv[1]); a.y = cvt_pk_bf16(c[q][2] * rc * gv[2], c[q][3] * rc * gv[3]);
            *(u32x2*)(o1 + (size_t)r * D + col) = a;
            if (g2) { const f32x4 g2v = *(const f32x4*)(g2 + col);
                u32x2 bq; bq.x = cvt_pk_bf16(c[q][0] * rc * g2v[0], c[q][1] * rc * g2v[1]); bq.y = cvt_pk_bf16(c[q][2] * rc * g2v[2], c[q][3] * rc * g2v[3]);
                *(u32x2*)(o2 + (size_t)r * D + col) = bq; }
        }
    }
}

__device__ void scan_phase(const Params& P, int i, LAS unsigned char* lds) {
    const int tid = otid(), w = tid >> 6, lane = tid & 63;
    const bf16_t* RB = (const bf16_t*)(P.ws + OFF_RB); const bf16_t* KF = (const bf16_t*)(P.ws + OFF_KF);
    const bf16_t* VF = (const bf16_t*)(P.ws + (i == 0 ? OFF_VFIRST : OFF_VF)); const float* DEC = (const float*)(P.ws + OFF_DEC);
    const bf16_t* AB = (const bf16_t*)(P.ws + OFF_MIX); bf16_t* YB = (bf16_t*)(P.ws + OFF_MIX + 2 * SZB);
    const float* k_k = P.in[20] + (size_t)i * D; const float* k_a = P.in[21] + (size_t)i * D; const float* r_k = P.in[22] + (size_t)i * D;
    float* SBON = (float*)(P.ws + OFF_LORA);
    LAS float* fl = (LAS float*)lds;
    constexpr int STG = 11264;
    LAS float* ybuf = fl + 2 * STG;
    typedef float f32x2 __attribute__((ext_vector_type(2)));
    const int wu = __builtin_amdgcn_readfirstlane(w);
    const int kg = lane & 15, rp = 4 * (wu & 3) + (lane >> 4);
    const int lt = tid & 255;
    const int lc = (lt & 15) * 4, vt = lt >> 3, vc = (lt & 7) * 4;
    constexpr int NCH = (L + 31) / 32;
    for (int u = obid(); u < 256; u += gridDim.x) {
        const int bh = u >> 1, rh = u & 1, b = bh >> 5, h = bh & 31;
        f32x4 kkp = (f32x4){0.f, 0.f, 0.f, 0.f}, kap = kkp, rkp = kkp;
        f32x4 gk[2], gd[2], gv; u32x2 gr[2], ga[2];
        __syncthreads();
#define SCAN_LOAD(cc) do { _Pragma("unroll") for (int q_ = 0; q_ < 2; ++q_) { const int t_ = 32 * (cc) + (lt >> 4) + 16 * q_; \
              gk[q_] = (f32x4){0.f, 0.f, 0.f, 0.f}; gd[q_] = gk[q_]; gr[q_] = (u32x2){0u, 0u}; ga[q_] = gr[q_]; \
              if (t_ < L) { const size_t o_ = (size_t)rowof(b, t_) * D + 64 * h + lc; { const u32x2 kr_ = *(const u32x2*)(KF + o_); gk[q_][0] = bf_lo(kr_.x); gk[q_][1] = bf_hi(kr_.x); gk[q_][2] = bf_lo(kr_.y); gk[q_][3] = bf_hi(kr_.y); } gd[q_] = *(const f32x4*)(DEC + o_); gr[q_] = *(const u32x2*)(RB + o_); ga[q_] = *(const u32x2*)(AB + o_); } } \
            { const int tv_ = 32 * (cc) + vt; gv = (f32x4){0.f, 0.f, 0.f, 0.f}; if (tv_ < L) { const u32x2 vr_ = *(const u32x2*)(VF + (size_t)rowof(b, tv_) * D + 64 * h + 32 * rh + vc); gv[0] = bf_lo(vr_.x); gv[1] = bf_hi(vr_.x); gv[2] = bf_lo(vr_.y); gv[3] = bf_hi(vr_.y); } } } while (0)
#define SCAN_STORE(st, cc) do { LAS float* s_ = fl + (st) * STG; _Pragma("unroll") for (int q_ = 0; q_ < 2; ++q_) { const int o_ = ((lt >> 4) + 16 * q_) * 64 + lc; \
              f32x4 kr_ = gk[q_] * kkp; float ss_ = kr_[0] * kr_[0] + kr_[1] * kr_[1] + kr_[2] * kr_[2] + kr_[3] * kr_[3]; ss_ = rowsum16(ss_); \
              const float inv_ = rsqrtf(fmaxf(ss_, 1e-24f)); \
              f32x4 av_; av_[0] = bf_lo(ga[q_].x); av_[1] = bf_hi(ga[q_].x); av_[2] = bf_lo(ga[q_].y); av_[3] = bf_hi(ga[q_].y); \
              f32x4 rv_; rv_[0] = bf_lo(gr[q_].x); rv_[1] = bf_hi(gr[q_].x); rv_[2] = bf_lo(gr[q_].y); rv_[3] = bf_hi(gr[q_].y); \
              const f32x4 kk_ = kr_ * inv_; f32x4 kp_; \
              for (int e_ = 0; e_ < 4; ++e_) kp_[e_] = gk[q_][e_] * (1.0f + (av_[e_] - 1.0f) * kap[e_]); \
              *(LAS f32x4*)(s_ + o_) = rv_; *(LAS f32x4*)(s_ + 2048 + o_) = gd[q_]; *(LAS f32x4*)(s_ + 4096 + o_) = kp_; \
              *(LAS f32x4*)(s_ + 6144 + o_) = kk_; *(LAS f32x4*)(s_ + 8192 + o_) = kk_ * av_; \
              float sb_ = rv_[0] * kp_[0] * rkp[0] + rv_[1] * kp_[1] * rkp[1] + rv_[2] * kp_[2] * rkp[2] + rv_[3] * kp_[3] * rkp[3]; sb_ = rowsum16(sb_); \
              { const int tb_ = 32 * (cc) + (lt >> 4) + 16 * q_; if (rh == 0 && (lt & 15) == 0 && tb_ < L) SBON[(size_t)rowof(b, tb_) * 32 + h] = sb_; } } \
            *(LAS f32x4*)(s_ + 10240 + vt * 32 + vc) = gv; } while (0)
#define SCAN_FLUSH(cc) do { const LAS float* yb_ = ybuf + ((cc) & 1) * 1024; _Pragma("unroll") for (int q_ = 0; q_ < 2; ++q_) { const int ft_ = (lt >> 4) + 16 * q_, fv_ = (lt & 15) * 2; const int tt_ = 32 * (cc) + ft_; \
              if (tt_ < L) { const unsigned pk_ = cvt_pk_bf16(yb_[ft_ * 32 + fv_], yb_[ft_ * 32 + fv_ + 1]); *(unsigned*)(YB + (size_t)rowof(b, tt_) * D + 64 * h + 32 * rh + fv_) = pk_; } } } while (0)
        if (wu >= 4) {
            kkp = *(const f32x4*)(k_k + 64 * h + lc); kap = *(const f32x4*)(k_a + 64 * h + lc); rkp = *(const f32x4*)(r_k + 64 * h + lc);
            SCAN_LOAD(0); SCAN_STORE(0, 0);
            SCAN_LOAD(1);
        }
        __syncthreads();
        f32x2 SA01 = {0.f, 0.f}, SA23 = SA01, SB01 = SA01, SB23 = SA01;
        for (int c = 0; c < NCH; ++c) {
            if (wu < 4) {
                const LAS float* s = fl + (c & 1) * STG;
                LAS float* yb = ybuf + (c & 1) * 1024;
                const int ns = (L - 32 * c) < 32 ? (L - 32 * c) : 32;
                for (int tb = 0; tb < ns; tb += 16) {
                    float ykA = 0.f, ykB = 0.f;
#pragma unroll
                    for (int j = 0; j < 16; ++j) {
                        const int t = tb + j;
                        const int o = t * 64 + 4 * kg;
                        const f32x4 r4 = *(const LAS f32x4*)(s + o), d4 = *(const LAS f32x4*)(s + 2048 + o), kp4 = *(const LAS f32x4*)(s + 4096 + o);
                        const f32x4 kk4 = *(const LAS f32x4*)(s + 6144 + o), ka4 = *(const LAS f32x4*)(s + 8192 + o);
                        const f32x2 vv = *(const LAS f32x2*)(s + 10240 + t * 32 + 2 * rp);
                        const f32x2 kk01 = {kk4[0], kk4[1]}, kk23 = {kk4[2], kk4[3]}, ka01 = {ka4[0], ka4[1]}, ka23 = {ka4[2], ka4[3]};
                        const f32x2 kp01 = {kp4[0], kp4[1]}, kp23 = {kp4[2], kp4[3]}, d01 = {d4[0], d4[1]}, d23 = {d4[2], d4[3]}, r01 = {r4[0], r4[1]}, r23 = {r4[2], r4[3]};
                        f32x2 pA = SA01 * kk01; pA = SA23 * kk23 + pA;
                        f32x2 pB = SB01 * kk01; pB = SB23 * kk23 + pB;
                        const float saA = -rowsum16(pA.x + pA.y), saB = -rowsum16(pB.x + pB.y);
                        f32x2 tA01 = kp01 * vv.x, tA23 = kp23 * vv.x, tB01 = kp01 * vv.y, tB23 = kp23 * vv.y;
                        tA01 = ka01 * saA + tA01; tA23 = ka23 * saA + tA23; tB01 = ka01 * saB + tB01; tB23 = ka23 * saB + tB23;
                        SA01 = SA01 * d01 + tA01; SA23 = SA23 * d23 + tA23; SB01 = SB01 * d01 + tB01; SB23 = SB23 * d23 + tB23;
                        f32x2 qA = SA01 * r01; qA = SA23 * r23 + qA;
                        f32x2 qB = SB01 * r01; qB = SB23 * r23 + qB;
                        const float yA = rowsum16(qA.x + qA.y), yB = rowsum16(qB.x + qB.y);
                        ykA = (kg == j) ? yA : ykA; ykB = (kg == j) ? yB : ykB;
                    }
                    { f32x2 yy = {ykA, ykB}; *(LAS f32x2*)(yb + (tb + kg) * 32 + 2 * rp) = yy; }
                }
            } else {
                if (c + 1 < NCH) SCAN_STORE((c + 1) & 1, c + 1);
                if (c + 2 < NCH) SCAN_LOAD(c + 2);
                if (c >= 1) SCAN_FLUSH(c - 1);
            }
            __syncthreads();
        }
        if (wu >= 4) SCAN_FLUSH(NCH - 1);
#undef SCAN_LOAD
#undef SCAN_STORE
#undef SCAN_FLUSH
    }
}

__device__ void post_phase(const Params& P, int i) {
    const int tid_ = otid(); const int w = tid_ >> 6, lane = tid_ & 63;
    const bf16_t* VF = (const bf16_t*)(P.ws + (i == 0 ? OFF_VFIRST : OFF_VF)); const float* SBON = (const float*)(P.ws + OFF_LORA);
    const bf16_t* GB = (const bf16_t*)(P.ws + OFF_MIX + SZB); bf16_t* YB = (bf16_t*)(P.ws + OFF_MIX + 2 * SZB);
    const float* gn_w = P.in[23] + (size_t)i * D; const float* gn_b = P.in[24] + (size_t)i * D;
    for (int r = obid() * 8 + w; r < M; r += gridDim.x * 8) {
#pragma unroll
        for (int q = 0; q < 8; ++q) {
            const int col = 256 * q + 4 * lane; const size_t o = (size_t)r * D + col;
            const u32x2 yv = *(const u32x2*)(YB + o), gv = *(const u32x2*)(GB + o);
            const u32x2 vr_ = *(const u32x2*)(VF + o); f32x4 vv; vv[0] = bf_lo(vr_.x); vv[1] = bf_hi(vr_.x); vv[2] = bf_lo(vr_.y); vv[3] = bf_hi(vr_.y);
            const float sb = SBON[(size_t)r * 32 + 4 * q + (lane >> 4)];
            const f32x4 gw = *(const f32x4*)(gn_w + col), gb = *(const f32x4*)(gn_b + col);
            float y[4] = {bf_lo(yv.x), bf_hi(yv.x), bf_lo(yv.y), bf_hi(yv.y)};
            const float gg[4] = {bf_lo(gv.x), bf_hi(gv.x), bf_lo(gv.y), bf_hi(gv.y)};
            float sy = (y[0] + y[1]) + (y[2] + y[3]);
            sy = rowsum16(sy);
            const float mean = sy * (1.0f / 64.0f);
            float sv = 0.f;
#pragma unroll
            for (int e = 0; e < 4; ++e) { y[e] -= mean; sv += y[e] * y[e]; }
            sv = rowsum16(sv);
            const float rstd = rsqrtf(sv * (1.0f / 64.0f) + 64e-5f);
            float z[4];
#pragma unroll
            for (int e = 0; e < 4; ++e) z[e] = (y[e] * rstd * gw[e] + gb[e] + sb * vv[e]) * gg[e];
            u32x2 zo; zo.x = cvt_pk_bf16(z[0], z[1]); zo.y = cvt_pk_bf16(z[2], z[3]);
            *(u32x2*)(YB + o) = zo;
        }
    }
}

__device__ void headnorm_phase(const Params& P, LAS unsigned char* lds) {
    const int tid = otid(), w = tid >> 6, lane = tid & 63;
    const bf16_t* KR = (const bf16_t*)(P.ws + OFF_KF); const bf16_t* VR = (const bf16_t*)(P.ws + OFF_VF);
    bf16_t* KN = (bf16_t*)(P.ws + OFF_MIX + 2 * SZB); bf16_t* VT = (bf16_t*)(P.ws + OFF_DEC);
    const float* kg = P.in[31];
    for (int r = obid() * 8 + w; r < M; r += gridDim.x * 8) {
#pragma unroll
        for (int q = 0; q < 8; ++q) {
            const int col = 256 * q + 4 * lane; const size_t o = (size_t)r * D + col;
            const u32x2 kraw = *(const u32x2*)(KR + o); f32x4 kv; kv[0] = bf_lo(kraw.x); kv[1] = bf_hi(kraw.x); kv[2] = bf_lo(kraw.y); kv[3] = bf_hi(kraw.y);
            float ss = kv[0] * kv[0] + kv[1] * kv[1] + kv[2] * kv[2] + kv[3] * kv[3];
            ss = rowsum16(ss); ss += __shfl_xor(ss, 16);
            const float rs = rsqrtf(ss * (1.0f / 128.0f) + 1e-6f);
            const f32x4 gv = *(const f32x4*)(kg + (col & 127));
            u32x2 a; a.x = cvt_pk_bf16(kv[0] * rs * gv[0], kv[1] * rs * gv[1]); a.y = cvt_pk_bf16(kv[2] * rs * gv[2], kv[3] * rs * gv[3]);
            *(u32x2*)(KN + o) = a;
        }
    }
    LAS float* tile = (LAS float*)lds;
    for (int it = obid(); it < NBATCH * 66 * 16; it += gridDim.x) {
        const int h = it & 15, pt = (it >> 4) % 66, b = it / (16 * 66);
        __syncthreads();
#pragma unroll
        for (int pass = 0; pass < 4; ++pass) {
            const int key = (tid >> 5) + pass * 16, c4 = (tid & 31) * 4;
            const int t = 64 * pt + key - PPAD;
            f32x4 v = (f32x4){0.f, 0.f, 0.f, 0.f};
            if (t >= 0) { const u32x2 vraw = *(const u32x2*)(VR + (size_t)rowof(b, t) * D + 128 * h + c4); v[0] = bf_lo(vraw.x); v[1] = bf_hi(vraw.x); v[2] = bf_lo(vraw.y); v[3] = bf_hi(vraw.y); }
            tile[key * 129 + c4] = v[0]; tile[key * 129 + c4 + 1] = v[1]; tile[key * 129 + c4 + 2] = v[2]; tile[key * 129 + c4 + 3] = v[3];
        }
        __syncthreads();
        const int d = tid >> 2, k16 = (tid & 3) * 16;
        float e[16];
#pragma unroll
        for (int x = 0; x < 16; ++x) e[x] = tile[(k16 + x) * 129 + d];
        u32x4 o0, o1;
        o0.x = cvt_pk_bf16(e[0], e[1]); o0.y = cvt_pk_bf16(e[2], e[3]); o0.z = cvt_pk_bf16(e[4], e[5]); o0.w = cvt_pk_bf16(e[6], e[7]);
        o1.x = cvt_pk_bf16(e[8], e[9]); o1.y = cvt_pk_bf16(e[10], e[11]); o1.z = cvt_pk_bf16(e[12], e[13]); o1.w = cvt_pk_bf16(e[14], e[15]);
        bf16_t* dst = VT + ((size_t)((b * 16 + h) * 128 + d)) * PLEN + 64 * pt + k16;
        *(u32x4*)dst = o0; *(u32x4*)(dst + 8) = o1;
    }
}

__device__ void attn_phase(const Params& P, int j, LAS unsigned char* lds) {
    const int tid = otid(), w = tid >> 6, lane = tid & 63, fr = lane & 15, fq = lane >> 4;
    const bf16_t* QF = (const bf16_t*)(P.ws + OFF_RB);
    const bf16_t* KN = (const bf16_t*)(P.ws + OFF_MIX + 2 * SZB);
    const bf16_t* VT = (const bf16_t*)(P.ws + OFF_DEC);
    bf16_t* OB = (bf16_t*)(P.ws + OFF_MIX);
    const float* qg = P.in[33] + j * 128;
    constexpr int KSTR = 272, VSTR = 144, KBYTES = 64 * KSTR, VBYTES = 128 * VSTR, STGB = KBYTES + VBYTES;
#define ATT_LOADX(kt_, b_, h_, bh_, KR_, VR_) do { _Pragma("unroll") for (int i_ = 0; i_ < 2; ++i_) { const int id_ = tid + 512 * i_; \
            { const int row_ = id_ >> 4, c_ = id_ & 15; const int tk_ = 64 * (kt_) + row_ - PPAD; \
              KR_[i_] = *(const u32x4*)(KN + (size_t)rowof((b_), tk_ > 0 ? tk_ : 0) * D + 128 * (h_) + 8 * c_); } \
            { const int d_ = id_ >> 3, c_ = id_ & 7; VR_[i_] = *(const u32x4*)(VT + ((size_t)((bh_) * 128 + d_)) * PLEN + 64 * (kt_) + 8 * c_); } } } while (0)
#define ATT_PREFETCH(u_) do { const int qb_ = 32 - (u_) / 64, bh_ = (u_) % 64, b_ = bh_ >> 4, h_ = bh_ & 15; const int tq_ = 128 * qb_ + 16 * w + fr - PPAD; \
            const bf16_t* qp_ = QF + (size_t)rowof(b_, tq_ > 0 ? tq_ : 0) * D + 128 * h_ + 8 * fq; \
            _Pragma("unroll") for (int s_ = 0; s_ < 4; ++s_) nq[s_] = *(const u32x4*)(qp_ + 32 * s_); \
            ATT_LOADX(2 * qb_ + 1, b_, h_, bh_, nk, nv); } while (0)
    u32x4 nq[4], nk[2], nv[2];
    { const int u0 = obid(); if (u0 < 64 * 33) ATT_PREFETCH(u0); }
    for (int u = obid(); u < 64 * 33; u += gridDim.x) {
        const int qb = 32 - u / 64, bh = u % 64, b = bh >> 4, h = bh & 15;
        const int pq = 128 * qb + 16 * w + fr, tq = pq - PPAD;
        const int qrow = rowof(b, tq > 0 ? tq : 0);
        bf16x8 qf[4];
        u32x4 kr[2], vr[2];
        u32x4 cq[4];
#pragma unroll
        for (int s = 0; s < 4; ++s) cq[s] = nq[s];
        kr[0] = nk[0]; kr[1] = nk[1]; vr[0] = nv[0]; vr[1] = nv[1];
        { const int un = u + (int)gridDim.x; if (un < 64 * 33) ATT_PREFETCH(un); }
        {
            f32x4 qa[4], qc[4]; float ss = 0.f;
#pragma unroll
            for (int s = 0; s < 4; ++s) { const u32x4 qraw = cq[s];
                qa[s][0] = bf_lo(qraw.x); qa[s][1] = bf_hi(qraw.x); qa[s][2] = bf_lo(qraw.y); qa[s][3] = bf_hi(qraw.y); qc[s][0] = bf_lo(qraw.z); qc[s][1] = bf_hi(qraw.z); qc[s][2] = bf_lo(qraw.w); qc[s][3] = bf_hi(qraw.w);
                ss += qa[s][0] * qa[s][0] + qa[s][1] * qa[s][1] + qa[s][2] * qa[s][2] + qa[s][3] * qa[s][3] + qc[s][0] * qc[s][0] + qc[s][1] * qc[s][1] + qc[s][2] * qc[s][2] + qc[s][3] * qc[s][3]; }
            ss += __shfl_xor(ss, 16); ss += __shfl_xor(ss, 32);
            const float rs = rsqrtf(ss * (1.0f / 128.0f) + 1e-6f) * 0.08838834764831845f;
#pragma unroll
            for (int s = 0; s < 4; ++s) {
                const f32x4 g0 = *(const f32x4*)(qg + 32 * s + 8 * fq), g1 = *(const f32x4*)(qg + 32 * s + 8 * fq + 4);
                u32x4 pk; pk.x = cvt_pk_bf16(qa[s][0] * rs * g0[0], qa[s][1] * rs * g0[1]); pk.y = cvt_pk_bf16(qa[s][2] * rs * g0[2], qa[s][3] * rs * g0[3]);
                pk.z = cvt_pk_bf16(qc[s][0] * rs * g1[0], qc[s][1] * rs * g1[1]); pk.w = cvt_pk_bf16(qc[s][2] * rs * g1[2], qc[s][3] * rs * g1[3]);
                qf[s] = __builtin_bit_cast(bf16x8, pk);
            }
        }
        f32x4 oacc[8];
#pragma unroll
        for (int x = 0; x < 8; ++x) oacc[x] = (f32x4){0.f, 0.f, 0.f, 0.f};
        float carry = 1.0f;
#define ATT_LOAD(kt_) do { _Pragma("unroll") for (int i_ = 0; i_ < 2; ++i_) { const int id_ = tid + 512 * i_; \
            { const int row_ = id_ >> 4, c_ = id_ & 15; const int tk_ = 64 * (kt_) + row_ - PPAD; \
              kr[i_] = *(const u32x4*)(KN + (size_t)rowof(b, tk_ > 0 ? tk_ : 0) * D + 128 * h + 8 * c_); } \
            { const int d_ = id_ >> 3, c_ = id_ & 7; vr[i_] = *(const u32x4*)(VT + ((size_t)(bh * 128 + d_)) * PLEN + 64 * (kt_) + 8 * c_); } } } while (0)
#define ATT_WRITE(st_) do { _Pragma("unroll") for (int i_ = 0; i_ < 2; ++i_) { const int id_ = tid + 512 * i_; \
            *(LAS u32x4*)(lds + (st_) * STGB + (id_ >> 4) * KSTR + 16 * (id_ & 15)) = kr[i_]; \
            *(LAS u32x4*)(lds + (st_) * STGB + KBYTES + (id_ >> 3) * VSTR + 16 * (id_ & 7)) = vr[i_]; } } while (0)
        const int nti = 2 * qb + 1;
        __syncthreads();
        ATT_WRITE(0);
        __syncthreads();
        for (int it = 0; it < nti; ++it) {
            const int kt = nti - it;
            if (it + 1 < nti) ATT_LOAD(kt - 1);
            const LAS unsigned char* Ks = lds + (it & 1) * STGB; const LAS unsigned char* Vs = Ks + KBYTES;
            f32x4 st[4];
#pragma unroll
            for (int n = 0; n < 4; ++n) { st[n] = (f32x4){0.f, 0.f, 0.f, 0.f};
#pragma unroll
                for (int s = 0; s < 4; ++s) { const bf16x8 a = *(const LAS bf16x8*)(Ks + (16 * n + fr) * KSTR + 64 * s + 16 * fq);
                    st[n] = __builtin_amdgcn_mfma_f32_16x16x32_bf16(a, qf[s], st[n], 0, 0, 0); } }
            const bool need_mask = (kt >= 2 * qb) || (kt == 1);
            float kp[4][4], sg[4][4];
#pragma unroll
            for (int n = 0; n < 4; ++n)
#pragma unroll
                for (int e = 0; e < 4; ++e) { const float z = st[n][e]; const float ex = __expf(-fabsf(z)); const float r = __builtin_amdgcn_rcpf(1.0f + ex);
                    const bool pos = z >= 0.f; sg[n][e] = (pos ? 1.0f : ex) * r; kp[n][e] = (pos ? ex : 1.0f) * r; }
            if (need_mask) {
#pragma unroll
                for (int n = 0; n < 4; ++n)
#pragma unroll
                    for (int e = 0; e < 4; ++e) { const int pk = 64 * kt + 16 * n + 4 * fq + e; const bool valid = (pk < pq) && (pk >= PPAD);
                        if (!valid) { kp[n][e] = 1.0f; sg[n][e] = 0.f; } }
            }
            float X[4], Bt[4];
            {
                LAS f32x4* xch = (LAS f32x4*)(lds + 2 * STGB) + w * 64;
                f32x4 Tv;
#pragma unroll
                for (int n = 0; n < 4; ++n) Tv[n] = (kp[n][0] * kp[n][1]) * (kp[n][2] * kp[n][3]);
                xch[lane] = Tv;
                const f32x4 t0 = xch[fr], t1 = xch[fr + 16], t2 = xch[fr + 32], t3 = xch[fr + 48];
#pragma unroll
                for (int n = 0; n < 4; ++n) {
                    X[n] = (fq < 1 ? t1[n] : 1.0f) * (fq < 2 ? t2[n] : 1.0f) * (fq < 3 ? t3[n] : 1.0f);
                    Bt[n] = (t0[n] * t1[n]) * (t2[n] * t3[n]);
                }
            }
            float wgt[4][4]; float run = carry;
#pragma unroll
            for (int n = 3; n >= 0; --n) { const float s3 = run * X[n]; const float s2 = s3 * kp[n][3]; const float s1 = s2 * kp[n][2]; const float s0 = s1 * kp[n][1];
                wgt[n][3] = sg[n][3] * s3; wgt[n][2] = sg[n][2] * s2; wgt[n][1] = sg[n][1] * s1; wgt[n][0] = sg[n][0] * s0;
                run *= Bt[n]; }
            carry = run;
#pragma unroll
            for (int s2 = 0; s2 < 2; ++s2) {
                u32x4 pk; pk.x = cvt_pk_bf16(wgt[2 * s2][0], wgt[2 * s2][1]); pk.y = cvt_pk_bf16(wgt[2 * s2][2], wgt[2 * s2][3]);
                pk.z = cvt_pk_bf16(wgt[2 * s2 + 1][0], wgt[2 * s2 + 1][1]); pk.w = cvt_pk_bf16(wgt[2 * s2 + 1][2], wgt[2 * s2 + 1][3]);
                const bf16x8 pf = __builtin_bit_cast(bf16x8, pk);
#pragma unroll
                for (int db = 0; db < 8; ++db) {
                    const LAS unsigned char* vp = Vs + (16 * db + fr) * VSTR + 64 * s2 + 8 * fq;
                    const u32x2 v0 = *(const LAS u32x2*)vp, v1 = *(const LAS u32x2*)(vp + 32);
                    u32x4 vv; vv.x = v0.x; vv.y = v0.y; vv.z = v1.x; vv.w = v1.y;
                    oacc[db] = __builtin_amdgcn_mfma_f32_16x16x32_bf16(__builtin_bit_cast(bf16x8, vv), pf, oacc[db], 0, 0, 0);
                }
            }
            if (it + 1 < nti) ATT_WRITE((it + 1) & 1);
#ifndef NO_EARLY_EXIT
            LAS int* flg = (LAS int*)(lds + 2 * STGB + 8192) + (it & 1) * 8;
            { const int dead = __all(carry == 0.f); if (lane == 0) flg[w] = dead; }
            __syncthreads();
            { int alld = 1;
#pragma unroll
              for (int x = 0; x < 8; ++x) alld &= flg[x];
              if (alld) break; }
#else
            __syncthreads();
#endif
        }
#undef ATT_LOAD
#undef ATT_WRITE
        if (tq >= 0) {
#pragma unroll
            for (int db = 0; db < 8; ++db) { u32x2 o; o.x = cvt_pk_bf16(oacc[db][0], oacc[db][1]); o.y = cvt_pk_bf16(oacc[db][2], oacc[db][3]);
                *(u32x2*)(OB + (size_t)qrow * D + 128 * h + 16 * db + 4 * fq) = o; }
        }
    }
}

#define XB_TMO      128
#define XB_XCNT(j)  (256  + 64 * (j))
#define XB_XSUB(j)  (1280 + 64 * (j))
#define XB_XGEN(j)  (2304 + 64 * (j))
#define XB_TOP      3328
#define XB_TOPGEN   3392
#define XCD_BAR_WORDS 3456
#define XB_SPIN_CAP (1u << 18)

__device__ __forceinline__ unsigned xb_ld(unsigned* p)              { return __hip_atomic_load(p, __ATOMIC_RELAXED, __HIP_MEMORY_SCOPE_AGENT); }
__device__ __forceinline__ unsigned xb_add(unsigned* p, unsigned v) { return __hip_atomic_fetch_add(p, v, __ATOMIC_RELAXED, __HIP_MEMORY_SCOPE_AGENT); }
__device__ __forceinline__ unsigned xb_xcc_id() { return (unsigned)__builtin_amdgcn_s_getreg((3 << 11) | 20) & 0xFu; }
#define XB_SPIN(cond, bar) do { unsigned _sp = 0; while (cond) { __builtin_amdgcn_s_sleep(1); \
    if ((++_sp & 255u) == 0u) { if (xb_ld(&(bar)[XB_TMO])) break; if (_sp > XB_SPIN_CAP) { atomicAdd(&(bar)[XB_TMO], 1u); break; } } } } while (0)

struct XcdBarrier {
    unsigned* bar; unsigned x;
    volatile LAS unsigned* st;
};

__device__ __forceinline__ XcdBarrier xcd_barrier_post(unsigned* bar, volatile LAS unsigned* st) {
    XcdBarrier b; b.bar = bar; b.x = xb_xcc_id(); b.st = st;
    if (threadIdx.x == 0) (void)xb_add(&bar[XB_XCNT(b.x)], 1u);
    return b;
}
__device__ __forceinline__ void xcd_barrier_complete(unsigned* bar, unsigned x, unsigned& nloc, unsigned& nx) {
    const unsigned G = gridDim.x * gridDim.y * gridDim.z;
    unsigned sum, cnt, mine, sp = 0u;
    for (;;) {
        sum = 0u; cnt = 0u; mine = 0u;
#pragma unroll
        for (unsigned j = 0; j < 16; ++j) { const unsigned c = xb_ld(&bar[XB_XCNT(j)]); sum += c; cnt += (c > 0u) ? 1u : 0u; mine = (j == x) ? c : mine; }
        if (sum == G) break;
        __builtin_amdgcn_s_sleep(1);
        if ((++sp & 255u) == 0u) { if (xb_ld(&bar[XB_TMO])) break; if (sp > XB_SPIN_CAP) { atomicAdd(&bar[XB_TMO], 1u); break; } }
    }
    nloc = mine > 0u ? mine : 1u; nx = cnt > 0u ? cnt : 1u;
}

__device__ __forceinline__ void xcd_barrier(const XcdBarrier& b) {
    asm volatile("s_waitcnt vmcnt(0)" ::: "memory");
    __syncthreads();
    if (threadIdx.x == 0) {
        unsigned* bar = b.bar;
        __builtin_amdgcn_s_waitcnt(0);
        unsigned nloc = b.st[0], nx = b.st[1];
        if (nloc == 0u) { xcd_barrier_complete(bar, b.x, nloc, nx); b.st[0] = nloc; b.st[1] = nx; }
        const unsigned old = xb_add(&bar[XB_XSUB(b.x)], 1u);
        const unsigned gen = old / nloc;
        if (old + 1u == (gen + 1u) * nloc) {
            __builtin_amdgcn_fence(__ATOMIC_RELEASE, "agent");
            asm volatile("s_waitcnt vmcnt(0)" ::: "memory");
            const unsigned og = xb_add(&bar[XB_TOP], 1u);
            const unsigned tg = og / nx;
            if (og + 1u == (tg + 1u) * nx) xb_add(&bar[XB_TOPGEN], 1u);
            else XB_SPIN(xb_ld(&bar[XB_TOPGEN]) == tg, bar);
            __builtin_amdgcn_fence(__ATOMIC_ACQUIRE, "agent");
            xb_add(&bar[XB_XGEN(b.x)], 1u);
            asm volatile("s_waitcnt vmcnt(0)" ::: "memory");
        } else {
            XB_SPIN(xb_ld(&bar[XB_XGEN(b.x)]) == gen, bar);
            __builtin_amdgcn_fence(__ATOMIC_ACQUIRE, "agent");
            asm volatile("s_waitcnt vmcnt(0)" ::: "memory");
        }
    }
    __syncthreads();
}


__device__ __forceinline__ void grid_barrier(unsigned* ctr, unsigned target) {
    asm volatile("s_waitcnt vmcnt(0) lgkmcnt(0)" ::: "memory");
    __syncthreads();
    if (threadIdx.x == 0) {
        __builtin_amdgcn_fence(__ATOMIC_RELEASE, "agent");
        asm volatile("s_waitcnt vmcnt(0)" ::: "memory");
        __hip_atomic_fetch_add(ctr, 1u, __ATOMIC_RELAXED, __HIP_MEMORY_SCOPE_AGENT);
        while (__hip_atomic_load(ctr, __ATOMIC_RELAXED, __HIP_MEMORY_SCOPE_AGENT) < target) __builtin_amdgcn_s_sleep(2);
        __builtin_amdgcn_fence(__ATOMIC_ACQUIRE, "agent");
        asm volatile("s_waitcnt vmcnt(0)" ::: "memory");
    }
    __syncthreads();
}

#ifndef DUP_ATTN
#define DUP_ATTN 0
#endif
#ifndef DUP_FFN1
#define DUP_FFN1 0
#endif
#ifndef DUP_SCAN
#define DUP_SCAN 0
#endif
constexpr int NPHASE = 35 + 2 * DUP_ATTN + 4 * DUP_FFN1 + 2 * DUP_SCAN;
enum { K_INIT = 0, K_MIXPREP, K_GEMM, K_SCAN, K_POST, K_NORMF, K_NORMSB, K_HEADNORM, K_ATTN };
struct Tab { PE e[NPHASE]; };
constexpr GD mkgd(size_t A, size_t Bt, int N, int mode, size_t o0, size_t o1, int bin, int boff, int ldo) {
    GD g{}; g.A = A; g.Bt = Bt; g.o0 = o0; g.o1 = o1; g.N = N; g.mode = mode; g.bin = bin; g.boff = boff; g.ldo = ldo; g.pad = 0; return g;
}
constexpr PE mkgemm(int layer, int sub) {
    PE p{}; p.kind = K_GEMM; p.layer = layer; p.sub = sub; p.ng = 1; p.K = D; p.pad = 0;
    const int i = layer;
    for (int q = 0; q < 4; ++q) p.g[q] = mkgd(0, 0, 256, 0, 0, 0, 0, 0, D);
    if (sub == 0) {
        p.g[0] = mkgd(OFF_MIX, OFF_WA + WA_W0, D, 0, OFF_RB, 0, 0, 0, D);
        p.g[1] = mkgd(OFF_MIX + SZB, OFF_WA + WA_W1, D, 0, OFF_KF, 0, 0, 0, D);
        p.g[2] = mkgd(OFF_MIX + 2 * SZB, OFF_WA + WA_W2, D, 0, i == 0 ? OFF_VFIRST : OFF_VF, 0, 0, 0, D);
        p.ng = 3;
    } else if (sub == 1) {
        p.g[0] = mkgd(OFF_DEC, OFF_WA + WA_L1 + 0 * WSLOT, 256, 3, OFF_LORA + 0 * SZLORA, 0, 0, 0, 256);
        p.g[1] = mkgd(OFF_DEC + SZB, OFF_WA + WA_L1 + 1 * WSLOT, 256, 0, OFF_LORA + 1 * SZLORA, 0, 0, 0, 256);
        p.g[2] = mkgd(OFF_KF, OFF_WA + WA_L1 + 2 * WSLOT, 256, 4, OFF_LORA + 2 * SZLORA, 0, 0, 0, 256);
        p.ng = 3;
        if (i >= 1) { p.g[3] = mkgd(OFF_MIX + 2 * SZB, OFF_WA + WA_L1 + 3 * WSLOT, 256, 0, OFF_LORA + 3 * SZLORA, 0, 0, 0, 256); p.ng = 4; }
    } else if (sub == 2) {
        p.K = 256;
        p.g[0] = mkgd(OFF_LORA + 0 * SZLORA, OFF_WA + WA_L2 + 0 * WSLOT, D, 5, OFF_DEC, 0, 12, i * D, D);
        p.g[1] = mkgd(OFF_LORA + 1 * SZLORA, OFF_WA + WA_L2 + 1 * WSLOT, D, 6, OFF_MIX, 0, 15, i * D, D);
        p.g[2] = mkgd(OFF_LORA + 2 * SZLORA, OFF_WA + WA_L2 + 2 * WSLOT, D, 0, OFF_MIX + SZB, 0, 0, 0, D);
        p.ng = 3;
        if (i >= 1) { p.g[3] = mkgd(OFF_LORA + 3 * SZLORA, OFF_WA + WA_L2 + 3 * WSLOT, D, 7, OFF_VF, OFF_VFIRST, 25, (i - 1) * D, D); p.ng = 4; }
    } else if (sub == 3) {
        p.g[0] = mkgd(OFF_MIX + 2 * SZB, OFF_WB + WB_WO, D, 8, 0, 0, 0, 0, D);
    } else if (sub == 4) {
        p.g[0] = mkgd(OFF_HN2, OFF_WB + WB_F1, 2 * FF, 9, OFF_ACT, 0, 0, 0, FF);
    } else if (sub == 5) {
        p.K = FF;
        p.g[0] = mkgd(OFF_ACT, OFF_WB + WB_F2, D, 8, 0, 0, 0, 0, D);
    } else if (sub == 6) {
        p.g[0] = mkgd(OFF_MIX, OFF_WA + WA_W0, D, 0, OFF_RB, 0, 0, 0, D);
        if (layer == 2) {
            p.g[1] = mkgd(OFF_MIX + SZB, OFF_WA + WA_W1, D, 0, OFF_KF, 0, 0, 0, D);
            p.g[2] = mkgd(OFF_MIX + SZB, OFF_WA + WA_W2, D, 0, OFF_VF, 0, 0, 0, D);
            p.ng = 3;
        }
    } else {
        p.g[0] = mkgd(OFF_MIX, OFF_WB + WB_WO, D, 8, 0, 0, 0, 0, D);
    }
    return p;
}
constexpr PE mkother(int kind, int layer, int sub) { PE p{}; p.kind = kind; p.layer = layer; p.sub = sub; p.ng = 0; p.K = D; p.pad = 0; for (int q = 0; q < 4; ++q) p.g[q] = mkgd(0, 0, 256, 0, 0, 0, 0, 0, D); return p; }
constexpr Tab make_tab() {
    Tab t{};
    int n = 0;
    for (int i = 0; i < 2; ++i) {
        t.e[n++] = mkother(K_MIXPREP, i, 0);
        t.e[n++] = mkgemm(i, 1);
        t.e[n++] = mkgemm(i, 0);
        t.e[n++] = mkgemm(i, 2);
        t.e[n++] = mkother(K_SCAN, i, 0);
        if (DUP_SCAN) t.e[n++] = mkother(K_SCAN, i, 0);
        t.e[n++] = mkother(K_POST, i, 0);
        t.e[n++] = mkgemm(i, 3);
        t.e[n++] = mkother(K_NORMF, i, 0);
        t.e[n++] = mkgemm(i, 4);
        if (DUP_FFN1) t.e[n++] = mkgemm(i, 4);
        t.e[n++] = mkgemm(i, 5);
    }
    for (int j = 0; j < 2; ++j) {
        const int layer = 2 + j;
        t.e[n++] = mkother(K_NORMSB, layer, 0);
        t.e[n++] = mkgemm(layer, 6);
        if (j == 0) t.e[n++] = mkother(K_HEADNORM, layer, 0);
        t.e[n++] = mkother(K_ATTN, layer, 0);
        if (DUP_ATTN) t.e[n++] = mkother(K_ATTN, layer, 0);
        t.e[n++] = mkgemm(layer, 7);
        t.e[n++] = mkother(K_NORMF, layer, 0);
        t.e[n++] = mkgemm(layer, 4);
        if (DUP_FFN1) t.e[n++] = mkgemm(layer, 4);
        t.e[n++] = mkgemm(layer, 5);
    }
    return t;
}
__constant__ const Tab TAB = make_tab();

#ifndef ONLY
#define ONLY -1
#endif
#define EN(k) (ONLY < 0 || ONLY == (k))

__global__ void __launch_bounds__(512, 2) mk_forward(Params P, int ph_lo, int ph_hi) {
    extern __shared__ __attribute__((aligned(16))) unsigned char shm[];
    LAS unsigned char* lds = (LAS unsigned char*)shm;
    cg::grid_group grid = cg::this_grid();
    __shared__ uint4 xb_words;
    if (threadIdx.x == 0) xb_words = make_uint4(0u, 0u, 0u, 0u);
    unsigned* const xbar = (unsigned*)(P.ws + WS_END);
    XcdBarrier xb; xb.bar = xbar; xb.x = 0; xb.st = (volatile LAS unsigned*)&xb_words;
    for (int ph = ph_lo; ph < ph_hi; ++ph) {
        const PE* pe = &TAB.e[ph];
        const int kind = pe->kind, layer = pe->layer, sub = pe->sub;
        if (kind == K_GEMM) { if (EN(K_GEMM)) {
            const bool tail_first = (blockIdx.x & 1) != 0;
            if (tail_first) { tail_gemm(lds, pe, P); __syncthreads(); }
            gemm_phase(lds, pe, P);
            if (!tail_first) tail_gemm(lds, pe, P); } }
        else if (!EN(kind)) {}
        else if (kind == K_MIXPREP) { mixprep_phase(P, layer); convert_layer(P, layer, lds); }
        else if (kind == K_SCAN) scan_phase(P, layer, lds);
        else if (kind == K_POST) post_phase(P, layer);
        else if (kind == K_NORMF) norm_phase(P, P.in[3] + (size_t)layer * D, (bf16_t*)(P.ws + OFF_HN2), nullptr, nullptr);
        else if (kind == K_NORMSB) {
            norm_phase(P, P.in[2] + (size_t)layer * D, (bf16_t*)(P.ws + OFF_MIX), layer == 2 ? P.in[28] : nullptr, (bf16_t*)(P.ws + OFF_MIX + SZB));
            convert_layer(P, layer, lds);
        }
        else if (kind == K_HEADNORM) { if (layer == 2) headnorm_phase(P, lds); }
        else if (kind == K_ATTN) attn_phase(P, layer - 2, lds);
        if (ph + 1 < ph_hi) {
#ifdef USE_CG_SYNC
            grid.sync();
#else
            if (ph == ph_lo) {
                if (blockIdx.x == 0) for (int q = threadIdx.x; q < XCD_BAR_WORDS; q += NTHR) __hip_atomic_store(xbar + q, 0u, __ATOMIC_RELAXED, __HIP_MEMORY_SCOPE_AGENT);
                grid.sync();
                xb = xcd_barrier_post(xbar, (volatile LAS unsigned*)&xb_words);
            }
            else xcd_barrier(xb);
#endif
        }
    }
}

__global__ void dbg_copy(Params P, size_t off_bf16a, size_t off_bf16b, size_t off_f32) {
    const size_t n = (size_t)MMAIN * D;
    for (size_t i = (size_t)blockIdx.x * blockDim.x + threadIdx.x; i < n; i += (size_t)gridDim.x * blockDim.x) {
        float v = 0.f;
        if (off_bf16a) v += __uint_as_float(((unsigned)((const bf16_t*)(P.ws + off_bf16a))[i]) << 16);
        if (off_bf16b) v += __uint_as_float(((unsigned)((const bf16_t*)(P.ws + off_bf16b))[i]) << 16);
        if (off_f32) v += ((const float*)(P.ws + off_f32))[i];
        P.out[i] = v;
    }
}
extern "C" void kernel_launch(void* const* d_in, const int* in_sizes, int n_in, void* d_out, int out_size, void* d_ws, size_t ws_size, hipStream_t stream) {
    constexpr size_t kDynLds = 131072;
    static int grid_blocks = 0;
    if (!grid_blocks) {
        hipFuncSetAttribute((const void*)mk_forward, hipFuncAttributeMaxDynamicSharedMemorySize, (int)kDynLds);
        int dev = 0, cus = 0, per_cu = 0;
        hipGetDevice(&dev);
        hipDeviceGetAttribute(&cus, hipDeviceAttributeMultiprocessorCount, dev);
        hipOccupancyMaxActiveBlocksPerMultiprocessor(&per_cu, mk_forward, NTHR, kDynLds);
        if (per_cu < 1) per_cu = 1;
        grid_blocks = cus * per_cu;
        if (ws_size < WS_END) fprintf(stderr, "workspace too small: %zu < %zu\n", ws_size, (size_t)WS_END);
    }
    Params p{};
    for (int i = 0; i < 35; ++i) p.in[i] = (const float*)d_in[i];
    p.out = (float*)d_out; p.ws = (unsigned char*)d_ws;
#ifdef MULTI_LAUNCH
    for (int ph = 0; ph < NPHASE; ++ph) hipLaunchKernelGGL(mk_forward, dim3(grid_blocks), dim3(NTHR), kDynLds, stream, p, ph, ph + 1);
#ifdef DBG_A
    hipLaunchKernelGGL(dbg_copy, dim3(2048), dim3(256), 0, stream, p, (size_t)DBG_A, (size_t)DBG_B, (size_t)DBG_F);
#endif
#else
    int lo = 0, hi = NPHASE;
    void* args[] = {&p, &lo, &hi};
    hipError_t e = hipLaunchCooperativeKernel((void*)mk_forward, dim3(grid_blocks), dim3(NTHR), args, kDynLds, stream);
    if (e != hipSuccess) fprintf(stderr, "cooperative launch failed: %s (grid %d)\n", hipGetErrorString(e), grid_blocks);
#endif
}
```

```cpp
#include <hip/hip_runtime.h>
#include <hip/hip_cooperative_groups.h>
#include <cstdio>
namespace cg = cooperative_groups;

#define LAS __attribute__((address_space(3)))
typedef unsigned short bf16_t;
typedef short bf16x8 __attribute__((ext_vector_type(8)));
typedef float f32x4 __attribute__((ext_vector_type(4)));
typedef unsigned u32x2 __attribute__((ext_vector_type(2)));
typedef unsigned u32x4 __attribute__((ext_vector_type(4)));

constexpr int D = 2048, FF = 5632, NBATCH = 4, SEQ = 4096, NMETA = 16, L = SEQ + NMETA;
constexpr int M = NBATCH * L;
constexpr int MMAIN = NBATCH * SEQ;
constexpr int MP = 16640;
constexpr int NTHR = 512;
constexpr int PPAD = 112, PLEN = 4224;

constexpr size_t SZB = (size_t)MP * D * 2, SZF = 2 * SZB;
constexpr size_t OFF_WA = 0;
constexpr size_t OFF_WB = 37748736;
constexpr size_t OFF_HT = OFF_WB + 83886080;
constexpr size_t OFF_RB = OFF_HT + 1048576;
constexpr size_t OFF_VFIRST = OFF_RB + SZB;
constexpr size_t OFF_KF = OFF_VFIRST + SZB;
constexpr size_t OFF_VF = OFF_KF + SZF;
constexpr size_t OFF_DEC = OFF_VF + SZF;
constexpr size_t OFF_MIX = OFF_DEC + SZF;
constexpr size_t OFF_LORA = OFF_MIX + 3 * SZB;
constexpr size_t SZLORA = (size_t)MP * 256 * 2;
constexpr size_t WS_END = OFF_LORA + 4 * SZLORA;
constexpr size_t OFF_HN2 = OFF_KF, OFF_ACT = OFF_KF + SZB;
constexpr size_t WA_W0 = 0, WA_W1 = 8388608, WA_W2 = 16777216, WA_L1 = 25165824, WA_L2 = 29360128, WSLOT = 1048576;
constexpr size_t WB_WO = 0, WB_F1 = 8388608, WB_F2 = WB_F1 + (size_t)2 * FF * D * 2;

struct Params {
    const float* in[35];
    float* out;
    unsigned char* ws;
};

__device__ __forceinline__ int rowof(int b, int t) { return t < NMETA ? MMAIN + b * NMETA + t : b * SEQ + (t - NMETA); }
__device__ __forceinline__ float* hrow(const Params& P, int r) {
    return r < MMAIN ? P.out + (size_t)r * D : (float*)(P.ws + OFF_HT) + (size_t)(r - MMAIN) * D;
}
__device__ __forceinline__ unsigned cvt_pk_bf16(float lo, float hi) { unsigned r; asm volatile("v_cvt_pk_bf16_f32 %0, %1, %2" : "=v"(r) : "v"(lo), "v"(hi)); return r; }
__device__ __forceinline__ float bf_lo(unsigned x) { return __uint_as_float(x << 16); }
__device__ __forceinline__ float bf_hi(unsigned x) { return __uint_as_float(x & 0xffff0000u); }
template <int CTRL> __device__ __forceinline__ float dpp_mov(float x) {
    return __int_as_float(__builtin_amdgcn_update_dpp(0, __float_as_int(x), CTRL, 0xF, 0xF, true));
}
__device__ __forceinline__ float rowsum16(float x) {
    x += dpp_mov<0x128>(x); x += dpp_mov<0x124>(x); x += dpp_mov<0x122>(x); x += dpp_mov<0x121>(x); return x;
}
__device__ __forceinline__ float wavesum(float x) { x = rowsum16(x); x += __shfl_xor(x, 16); x += __shfl_xor(x, 32); return x; }
__device__ __forceinline__ int otid() { int t = threadIdx.x; asm volatile("" : "+v"(t)); return t; }
__device__ __forceinline__ int obid() { int t = blockIdx.x; asm volatile("" : "+s"(t)); return t; }
__device__ __forceinline__ float sigmoidf_(float x) { return 1.0f / (1.0f + __expf(-x)); }

constexpr int BM = 256, BK = 64, HALF = 128, HTB = HALF * BK * 2, NXCD = 8, WGM = 8, NMT = MMAIN / BM;
__device__ __forceinline__ int lds_byte(int r, int c) { const int st = (r >> 4) * 2 + (c >> 5), rr = r & 15, cc = c & 31, ob = rr * 64 + cc * 2; return st * 1024 + (ob ^ (((ob >> 9) & 1) << 5)); }
__device__ __forceinline__ void stage_rc(int b, int& R, int& C) { const int st = b / 1024, sb = b % 1024, swz = sb ^ (((sb >> 9) & 1) << 5); R = (st >> 1) * 16 + swz / 64; C = (st & 1) * 32 + (swz % 64) / 2; }

struct GD { unsigned long long A, Bt, o0, o1; int N, mode, bin, boff, ldo, pad; };
struct PE { int kind, layer, sub, ng, K, pad; GD g[4]; };
struct Unit { int pm, pn, gi; };

__device__ __forceinline__ bool sched_next(const int Lx, const int c1, const int c2, const int c3, const int c4, Unit& u) {
    if (Lx >= c4) return false;
    int gi = 0, base = 0, top = c1;
    if (Lx >= c1) { gi = 1; base = c1; top = c2; }
    if (Lx >= c2) { gi = 2; base = c2; top = c3; }
    if (Lx >= c3) { gi = 3; base = c3; top = c4; }
    const int nM = NMT, nwg = top - base, nN = nwg / NMT;
    int wgid = Lx - base; { const int q = nwg / NXCD, r = nwg % NXCD, xcd = wgid % NXCD, off = wgid / NXCD; wgid = (xcd < r ? xcd * (q + 1) : r * (q + 1) + (xcd - r) * q) + off; }
    const int nig = WGM * nN, gid = wgid / nig, fm = gid * WGM, gsz = (nM - fm) < WGM ? (nM - fm) : WGM;
    u.pm = fm + ((wgid % nig) % gsz); u.pn = (wgid % nig) / gsz; u.gi = gi; return true;
}

template <int MODE>
__device__ __forceinline__ void epi_elem(const int r, const int c, f32x4 v, void* g_o0, void* g_o1, const f32x4 bv, const int ldo, float* outp, float* htp) {
    if constexpr (MODE == 8) {
        float* p = (r < MMAIN ? outp + (size_t)r * D : htp + (size_t)(r - MMAIN) * D) + c; f32x4 hv = *(f32x4*)p; *(f32x4*)p = hv + v;
    } else if constexpr (MODE == 1) {
        *(f32x4*)((float*)g_o0 + (size_t)r * ldo + c) = v;
    } else if constexpr (MODE == 2) {
        *(f32x4*)((float*)g_o0 + (size_t)r * ldo + c) = v;
        u32x2 wv; wv.x = cvt_pk_bf16(v[0], v[1]); wv.y = cvt_pk_bf16(v[2], v[3]);
        *(u32x2*)((bf16_t*)g_o1 + (size_t)r * ldo + c) = wv;
    } else if constexpr (MODE == 5) {
        f32x4 o;
#pragma unroll
        for (int e = 0; e < 4; ++e) { const float x = -(bv[e] + v[e]); const float sp = fmaxf(x, 0.f) + __logf(1.0f + __expf(-fabsf(x))); const float wl = -sp - 0.5f; o[e] = __expf(-__expf(wl)); }
        *(f32x4*)((float*)g_o0 + (size_t)r * ldo + c) = o;
    } else if constexpr (MODE == 7) {
        bf16_t* vp = (bf16_t*)g_o0 + (size_t)r * ldo + c; const u32x2 vr_ = *(const u32x2*)vp; f32x4 vv; vv[0] = bf_lo(vr_.x); vv[1] = bf_hi(vr_.x); vv[2] = bf_lo(vr_.y); vv[3] = bf_hi(vr_.y);
        const u32x2 vf = *(const u32x2*)((const bf16_t*)g_o1 + (size_t)r * ldo + c);
        const float f0 = bf_lo(vf.x), f1 = bf_hi(vf.x), f2 = bf_lo(vf.y), f3 = bf_hi(vf.y);
        f32x4 o;
        o[0] = vv[0] + (f0 - vv[0]) * sigmoidf_(bv[0] + v[0]); o[1] = vv[1] + (f1 - vv[1]) * sigmoidf_(bv[1] + v[1]);
        o[2] = vv[2] + (f2 - vv[2]) * sigmoidf_(bv[2] + v[2]); o[3] = vv[3] + (f3 - vv[3]) * sigmoidf_(bv[3] + v[3]);
        u32x2 ow; ow.x = cvt_pk_bf16(o[0], o[1]); ow.y = cvt_pk_bf16(o[2], o[3]); *(u32x2*)vp = ow;
    } else {
        if constexpr (MODE == 3) {
#pragma unroll
            for (int e = 0; e < 4; ++e) { const float ax = fminf(fabsf(v[e]), 15.0f); const float t = 1.0f - 2.0f / (__expf(2.0f * ax) + 1.0f); v[e] = v[e] < 0.f ? -t : t; } }
        else if constexpr (MODE == 4) { v[0] = sigmoidf_(v[0]); v[1] = sigmoidf_(v[1]); v[2] = sigmoidf_(v[2]); v[3] = sigmoidf_(v[3]); }
        else if constexpr (MODE == 6) { v[0] = sigmoidf_(bv[0] + v[0]); v[1] = sigmoidf_(bv[1] + v[1]); v[2] = sigmoidf_(bv[2] + v[2]); v[3] = sigmoidf_(bv[3] + v[3]); }
        u32x2 wv; wv.x = cvt_pk_bf16(v[0], v[1]); wv.y = cvt_pk_bf16(v[2], v[3]);
        *(u32x2*)((bf16_t*)g_o0 + (size_t)r * ldo + c) = wv;
    }
}
__device__ __forceinline__ void epi_swiglu(const int r, const int oc, const f32x4 g, const f32x4 up, void* g_o0, const int ldo) {
    float o[4];
#pragma unroll
    for (int e = 0; e < 4; ++e) o[e] = g[e] * __builtin_amdgcn_rcpf(1.0f + __expf(-g[e])) * up[e];
    u32x2 wv; wv.x = cvt_pk_bf16(o[0], o[1]); wv.y = cvt_pk_bf16(o[2], o[3]);
    *(u32x2*)((bf16_t*)g_o0 + (size_t)r * ldo + oc) = wv;
}
template <int MODE>
__device__ __forceinline__ void epi_t(const f32x4 (&acc)[2][2][4][2], void* g_o0, void* g_o1, const float* g_bias, const int ldo, const int u_pm, const int u_pn, int wr, int wc, int fr, int fq, float* outp, float* htp) {
    const int row0 = u_pm * BM + wr * 64 + fr, col0 = u_pn * BM + wc * 32 + 4 * fq;
    f32x4 bvv[2][2];
#pragma unroll
    for (int bj = 0; bj < 2; ++bj)
#pragma unroll
        for (int n = 0; n < 2; ++n) bvv[bj][n] = (MODE == 5 || MODE == 6 || MODE == 7) ? *(const f32x4*)(g_bias + col0 + bj * HALF + n * 16) : (f32x4){0.f, 0.f, 0.f, 0.f};
    if constexpr (MODE == 7) {
#pragma unroll
        for (int ai = 0; ai < 2; ++ai) {
#pragma unroll
            for (int mh = 0; mh < 2; ++mh) {
                f32x4 vv[2][2][2]; u32x2 vf[2][2][2];
#pragma unroll
                for (int ml = 0; ml < 2; ++ml) { const size_t o = (size_t)(row0 + ai * HALF + (2 * mh + ml) * 16) * ldo + col0;
#pragma unroll
                    for (int bj = 0; bj < 2; ++bj)
#pragma unroll
                        for (int n = 0; n < 2; ++n) { const u32x2 vr_ = *(const u32x2*)((const bf16_t*)g_o0 + o + bj * HALF + n * 16);
                            vv[ml][bj][n][0] = bf_lo(vr_.x); vv[ml][bj][n][1] = bf_hi(vr_.x); vv[ml][bj][n][2] = bf_lo(vr_.y); vv[ml][bj][n][3] = bf_hi(vr_.y);
                            vf[ml][bj][n] = *(const u32x2*)((const bf16_t*)g_o1 + o + bj * HALF + n * 16); } }
#pragma unroll
                for (int ml = 0; ml < 2; ++ml) { const size_t o = (size_t)(row0 + ai * HALF + (2 * mh + ml) * 16) * ldo + col0;
#pragma unroll
                    for (int bj = 0; bj < 2; ++bj)
#pragma unroll
                        for (int n = 0; n < 2; ++n) { const f32x4 a = acc[ai][bj][2 * mh + ml][n], x = vv[ml][bj][n], bb = bvv[bj][n]; const u32x2 f = vf[ml][bj][n];
                            f32x4 ov;
                            ov[0] = x[0] + (bf_lo(f.x) - x[0]) * sigmoidf_(bb[0] + a[0]); ov[1] = x[1] + (bf_hi(f.x) - x[1]) * sigmoidf_(bb[1] + a[1]);
                            ov[2] = x[2] + (bf_lo(f.y) - x[2]) * sigmoidf_(bb[2] + a[2]); ov[3] = x[3] + (bf_hi(f.y) - x[3]) * sigmoidf_(bb[3] + a[3]);
                            u32x2 ow; ow.x = cvt_pk_bf16(ov[0], ov[1]); ow.y = cvt_pk_bf16(ov[2], ov[3]);
                            *(u32x2*)((bf16_t*)g_o0 + o + bj * HALF + n * 16) = ow; } }
            }
        }
        return;
    }
    if constexpr (MODE == 8) {
#pragma unroll
        for (int ai = 0; ai < 2; ++ai) {
            f32x4 hv[4][2][2];
#pragma unroll
            for (int m = 0; m < 4; ++m) { const int r = row0 + ai * HALF + m * 16; float* p = (r < MMAIN ? outp + (size_t)r * D : htp + (size_t)(r - MMAIN) * D) + col0;
#pragma unroll
                for (int bj = 0; bj < 2; ++bj)
#pragma unroll
                    for (int n = 0; n < 2; ++n) hv[m][bj][n] = *(const f32x4*)(p + bj * HALF + n * 16); }
#pragma unroll
            for (int m = 0; m < 4; ++m) { const int r = row0 + ai * HALF + m * 16; float* p = (r < MMAIN ? outp + (size_t)r * D : htp + (size_t)(r - MMAIN) * D) + col0;
#pragma unroll
                for (int bj = 0; bj < 2; ++bj)
#pragma unroll
                    for (int n = 0; n < 2; ++n) *(f32x4*)(p + bj * HALF + n * 16) = hv[m][bj][n] + acc[ai][bj][m][n]; }
        }
        return;
    }
#pragma unroll
    for (int ai = 0; ai < 2; ++ai) {
#pragma unroll
        for (int m = 0; m < 4; ++m) {
            const int r = row0 + ai * HALF + m * 16;
            if constexpr (MODE == 9) {
#pragma unroll
                for (int bj = 0; bj < 2; ++bj)
                    epi_swiglu(r, 16 * (u_pn * 8 + bj * 4 + wc) + 4 * fq, acc[ai][bj][m][0], acc[ai][bj][m][1], g_o0, ldo);
            } else if constexpr (MODE == 8 || MODE == 7) {
            } else {
#pragma unroll
                for (int bj = 0; bj < 2; ++bj) {
#pragma unroll
                    for (int n = 0; n < 2; ++n)
                        epi_elem<MODE>(r, col0 + bj * HALF + n * 16, acc[ai][bj][m][n], g_o0, g_o1, bvv[bj][n], ldo, outp, htp);
                }
            }
        }
    }
}
#define EPI_CALL(MD) epi_t<MD>(acc, g_o0, g_o1, g_bias, ldo, u_pm, u_pn, wr, wc, fr, fq, outp, htp)
__device__ __forceinline__ void epilogue(const f32x4 (&acc)[2][2][4][2], const int mode, void* g_o0, void* g_o1, const float* g_bias, const int ldo, const int u_pm, const int u_pn, int wr, int wc, int fr, int fq, float* outp, float* htp) {
    switch (mode) {
        case 0: EPI_CALL(0); break;
        case 1: EPI_CALL(1); break;
        case 2: EPI_CALL(2); break;
        case 3: EPI_CALL(3); break;
        case 4: EPI_CALL(4); break;
        case 5: EPI_CALL(5); break;
        case 6: EPI_CALL(6); break;
        case 7: EPI_CALL(7); break;
        case 8: EPI_CALL(8); break;
        default: EPI_CALL(9); break;
    }
}

__device__ __forceinline__ void gemm_phase(LAS unsigned char* lds, const PE* pe, const Params& P) {
    const int tid = threadIdx.x, wid = __builtin_amdgcn_readfirstlane(tid >> 6), lane = tid & 63, wr = wid >> 2, wc = wid & 3, fr = lane & 15, fq = lane >> 4;
    const int K = pe->K, nt = K / BK;
    const int sG = (int)gridDim.x, sC = (int)blockIdx.x, s_ng = pe->ng;
    const int sc1 = NMT * (pe->g[0].N / BM);
    const int sc2 = sc1 + (s_ng > 1 ? NMT * (pe->g[1].N / BM) : 0);
    const int sc3 = sc2 + (s_ng > 2 ? NMT * (pe->g[2].N / BM) : 0);
    const int sc4 = sc3 + (s_ng > 3 ? NMT * (pe->g[3].N / BM) : 0);
    unsigned char* const ws = P.ws;
    unsigned voff[2];
#pragma unroll
    for (int i = 0; i < 2; ++i) { int R, C; stage_rc(tid * 16 + i * 8192, R, C); voff[i] = (unsigned)(R * K + C) * 2u; }
    const size_t kstep = (size_t)(BK * 2);
    const size_t hstep = (size_t)HALF * K * 2;
    const size_t tstep = 2 * hstep;
    const unsigned ldsw = (unsigned)wid * 1024u;
    const int aoff = lds_byte(wr * 64 + fr, fq * 8), boff = lds_byte(wc * 32 + fr, fq * 8);
#define PG8_SA(b, h) (((b) * 2 + (h)) * HTB)
#define PG8_SB(b, h) ((4 + (b) * 2 + (h)) * HTB)
#define PG8_STAGE(bufoff, gbase) do { _Pragma("unroll") for (int _i = 0; _i < 2; ++_i) \
        __builtin_amdgcn_global_load_lds((const unsigned*)((const char*)(gbase) + voff[_i]), (LAS unsigned*)(lds + (bufoff) + ldsw + _i * 8192), 16, 0, 0); } while (0)
#define PG8_LDA(dst, b, h) do { _Pragma("unroll") for (int m = 0; m < 4; ++m) _Pragma("unroll") for (int k = 0; k < 2; ++k) dst[m][k] = *(const LAS bf16x8*)(lds + PG8_SA(b, h) + aoff + m * 2048 + k * 1024); } while (0)
#define PG8_LDB(dst, b, h) do { _Pragma("unroll") for (int n = 0; n < 2; ++n) _Pragma("unroll") for (int k = 0; k < 2; ++k) dst[n][k] = *(const LAS bf16x8*)(lds + PG8_SB(b, h) + boff + n * 2048 + k * 1024); } while (0)
#define PG8_MMA(ai, bj, At, Bt) do { __builtin_amdgcn_s_setprio(1); _Pragma("unroll") for (int m = 0; m < 4; ++m) _Pragma("unroll") for (int n = 0; n < 2; ++n) _Pragma("unroll") for (int k = 0; k < 2; ++k) \
        acc[ai][bj][m][n] = __builtin_amdgcn_mfma_f32_16x16x32_bf16(Bt[n][k], At[m][k], acc[ai][bj][m][n], 0, 0, 0); __builtin_amdgcn_s_setprio(0); } while (0)
#define PG8_WAIT_V(n) asm volatile("s_waitcnt vmcnt(" #n ")" ::: "memory")
#define PG8_WAIT_L(n) asm volatile("s_waitcnt lgkmcnt(" #n ")" ::: "memory")
#define PG8_BAR __builtin_amdgcn_s_barrier()
#define PG8_SCHED __builtin_amdgcn_sched_barrier(0)
    Unit cur, nxt; int ui = 0;
    if (!sched_next(sC, sc1, sc2, sc3, sc4, cur)) return;
    f32x4 acc[2][2][4][2];
#pragma unroll
    for (int a = 0; a < 2; ++a)
#pragma unroll
        for (int b = 0; b < 2; ++b)
#pragma unroll
            for (int m = 0; m < 4; ++m)
#pragma unroll
                for (int n = 0; n < 2; ++n) acc[a][b][m][n] = (f32x4){0.f, 0.f, 0.f, 0.f};
    bf16x8 At[4][2], B0[2][2], B1[2][2];
    const char* cA = (const char*)ws + pe->g[cur.gi].A + (size_t)cur.pm * tstep; const char* cB = (const char*)ws + pe->g[cur.gi].Bt + (size_t)cur.pn * tstep;
    PG8_STAGE(PG8_SB(0, 0), cB); PG8_STAGE(PG8_SA(0, 0), cA); PG8_STAGE(PG8_SB(0, 1), cB + hstep); PG8_STAGE(PG8_SA(0, 1), cA + hstep);
    if (wr == 1) PG8_BAR;
    PG8_WAIT_V(4); PG8_BAR;
    PG8_STAGE(PG8_SB(1, 0), cB + kstep); PG8_STAGE(PG8_SA(1, 0), cA + kstep); PG8_STAGE(PG8_SB(1, 1), cB + hstep + kstep);
    PG8_WAIT_V(6); PG8_BAR;
    for (;;) {
        const bool has_next = sched_next((ui + 1) * sG + sC, sc1, sc2, sc3, sc4, nxt);
        const char* nA = cA; const char* nB = cB;
        if (has_next) { nA = (const char*)ws + pe->g[nxt.gi].A + (size_t)nxt.pm * tstep; nB = (const char*)ws + pe->g[nxt.gi].Bt + (size_t)nxt.pn * tstep; }
        for (int t = 0; t < nt; t += 2) {
            const bool last = (t == nt - 2);
            const char* a1 = cA + (size_t)(t + 1) * kstep;
            const char* a2 = last ? nA : cA + (size_t)(t + 2) * kstep; const char* b2 = last ? nB : cB + (size_t)(t + 2) * kstep;
            const char* a3 = a2 + kstep; const char* b3 = b2 + kstep;
            PG8_LDB(B0, 0, 0); PG8_SCHED; PG8_LDA(At, 0, 0); PG8_STAGE(PG8_SA(1, 1), a1 + hstep);
            PG8_WAIT_L(8); PG8_BAR; PG8_WAIT_L(0); PG8_MMA(0, 0, At, B0); PG8_BAR; PG8_SCHED;
            PG8_LDB(B1, 0, 1); PG8_STAGE(PG8_SB(0, 0), b2);
            PG8_BAR; PG8_WAIT_L(0); PG8_MMA(0, 1, At, B1); PG8_BAR;
            PG8_LDA(At, 0, 1); PG8_STAGE(PG8_SA(0, 0), a2);
            PG8_BAR; PG8_WAIT_L(0); PG8_MMA(1, 0, At, B0); PG8_BAR; PG8_SCHED;
            PG8_STAGE(PG8_SB(0, 1), b2 + hstep);
            PG8_WAIT_V(6); PG8_BAR; PG8_MMA(1, 1, At, B1); PG8_BAR;
            PG8_LDB(B0, 1, 0); PG8_SCHED; PG8_LDA(At, 1, 0); PG8_STAGE(PG8_SA(0, 1), a2 + hstep);
            PG8_WAIT_L(8); PG8_BAR; PG8_WAIT_L(0); PG8_MMA(0, 0, At, B0); PG8_BAR; PG8_SCHED;
            PG8_LDB(B1, 1, 1); PG8_STAGE(PG8_SB(1, 0), b3);
            PG8_BAR; PG8_WAIT_L(0); PG8_MMA(0, 1, At, B1); PG8_BAR;
            PG8_LDA(At, 1, 1); PG8_STAGE(PG8_SA(1, 0), a3);
            PG8_BAR; PG8_WAIT_L(0); PG8_MMA(1, 0, At, B0); PG8_BAR; PG8_SCHED;
            PG8_STAGE(PG8_SB(1, 1), b3 + hstep);
            PG8_WAIT_V(6); PG8_BAR; PG8_MMA(1, 1, At, B1); PG8_BAR;
        }
        { const GD* gd = &pe->g[cur.gi];
          epilogue(acc, gd->mode, ws + gd->o0, ws + gd->o1, P.in[gd->bin] + gd->boff, gd->ldo, cur.pm, cur.pn, wr, wc, fr, fq, P.out, (float*)(ws + OFF_HT)); }
        if (!has_next) break;
#pragma unroll
        for (int a = 0; a < 2; ++a)
#pragma unroll
            for (int b = 0; b < 2; ++b)
#pragma unroll
                for (int m = 0; m < 4; ++m)
#pragma unroll
                    for (int n = 0; n < 2; ++n) acc[a][b][m][n] = (f32x4){0.f, 0.f, 0.f, 0.f};
        cur = nxt; cA = nA; cB = nB; ++ui;
    }
    PG8_WAIT_V(0);
    if (wr == 0) PG8_BAR;
    PG8_BAR;
#undef PG8_SA
#undef PG8_SB
#undef PG8_STAGE
#undef PG8_LDA
#undef PG8_LDB
#undef PG8_MMA
#undef PG8_WAIT_V
#undef PG8_WAIT_L
#undef PG8_BAR
#undef PG8_SCHED
}

#define TE_CALL(MD) epi_elem<MD>(r, c, v, o0, o1, bvt, ldo, P.out, (float*)(ws + OFF_HT))
__device__ void tail_gemm(LAS unsigned char* lds, const PE* pe, const Params& P) {
    const int tid = otid(), w = tid >> 6, lane = tid & 63, fr = lane & 15, fq = lane >> 4;
    unsigned char* const ws = P.ws;
    const int K = pe->K, ks = K >> 3, nstep = ks >> 5, ng = pe->ng;
    const int t1 = pe->g[0].N >> 4;
    const int t2 = t1 + (ng > 1 ? pe->g[1].N >> 4 : 0);
    const int t3 = t2 + (ng > 2 ? pe->g[2].N >> 4 : 0);
    const int t4 = t3 + (ng > 3 ? pe->g[3].N >> 4 : 0);
    LAS f32x4* part = (LAS f32x4*)lds;
    const int bid_ = obid();
    const int rank_ = (bid_ & 1) ? (bid_ >> 1) : ((int)(gridDim.x >> 1) + (bid_ >> 1));
    for (int item = rank_; item < t4; item += gridDim.x) {
        int gi = 0, base = 0;
        if (item >= t1) { gi = 1; base = t1; }
        if (item >= t2) { gi = 2; base = t2; }
        if (item >= t3) { gi = 3; base = t3; }
        const int cb = (item - base) >> 1, mh = (item - base) & 1;
        const GD* gd = &pe->g[gi];
        const bf16_t* A = (const bf16_t*)(ws + gd->A) + (size_t)(MMAIN + 32 * mh + fr) * K + (size_t)w * ks + 8 * fq;
        const bf16_t* Bt = (const bf16_t*)(ws + gd->Bt) + (size_t)(32 * cb + fr) * K + (size_t)w * ks + 8 * fq;
        const size_t r16 = (size_t)16 * K;
        f32x4 acc[2][2];
#pragma unroll
        for (int m = 0; m < 2; ++m) { acc[m][0] = (f32x4){0.f, 0.f, 0.f, 0.f}; acc[m][1] = acc[m][0]; }
        for (int s0 = 0; s0 < nstep; s0 += 8) {
            bf16x8 af[8][2], bfr[8][2];
#pragma unroll
            for (int s = 0; s < 8; ++s) if (s0 + s < nstep) {
                const int k0 = (s0 + s) * 32;
                af[s][0] = *(const bf16x8*)(A + k0); af[s][1] = *(const bf16x8*)(A + r16 + k0);
                bfr[s][0] = *(const bf16x8*)(Bt + k0); bfr[s][1] = *(const bf16x8*)(Bt + r16 + k0);
            }
#pragma unroll
            for (int s = 0; s < 8; ++s) if (s0 + s < nstep) {
#pragma unroll
                for (int m = 0; m < 2; ++m)
#pragma unroll
                    for (int nb = 0; nb < 2; ++nb) acc[m][nb] = __builtin_amdgcn_mfma_f32_16x16x32_bf16(bfr[s][nb], af[s][m], acc[m][nb], 0, 0, 0);
            }
        }
        __syncthreads();
#pragma unroll
        for (int m = 0; m < 2; ++m)
#pragma unroll
            for (int nb = 0; nb < 2; ++nb) part[(w * 4 + m * 2 + nb) * 64 + lane] = acc[m][nb];
        __syncthreads();
        if (tid < 256) {
            const int ml = tid >> 7, nb2 = (tid >> 6) & 1;
            f32x4 v = part[(ml * 2 + nb2) * 64 + lane];
#pragma unroll
            for (int x = 1; x < 8; ++x) v += part[(x * 4 + ml * 2 + nb2) * 64 + lane];
            const int r = MMAIN + 32 * mh + 16 * ml + fr, c = 32 * cb + 16 * nb2 + 4 * fq;
            const int mode = gd->mode, ldo = gd->ldo;
            void* o0 = ws + gd->o0; void* o1 = ws + gd->o1; const float* bias = P.in[gd->bin] + gd->boff;
            const f32x4 bvt = (mode == 5 || mode == 6 || mode == 7) ? *(const f32x4*)(bias + c) : (f32x4){0.f, 0.f, 0.f, 0.f};
            if (mode == 9) {
                if (nb2 == 0) { f32x4 up = part[(ml * 2 + 1) * 64 + lane];
#pragma unroll
                    for (int x = 1; x < 8; ++x) up += part[(x * 4 + ml * 2 + 1) * 64 + lane];
                    epi_swiglu(r, 16 * cb + 4 * fq, v, up, o0, ldo); }
            } else {
                switch (mode) {
                    case 0: TE_CALL(0); break;
                    case 1: TE_CALL(1); break;
                    case 2: TE_CALL(2); break;
                    case 3: TE_CALL(3); break;
                    case 4: TE_CALL(4); break;
                    case 5: TE_CALL(5); break;
                    case 6: TE_CALL(6); break;
                    case 7: TE_CALL(7); break;
                    default: TE_CALL(8); break;
                }
            }
        }
    }
}

__device__ void conv_T(const float* src, const float* src2, int ldsrc, bf16_t* dst, int K, int N, int Kpad, int Npad, int mode, LAS float* tile) {
    const int tid = otid();
    const int tk = Kpad / 256, tn = Npad / 64, ntile = tk * tn;
    for (int ti = obid(); ti < ntile; ti += gridDim.x) {
        const int R0 = (ti / tk) * 64, k0 = (ti % tk) * 256;
        f32x4 v[4][2];
#pragma unroll
        for (int sub = 0; sub < 4; ++sub)
#pragma unroll
            for (int pass = 0; pass < 2; ++pass) {
                const int kr = (tid >> 4) + pass * 32, c4 = (tid & 15) * 4;
                const int k = k0 + sub * 64 + kr, R = R0 + c4;
                v[sub][pass] = (f32x4){0.f, 0.f, 0.f, 0.f};
                if (k < K && R < N) {
                    const float* s; int col;
                    if (mode == 1) { const int g = R >> 5, wi = R & 31; s = wi < 16 ? src : src2; col = 16 * g + (wi & 15); }
                    else { s = src; col = R; }
                    v[sub][pass] = __builtin_nontemporal_load((const f32x4*)(s + (size_t)k * ldsrc + col));
                }
            }
        __syncthreads();
#pragma unroll
        for (int sub = 0; sub < 4; ++sub)
#pragma unroll
            for (int pass = 0; pass < 2; ++pass) {
                const int kr = (tid >> 4) + pass * 32, c4 = (tid & 15) * 4;
                LAS float* t = tile + sub * (64 * 65) + kr * 65 + c4;
                t[0] = v[sub][pass][0]; t[1] = v[sub][pass][1]; t[2] = v[sub][pass][2]; t[3] = v[sub][pass][3];
            }
        __syncthreads();
        const int Rr = tid >> 3, k8 = (tid & 7) * 8;
#pragma unroll
        for (int sub = 0; sub < 4; ++sub) {
            float e[8];
#pragma unroll
            for (int i = 0; i < 8; ++i) e[i] = tile[sub * (64 * 65) + (k8 + i) * 65 + Rr];
            u32x4 o; o.x = cvt_pk_bf16(e[0], e[1]); o.y = cvt_pk_bf16(e[2], e[3]); o.z = cvt_pk_bf16(e[4], e[5]); o.w = cvt_pk_bf16(e[6], e[7]);
            *(u32x4*)(dst + (size_t)(R0 + Rr) * Kpad + k0 + sub * 64 + k8) = o;
        }
    }
}

struct CJ { int in0, in1, ldsrc, K, N, Kpad, Npad, mode; unsigned long long soff, doff; };
struct CJTab { CJ j[4][14]; int n[4]; };
constexpr CJ mkcj(int in0, int in1, unsigned long long soff, int ldsrc, unsigned long long doff, int K, int N, int Kpad, int Npad, int mode) {
    CJ c{}; c.in0 = in0; c.in1 = in1; c.ldsrc = ldsrc; c.K = K; c.N = N; c.Kpad = Kpad; c.Npad = Npad; c.mode = mode; c.soff = soff; c.doff = doff; return c;
}
constexpr CJTab make_cjtab() {
    CJTab t{};
    const unsigned long long DD = (unsigned long long)D * D, DF = (unsigned long long)D * FF;
    for (int layer = 0; layer < 4; ++layer) {
        int n = 0;
        if (layer < 2) {
            const unsigned long long i = layer;
            t.j[layer][n++] = mkcj(8, 8, i * DD, D, OFF_WA + WA_W0, D, D, D, D, 0);
            t.j[layer][n++] = mkcj(9, 9, i * DD, D, OFF_WA + WA_W1, D, D, D, D, 0);
            t.j[layer][n++] = mkcj(10, 10, i * DD, D, OFF_WA + WA_W2, D, D, D, D, 0);
            t.j[layer][n++] = mkcj(13, 13, i * D * 96, 96, OFF_WA + WA_L1 + 0 * WSLOT, D, 96, D, 256, 0);
            t.j[layer][n++] = mkcj(16, 16, i * D * 96, 96, OFF_WA + WA_L1 + 1 * WSLOT, D, 96, D, 256, 0);
            t.j[layer][n++] = mkcj(18, 18, i * D * 256, 256, OFF_WA + WA_L1 + 2 * WSLOT, D, 256, D, 256, 0);
            t.j[layer][n++] = mkcj(14, 14, i * 96 * D, D, OFF_WA + WA_L2 + 0 * WSLOT, 96, D, 256, D, 0);
            t.j[layer][n++] = mkcj(17, 17, i * 96 * D, D, OFF_WA + WA_L2 + 1 * WSLOT, 96, D, 256, D, 0);
            t.j[layer][n++] = mkcj(19, 19, i * 256 * D, D, OFF_WA + WA_L2 + 2 * WSLOT, 256, D, 256, D, 0);
            if (layer >= 1) {
                t.j[layer][n++] = mkcj(26, 26, (i - 1) * D * 64, 64, OFF_WA + WA_L1 + 3 * WSLOT, D, 64, D, 256, 0);
                t.j[layer][n++] = mkcj(27, 27, (i - 1) * 64 * D, D, OFF_WA + WA_L2 + 3 * WSLOT, 64, D, 256, D, 0);
            }
            t.j[layer][n++] = mkcj(11, 11, i * DD, D, OFF_WB + WB_WO, D, D, D, D, 0);
        } else {
            const unsigned long long jj = layer - 2;
            t.j[layer][n++] = mkcj(32, 32, jj * DD, D, OFF_WA + WA_W0, D, D, D, D, 0);
            if (layer == 2) {
                t.j[layer][n++] = mkcj(29, 29, 0, D, OFF_WA + WA_W1, D, D, D, D, 0);
                t.j[layer][n++] = mkcj(30, 30, 0, D, OFF_WA + WA_W2, D, D, D, D, 0);
            }
            t.j[layer][n++] = mkcj(34, 34, jj * DD, D, OFF_WB + WB_WO, D, D, D, D, 0);
        }
        t.j[layer][n++] = mkcj(4, 5, (unsigned long long)layer * DF, FF, OFF_WB + WB_F1, D, 2 * FF, D, 2 * FF, 1);
        t.j[layer][n++] = mkcj(6, 6, (unsigned long long)layer * DF, D, OFF_WB + WB_F2, FF, D, FF, D, 0);
        t.n[layer] = n;
    }
    return t;
}
__constant__ const CJTab CJT = make_cjtab();

__device__ void convert_layer(const Params& P, int layer, LAS unsigned char* lds) {
    LAS float* tile = (LAS float*)lds;
    const int nj = CJT.n[layer];
    for (int q = 0; q < nj; ++q) {
        const CJ* c = &CJT.j[layer][q];
        conv_T(P.in[c->in0] + c->soff, P.in[c->in1] + c->soff, c->ldsrc, (bf16_t*)(P.ws + c->doff), c->K, c->N, c->Kpad, c->Npad, c->mode, tile);
    }
}

__device__ void init_phase(const Params& P) {
    const f32x4* x = (const f32x4*)P.in[0]; f32x4* o = (f32x4*)P.out;
    const size_t n4 = (size_t)MMAIN * D / 4;
    for (size_t i = (size_t)obid() * NTHR + otid(); i < n4; i += (size_t)gridDim.x * NTHR) o[i] = x[i];
    const f32x4* mt = (const f32x4*)P.in[1]; f32x4* ht = (f32x4*)(P.ws + OFF_HT);
    const int m4 = NBATCH * NMETA * D / 4, per = NMETA * D / 4;
    for (int i = obid() * NTHR + otid(); i < m4; i += gridDim.x * NTHR) ht[i] = mt[i % per];
}

__device__ void mixprep_phase(const Params& P, int i, LAS unsigned char* lds) {
    const int tid_ = otid(); const int w = tid_ >> 6, lane = tid_ & 63;
    const float* g = P.in[2] + (size_t)i * D;
    const float* mu = P.in[7] + (size_t)i * 6 * D;
    LAS f32x4* pl = (LAS f32x4*)lds;
    __syncthreads();
    for (int q = tid_; q < 7 * (D / 4); q += NTHR) { const int v = q / (D / 4), c = q % (D / 4); pl[q] = *(const f32x4*)((v == 0 ? g : mu + (size_t)(v - 1) * D) + 4 * c); }
    __syncthreads();
    bf16_t* const ob[6] = {(bf16_t*)(P.ws + OFF_MIX), (bf16_t*)(P.ws + OFF_DEC), (bf16_t*)(P.ws + OFF_MIX + SZB), (bf16_t*)(P.ws + OFF_MIX + 2 * SZB),
                           (bf16_t*)(P.ws + OFF_DEC + SZB), (bf16_t*)(P.ws + OFF_KF)};
    for (int idx = obid() * 8 + w; idx < M; idx += gridDim.x * 8) {
        const int b = idx / L, t = idx % L;
        const int r = rowof(b, t), rprev = rowof(b, t > 0 ? t - 1 : 0);
        const float* hc; const float* hp;
        if (i == 0) {
            hc = r < MMAIN ? P.in[0] + (size_t)r * D : P.in[1] + (size_t)((r - MMAIN) & 15) * D;
            hp = rprev < MMAIN ? P.in[0] + (size_t)rprev * D : P.in[1] + (size_t)((rprev - MMAIN) & 15) * D;
        } else { hc = hrow(P, r); hp = hrow(P, rprev); }
        float* hw = hrow(P, r);
        f32x4 c[8], p[8]; float sc = 0.f, sp = 0.f;
#pragma unroll
        for (int q = 0; q < 8; ++q) { c[q] = *(const f32x4*)(hc + 256 * q + 4 * lane); p[q] = *(const f32x4*)(hp + 256 * q + 4 * lane);
            sc += c[q][0] * c[q][0] + c[q][1] * c[q][1] + c[q][2] * c[q][2] + c[q][3] * c[q][3];
            sp += p[q][0] * p[q][0] + p[q][1] * p[q][1] + p[q][2] * p[q][2] + p[q][3] * p[q][3]; }
        if (i == 0) {
#pragma unroll
            for (int q = 0; q < 8; ++q) *(f32x4*)(hw + 256 * q + 4 * lane) = c[q];
        }
        sc = wavesum(sc); sp = wavesum(sp);
        const float rc = rsqrtf(sc * (1.0f / D) + 1e-6f);
        const float rp = t > 0 ? rsqrtf(sp * (1.0f / D) + 1e-6f) : 0.f;
#pragma unroll
        for (int q = 0; q < 8; ++q) {
            const int col = 256 * q + 4 * lane;
            const f32x4 gv = pl[col >> 2];
            f32x4 hn, xx;
#pragma unroll
            for (int e = 0; e < 4; ++e) { hn[e] = c[q][e] * rc * gv[e]; xx[e] = p[q][e] * rp * gv[e] - hn[e]; }
#pragma unroll
            for (int j = 0; j < 6; ++j) {
                const f32x4 m = pl[(j + 1) * (D / 4) + (col >> 2)];
                u32x2 a; a.x = cvt_pk_bf16(hn[0] + xx[0] * m[0], hn[1] + xx[1] * m[1]); a.y = cvt_pk_bf16(hn[2] + xx[2] * m[2], hn[3] + xx[3] * m[3]);
                *(u32x2*)(ob[j] + (size_t)r * D + col) = a;
            }
        }
    }
}

__device__ void norm_phase(const Params& P, const float* g1, bf16_t* o1, const float* g2, bf16_t* o2, LAS unsigned char* lds) {
    const int tid_ = otid(); const int w = tid_ >> 6, lane = tid_ & 63;
    LAS f32x4* pl = (LAS f32x4*)lds;
    __syncthreads();
    for (int q = tid_; q < 2 * (D / 4); q += NTHR) { const int v = q / (D / 4), c = q % (D / 4); pl[q] = (v == 0 || g2) ? *(const f32x4*)((v == 0 ? g1 : g2) + 4 * c) : (f32x4){0.f, 0.f, 0.f, 0.f}; }
    __syncthreads();
    for (int r = obid() * 8 + w; r < M; r += gridDim.x * 8) {
        const float* hc = hrow(P, r);
        f32x4 c[8]; float sc = 0.f;
#pragma unroll
        for (int q = 0; q < 8; ++q) { c[q] = *(const f32x4*)(hc + 256 * q + 4 * lane); sc += c[q][0] * c[q][0] + c[q][1] * c[q][1] + c[q][2] * c[q][2] + c[q][3] * c[q][3]; }
        sc = wavesum(sc);
        const float rc = rsqrtf(sc * (1.0f / D) + 1e-6f);
#pragma unroll
        for (int q = 0; q < 8; ++q) {
            const int col = 256 * q + 4 * lane;
            const f32x4 gv = pl[col >> 2];
            u32x2 a; a.x = cvt_pk_bf16(c[q][0] * rc * gv[0], c[q][1] * rc * gv[1]); a.y = cvt_pk_bf16(c[q][2] * rc * gv[2], c[q][3] * rc * gv[3]);
            *(u32x2*)(o1 + (size_t)r * D + col) = a;
            if (g2) { const f32x4 g2v = pl[(D / 4) + (col >> 2)];
                u32x2 bq; bq.x = cvt_pk_bf16(c[q][0] * rc * g2v[0], c[q][1] * rc * g2v[1]); bq.y = cvt_pk_bf16(c[q][2] * rc * g2v[2], c[q][3] * rc * g2v[3]);
                *(u32x2*)(o2 + (size_t)r * D + col) = bq; }
        }
    }
}

__device__ void scan_phase(const Params& P, int i, LAS unsigned char* lds) {
    const int tid = otid(), w = tid >> 6, lane = tid & 63;
    const bf16_t* RB = (const bf16_t*)(P.ws + OFF_RB); const bf16_t* KF = (const bf16_t*)(P.ws + OFF_KF);
    const bf16_t* VF = (const bf16_t*)(P.ws + (i == 0 ? OFF_VFIRST : OFF_VF)); const float* DEC = (const float*)(P.ws + OFF_DEC);
    const bf16_t* AB = (const bf16_t*)(P.ws + OFF_MIX); bf16_t* YB = (bf16_t*)(P.ws + OFF_MIX + 2 * SZB);
    const float* k_k = P.in[20] + (size_t)i * D; const float* k_a = P.in[21] + (size_t)i * D; const float* r_k = P.in[22] + (size_t)i * D;
    float* SBON = (float*)(P.ws + OFF_LORA);
    LAS float* fl = (LAS float*)lds;
    constexpr int STG = 11264;
    LAS float* ybuf = fl + 2 * STG;
    typedef float f32x2 __attribute__((ext_vector_type(2)));
    const int wu = __builtin_amdgcn_readfirstlane(w);
    const int kg = lane & 15, rp = 4 * (wu & 3) + (lane >> 4);
    const int lt = tid & 255;
    const int lc = (lt & 15) * 4, vt = lt >> 3, vc = (lt & 7) * 4;
    constexpr int NCH = (L + 31) / 32;
    for (int u = obid(); u < 256; u += gridDim.x) {
        const int bh = u >> 1, rh = u & 1, b = bh >> 5, h = bh & 31;
        f32x4 kkp = (f32x4){0.f, 0.f, 0.f, 0.f}, kap = kkp, rkp = kkp;
        f32x4 gk[2], gd[2], gv; u32x2 gr[2], ga[2];
        __syncthreads();
#define SCAN_LOAD(cc) do { _Pragma("unroll") for (int q_ = 0; q_ < 2; ++q_) { const int t_ = 32 * (cc) + (lt >> 4) + 16 * q_; \
              gk[q_] = (f32x4){0.f, 0.f, 0.f, 0.f}; gd[q_] = gk[q_]; gr[q_] = (u32x2){0u, 0u}; ga[q_] = gr[q_]; \
              if (t_ < L) { const size_t o_ = (size_t)rowof(b, t_) * D + 64 * h + lc; { const u32x2 kr_ = *(const u32x2*)(KF + o_); gk[q_][0] = bf_lo(kr_.x); gk[q_][1] = bf_hi(kr_.x); gk[q_][2] = bf_lo(kr_.y); gk[q_][3] = bf_hi(kr_.y); } gd[q_] = *(const f32x4*)(DEC + o_); gr[q_] = *(const u32x2*)(RB + o_); ga[q_] = *(const u32x2*)(AB + o_); } } \
            { const int tv_ = 32 * (cc) + vt; gv = (f32x4){0.f, 0.f, 0.f, 0.f}; if (tv_ < L) { const u32x2 vr_ = *(const u32x2*)(VF + (size_t)rowof(b, tv_) * D + 64 * h + 32 * rh + vc); gv[0] = bf_lo(vr_.x); gv[1] = bf_hi(vr_.x); gv[2] = bf_lo(vr_.y); gv[3] = bf_hi(vr_.y); } } } while (0)
#define SCAN_STORE(st, cc) do { LAS float* s_ = fl + (st) * STG; _Pragma("unroll") for (int q_ = 0; q_ < 2; ++q_) { const int o_ = ((lt >> 4) + 16 * q_) * 64 + lc; \
              f32x4 kr_ = gk[q_] * kkp; float ss_ = kr_[0] * kr_[0] + kr_[1] * kr_[1] + kr_[2] * kr_[2] + kr_[3] * kr_[3]; ss_ = rowsum16(ss_); \
              const float inv_ = rsqrtf(fmaxf(ss_, 1e-24f)); \
              f32x4 av_; av_[0] = bf_lo(ga[q_].x); av_[1] = bf_hi(ga[q_].x); av_[2] = bf_lo(ga[q_].y); av_[3] = bf_hi(ga[q_].y); \
              f32x4 rv_; rv_[0] = bf_lo(gr[q_].x); rv_[1] = bf_hi(gr[q_].x); rv_[2] = bf_lo(gr[q_].y); rv_[3] = bf_hi(gr[q_].y); \
              const f32x4 kk_ = kr_ * inv_; f32x4 kp_; \
              for (int e_ = 0; e_ < 4; ++e_) kp_[e_] = gk[q_][e_] * (1.0f + (av_[e_] - 1.0f) * kap[e_]); \
              *(LAS f32x4*)(s_ + o_) = rv_; *(LAS f32x4*)(s_ + 2048 + o_) = gd[q_]; *(LAS f32x4*)(s_ + 4096 + o_) = kp_; \
              *(LAS f32x4*)(s_ + 6144 + o_) = kk_; *(LAS f32x4*)(s_ + 8192 + o_) = kk_ * av_; \
              float sb_ = rv_[0] * kp_[0] * rkp[0] + rv_[1] * kp_[1] * rkp[1] + rv_[2] * kp_[2] * rkp[2] + rv_[3] * kp_[3] * rkp[3]; sb_ = rowsum16(sb_); \
              { const int tb_ = 32 * (cc) + (lt >> 4) + 16 * q_; if (rh == 0 && (lt & 15) == 0 && tb_ < L) SBON[(size_t)rowof(b, tb_) * 32 + h] = sb_; } } \
            *(LAS f32x4*)(s_ + 10240 + vt * 32 + vc) = gv; } while (0)
#define SCAN_FLUSH(cc) do { const LAS float* yb_ = ybuf + ((cc) & 1) * 1024; _Pragma("unroll") for (int q_ = 0; q_ < 2; ++q_) { const int ft_ = (lt >> 4) + 16 * q_, fv_ = (lt & 15) * 2; const int tt_ = 32 * (cc) + ft_; \
              if (tt_ < L) { const unsigned pk_ = cvt_pk_bf16(yb_[ft_ * 32 + fv_], yb_[ft_ * 32 + fv_ + 1]); *(unsigned*)(YB + (size_t)rowof(b, tt_) * D + 64 * h + 32 * rh + fv_) = pk_; } } } while (0)
        if (wu >= 4) {
            kkp = *(const f32x4*)(k_k + 64 * h + lc); kap = *(const f32x4*)(k_a + 64 * h + lc); rkp = *(const f32x4*)(r_k + 64 * h + lc);
            SCAN_LOAD(0); SCAN_STORE(0, 0);
            SCAN_LOAD(1);
        }
        __syncthreads();
        f32x2 SA01 = {0.f, 0.f}, SA23 = SA01, SB01 = SA01, SB23 = SA01;
        for (int c = 0; c < NCH; ++c) {
            if (wu < 4) {
                const LAS float* s = fl + (c & 1) * STG;
                LAS float* yb = ybuf + (c & 1) * 1024;
                const int ns = (L - 32 * c) < 32 ? (L - 32 * c) : 32;
                for (int tb = 0; tb < ns; tb += 16) {
                    float ykA = 0.f, ykB = 0.f;
#pragma unroll
                    for (int j = 0; j < 16; ++j) {
                        const int t = tb + j;
                        const int o = t * 64 + 4 * kg;
                        const f32x4 r4 = *(const LAS f32x4*)(s + o), d4 = *(const LAS f32x4*)(s + 2048 + o), kp4 = *(const LAS f32x4*)(s + 4096 + o);
                        const f32x4 kk4 = *(const LAS f32x4*)(s + 6144 + o), ka4 = *(const LAS f32x4*)(s + 8192 + o);
                        const f32x2 vv = *(const LAS f32x2*)(s + 10240 + t * 32 + 2 * rp);
                        const f32x2 kk01 = {kk4[0], kk4[1]}, kk23 = {kk4[2], kk4[3]}, ka01 = {ka4[0], ka4[1]}, ka23 = {ka4[2], ka4[3]};
                        const f32x2 kp01 = {kp4[0], kp4[1]}, kp23 = {kp4[2], kp4[3]}, d01 = {d4[0], d4[1]}, d23 = {d4[2], d4[3]}, r01 = {r4[0], r4[1]}, r23 = {r4[2], r4[3]};
                        f32x2 pA = SA01 * kk01; pA = SA23 * kk23 + pA;
                        f32x2 pB = SB01 * kk01; pB = SB23 * kk23 + pB;
                        const float saA = -rowsum16(pA.x + pA.y), saB = -rowsum16(pB.x + pB.y);
                        f32x2 tA01 = kp01 * vv.x, tA23 = kp23 * vv.x, tB01 = kp01 * vv.y, tB23 = kp23 * vv.y;
                        tA01 = ka01 * saA + tA01; tA23 = ka23 * saA + tA23; tB01 = ka01 * saB + tB01; tB23 = ka23 * saB + tB23;
                        SA01 = SA01 * d01 + tA01; SA23 = SA23 * d23 + tA23; SB01 = SB01 * d01 + tB01; SB23 = SB23 * d23 + tB23;
                        f32x2 qA = SA01 * r01; qA = SA23 * r23 + qA;
                        f32x2 qB = SB01 * r01; qB = SB23 * r23 + qB;
                        const float yA = rowsum16(qA.x + qA.y), yB = rowsum16(qB.x + qB.y);
                        ykA = (kg == j) ? yA : ykA; ykB = (kg == j) ? yB : ykB;
                    }
                    { f32x2 yy = {ykA, ykB}; *(LAS f32x2*)(yb + (tb + kg) * 32 + 2 * rp) = yy; }
                }
            } else {
                if (c + 1 < NCH) SCAN_STORE((c + 1) & 1, c + 1);
                if (c + 2 < NCH) SCAN_LOAD(c + 2);
                if (c >= 1) SCAN_FLUSH(c - 1);
            }
            __syncthreads();
        }
        if (wu >= 4) SCAN_FLUSH(NCH - 1);
#undef SCAN_LOAD
#undef SCAN_STORE
#undef SCAN_FLUSH
    }
}

__device__ void post_phase(const Params& P, int i) {
    const int tid_ = otid(); const int w = tid_ >> 6, lane = tid_ & 63;
    const bf16_t* VF = (const bf16_t*)(P.ws + (i == 0 ? OFF_VFIRST : OFF_VF)); const float* SBON = (const float*)(P.ws + OFF_LORA);
    const bf16_t* GB = (const bf16_t*)(P.ws + OFF_MIX + SZB); bf16_t* YB = (bf16_t*)(P.ws + OFF_MIX + 2 * SZB);
    const float* gn_w = P.in[23] + (size_t)i * D; const float* gn_b = P.in[24] + (size_t)i * D;
    for (int r = obid() * 8 + w; r < M; r += gridDim.x * 8) {
#pragma unroll
        for (int q = 0; q < 8; ++q) {
            const int col = 256 * q + 4 * lane; const size_t o = (size_t)r * D + col;
            const u32x2 yv = *(const u32x2*)(YB + o), gv = *(const u32x2*)(GB + o);
            const u32x2 vr_ = *(const u32x2*)(VF + o); f32x4 vv; vv[0] = bf_lo(vr_.x); vv[1] = bf_hi(vr_.x); vv[2] = bf_lo(vr_.y); vv[3] = bf_hi(vr_.y);
            const float sb = SBON[(size_t)r * 32 + 4 * q + (lane >> 4)];
            const f32x4 gw = *(const f32x4*)(gn_w + col), gb = *(const f32x4*)(gn_b + col);
            float y[4] = {bf_lo(yv.x), bf_hi(yv.x), bf_lo(yv.y), bf_hi(yv.y)};
            const float gg[4] = {bf_lo(gv.x), bf_hi(gv.x), bf_lo(gv.y), bf_hi(gv.y)};
            float sy = (y[0] + y[1]) + (y[2] + y[3]);
            sy = rowsum16(sy);
            const float mean = sy * (1.0f / 64.0f);
            float sv = 0.f;
#pragma unroll
            for (int e = 0; e < 4; ++e) { y[e] -= mean; sv += y[e] * y[e]; }
            sv = rowsum16(sv);
            const float rstd = rsqrtf(sv * (1.0f / 64.0f) + 64e-5f);
            float z[4];
#pragma unroll
            for (int e = 0; e < 4; ++e) z[e] = (y[e] * rstd * gw[e] + gb[e] + sb * vv[e]) * gg[e];
            u32x2 zo; zo.x = cvt_pk_bf16(z[0], z[1]); zo.y = cvt_pk_bf16(z[2], z[3]);
            *(u32x2*)(YB + o) = zo;
        }
    }
}

__device__ void headnorm_phase(const Params& P, LAS unsigned char* lds) {
    const int tid = otid(), w = tid >> 6, lane = tid & 63;
    const bf16_t* KR = (const bf16_t*)(P.ws + OFF_KF); const bf16_t* VR = (const bf16_t*)(P.ws + OFF_VF);
    bf16_t* KN = (bf16_t*)(P.ws + OFF_MIX + 2 * SZB); bf16_t* VT = (bf16_t*)(P.ws + OFF_DEC);
    const float* kg = P.in[31];
    for (int r = obid() * 8 + w; r < M; r += gridDim.x * 8) {
#pragma unroll
        for (int q = 0; q < 8; ++q) {
            const int col = 256 * q + 4 * lane; const size_t o = (size_t)r * D + col;
            const u32x2 kraw = *(const u32x2*)(KR + o); f32x4 kv; kv[0] = bf_lo(kraw.x); kv[1] = bf_hi(kraw.x); kv[2] = bf_lo(kraw.y); kv[3] = bf_hi(kraw.y);
            float ss = kv[0] * kv[0] + kv[1] * kv[1] + kv[2] * kv[2] + kv[3] * kv[3];
            ss = rowsum16(ss); ss += __shfl_xor(ss, 16);
            const float rs = rsqrtf(ss * (1.0f / 128.0f) + 1e-6f);
            const f32x4 gv = *(const f32x4*)(kg + (col & 127));
            u32x2 a; a.x = cvt_pk_bf16(kv[0] * rs * gv[0], kv[1] * rs * gv[1]); a.y = cvt_pk_bf16(kv[2] * rs * gv[2], kv[3] * rs * gv[3]);
            *(u32x2*)(KN + o) = a;
        }
    }
    LAS float* tile = (LAS float*)lds;
    for (int it = obid(); it < NBATCH * 66 * 16; it += gridDim.x) {
        const int h = it & 15, pt = (it >> 4) % 66, b = it / (16 * 66);
        __syncthreads();
#pragma unroll
        for (int pass = 0; pass < 4; ++pass) {
            const int key = (tid >> 5) + pass * 16, c4 = (tid & 31) * 4;
            const int t = 64 * pt + key - PPAD;
            f32x4 v = (f32x4){0.f, 0.f, 0.f, 0.f};
            if (t >= 0) { const u32x2 vraw = *(const u32x2*)(VR + (size_t)rowof(b, t) * D + 128 * h + c4); v[0] = bf_lo(vraw.x); v[1] = bf_hi(vraw.x); v[2] = bf_lo(vraw.y); v[3] = bf_hi(vraw.y); }
            tile[key * 129 + c4] = v[0]; tile[key * 129 + c4 + 1] = v[1]; tile[key * 129 + c4 + 2] = v[2]; tile[key * 129 + c4 + 3] = v[3];
        }
        __syncthreads();
        const int d = tid >> 2, k16 = (tid & 3) * 16;
        float e[16];
#pragma unroll
        for (int x = 0; x < 16; ++x) e[x] = tile[(k16 + x) * 129 + d];
        u32x4 o0, o1;
        o0.x = cvt_pk_bf16(e[0], e[1]); o0.y = cvt_pk_bf16(e[2], e[3]); o0.z = cvt_pk_bf16(e[4], e[5]); o0.w = cvt_pk_bf16(e[6], e[7]);
        o1.x = cvt_pk_bf16(e[8], e[9]); o1.y = cvt_pk_bf16(e[10], e[11]); o1.z = cvt_pk_bf16(e[12], e[13]); o1.w = cvt_pk_bf16(e[14], e[15]);
        bf16_t* dst = VT + ((size_t)((b * 16 + h) * 128 + d)) * PLEN + 64 * pt + k16;
        *(u32x4*)dst = o0; *(u32x4*)(dst + 8) = o1;
    }
}

__device__ void attn_phase(const Params& P, int j, LAS unsigned char* lds) {
    const int tid = otid(), w = tid >> 6, lane = tid & 63, fr = lane & 15, fq = lane >> 4;
    const bf16_t* QF = (const bf16_t*)(P.ws + OFF_RB);
    const bf16_t* KN = (const bf16_t*)(P.ws + OFF_MIX + 2 * SZB);
    const bf16_t* VT = (const bf16_t*)(P.ws + OFF_DEC);
    bf16_t* OB = (bf16_t*)(P.ws + OFF_MIX);
    const float* qg = P.in[33] + j * 128;
    constexpr int KSTR = 272, VSTR = 144, KBYTES = 64 * KSTR, VBYTES = 128 * VSTR, STGB = KBYTES + VBYTES;
#define ATT_LOADX(kt_, b_, h_, bh_, KR_, VR_) do { _Pragma("unroll") for (int i_ = 0; i_ < 2; ++i_) { const int id_ = tid + 512 * i_; \
            { const int row_ = id_ >> 4, c_ = id_ & 15; const int tk_ = 64 * (kt_) + row_ - PPAD; \
              KR_[i_] = *(const u32x4*)(KN + (size_t)rowof((b_), tk_ > 0 ? tk_ : 0) * D + 128 * (h_) + 8 * c_); } \
            { const int d_ = id_ >> 3, c_ = id_ & 7; VR_[i_] = *(const u32x4*)(VT + ((size_t)((bh_) * 128 + d_)) * PLEN + 64 * (kt_) + 8 * c_); } } } while (0)
#define ATT_PREFETCH(u_) do { const int qb_ = 32 - (u_) / 64, bh_ = (u_) % 64, b_ = bh_ >> 4, h_ = bh_ & 15; const int tq_ = 128 * qb_ + 16 * w + fr - PPAD; \
            const bf16_t* qp_ = QF + (size_t)rowof(b_, tq_ > 0 ? tq_ : 0) * D + 128 * h_ + 8 * fq; \
            _Pragma("unroll") for (int s_ = 0; s_ < 4; ++s_) nq[s_] = *(const u32x4*)(qp_ + 32 * s_); \
            ATT_LOADX(2 * qb_ + 1, b_, h_, bh_, nk, nv); } while (0)
    u32x4 nq[4], nk[2], nv[2];
    { const int u0 = obid(); if (u0 < 64 * 33) ATT_PREFETCH(u0); }
    for (int u = obid(); u < 64 * 33; u += gridDim.x) {
        const int qb = 32 - u / 64, bh = u % 64, b = bh >> 4, h = bh & 15;
        const int pq = 128 * qb + 16 * w + fr, tq = pq - PPAD;
        const int qrow = rowof(b, tq > 0 ? tq : 0);
        bf16x8 qf[4];
        u32x4 kr[2], vr[2];
        u32x4 cq[4];
#pragma unroll
        for (int s = 0; s < 4; ++s) cq[s] = nq[s];
        kr[0] = nk[0]; kr[1] = nk[1]; vr[0] = nv[0]; vr[1] = nv[1];
        { const int un = u + (int)gridDim.x; if (un < 64 * 33) ATT_PREFETCH(un); }
        {
            f32x4 qa[4], qc[4]; float ss = 0.f;
#pragma unroll
            for (int s = 0; s < 4; ++s) { const u32x4 qraw = cq[s];
                qa[s][0] = bf_lo(qraw.x); qa[s][1] = bf_hi(qraw.x); qa[s][2] = bf_lo(qraw.y); qa[s][3] = bf_hi(qraw.y); qc[s][0] = bf_lo(qraw.z); qc[s][1] = bf_hi(qraw.z); qc[s][2] = bf_lo(qraw.w); qc[s][3] = bf_hi(qraw.w);
                ss += qa[s][0] * qa[s][0] + qa[s][1] * qa[s][1] + qa[s][2] * qa[s][2] + qa[s][3] * qa[s][3] + qc[s][0] * qc[s][0] + qc[s][1] * qc[s][1] + qc[s][2] * qc[s][2] + qc[s][3] * qc[s][3]; }
            ss += __shfl_xor(ss, 16); ss += __shfl_xor(ss, 32);
            const float rs = rsqrtf(ss * (1.0f / 128.0f) + 1e-6f) * 0.08838834764831845f;
#pragma unroll
            for (int s = 0; s < 4; ++s) {
                const f32x4 g0 = *(const f32x4*)(qg + 32 * s + 8 * fq), g1 = *(const f32x4*)(qg + 32 * s + 8 * fq + 4);
                u32x4 pk; pk.x = cvt_pk_bf16(qa[s][0] * rs * g0[0], qa[s][1] * rs * g0[1]); pk.y = cvt_pk_bf16(qa[s][2] * rs * g0[2], qa[s][3] * rs * g0[3]);
                pk.z = cvt_pk_bf16(qc[s][0] * rs * g1[0], qc[s][1] * rs * g1[1]); pk.w = cvt_pk_bf16(qc[s][2] * rs * g1[2], qc[s][3] * rs * g1[3]);
                qf[s] = __builtin_bit_cast(bf16x8, pk);
            }
        }
        f32x4 oacc[8];
#pragma unroll
        for (int x = 0; x < 8; ++x) oacc[x] = (f32x4){0.f, 0.f, 0.f, 0.f};
        float carry = 1.0f;
#define ATT_LOAD(kt_) do { _Pragma("unroll") for (int i_ = 0; i_ < 2; ++i_) { const int id_ = tid + 512 * i_; \
            { const int row_ = id_ >> 4, c_ = id_ & 15; const int tk_ = 64 * (kt_) + row_ - PPAD; \
              kr[i_] = *(const u32x4*)(KN + (size_t)rowof(b, tk_ > 0 ? tk_ : 0) * D + 128 * h + 8 * c_); } \
            { const int d_ = id_ >> 3, c_ = id_ & 7; vr[i_] = *(const u32x4*)(VT + ((size_t)(bh * 128 + d_)) * PLEN + 64 * (kt_) + 8 * c_); } } } while (0)
#define ATT_WRITE(st_) do { _Pragma("unroll") for (int i_ = 0; i_ < 2; ++i_) { const int id_ = tid + 512 * i_; \
            *(LAS u32x4*)(lds + (st_) * STGB + (id_ >> 4) * KSTR + 16 * (id_ & 15)) = kr[i_]; \
            *(LAS u32x4*)(lds + (st_) * STGB + KBYTES + (id_ >> 3) * VSTR + 16 * (id_ & 7)) = vr[i_]; } } while (0)
        const int nti = 2 * qb + 1;
        __syncthreads();
        ATT_WRITE(0);
        __syncthreads();
        for (int it = 0; it < nti; ++it) {
            const int kt = nti - it;
            if (it + 1 < nti) ATT_LOAD(kt - 1);
            const LAS unsigned char* Ks = lds + (it & 1) * STGB; const LAS unsigned char* Vs = Ks + KBYTES;
            f32x4 st[4];
#pragma unroll
            for (int n = 0; n < 4; ++n) { st[n] = (f32x4){0.f, 0.f, 0.f, 0.f};
#pragma unroll
                for (int s = 0; s < 4; ++s) { const bf16x8 a = *(const LAS bf16x8*)(Ks + (16 * n + fr) * KSTR + 64 * s + 16 * fq);
                    st[n] = __builtin_amdgcn_mfma_f32_16x16x32_bf16(a, qf[s], st[n], 0, 0, 0); } }
            const bool need_mask = (kt >= 2 * qb) || (kt == 1);
            float kp[4][4], sg[4][4];
#pragma unroll
            for (int n = 0; n < 4; ++n)
#pragma unroll
                for (int e = 0; e < 4; ++e) { const float z = st[n][e]; const float ex = __expf(-fabsf(z)); const float r = __builtin_amdgcn_rcpf(1.0f + ex);
                    const bool pos = z >= 0.f; sg[n][e] = (pos ? 1.0f : ex) * r; kp[n][e] = (pos ? ex : 1.0f) * r; }
            if (need_mask) {
#pragma unroll
                for (int n = 0; n < 4; ++n)
#pragma unroll
                    for (int e = 0; e < 4; ++e) { const int pk = 64 * kt + 16 * n + 4 * fq + e; const bool valid = (pk < pq) && (pk >= PPAD);
                        if (!valid) { kp[n][e] = 1.0f; sg[n][e] = 0.f; } }
            }
            float X[4], Bt[4];
            {
                LAS f32x4* xch = (LAS f32x4*)(lds + 2 * STGB) + w * 64;
                f32x4 Tv;
#pragma unroll
                for (int n = 0; n < 4; ++n) Tv[n] = (kp[n][0] * kp[n][1]) * (kp[n][2] * kp[n][3]);
                xch[lane] = Tv;
                const f32x4 t0 = xch[fr], t1 = xch[fr + 16], t2 = xch[fr + 32], t3 = xch[fr + 48];
#pragma unroll
                for (int n = 0; n < 4; ++n) {
                    X[n] = (fq < 1 ? t1[n] : 1.0f) * (fq < 2 ? t2[n] : 1.0f) * (fq < 3 ? t3[n] : 1.0f);
                    Bt[n] = (t0[n] * t1[n]) * (t2[n] * t3[n]);
                }
            }
            float wgt[4][4]; float run = carry;
#pragma unroll
            for (int n = 3; n >= 0; --n) { const float s3 = run * X[n]; const float s2 = s3 * kp[n][3]; const float s1 = s2 * kp[n][2]; const float s0 = s1 * kp[n][1];
                wgt[n][3] = sg[n][3] * s3; wgt[n][2] = sg[n][2] * s2; wgt[n][1] = sg[n][1] * s1; wgt[n][0] = sg[n][0] * s0;
                run *= Bt[n]; }
            carry = run;
#pragma unroll
            for (int s2 = 0; s2 < 2; ++s2) {
                u32x4 pk; pk.x = cvt_pk_bf16(wgt[2 * s2][0], wgt[2 * s2][1]); pk.y = cvt_pk_bf16(wgt[2 * s2][2], wgt[2 * s2][3]);
                pk.z = cvt_pk_bf16(wgt[2 * s2 + 1][0], wgt[2 * s2 + 1][1]); pk.w = cvt_pk_bf16(wgt[2 * s2 + 1][2], wgt[2 * s2 + 1][3]);
                const bf16x8 pf = __builtin_bit_cast(bf16x8, pk);
#pragma unroll
                for (int db = 0; db < 8; ++db) {
                    const LAS unsigned char* vp = Vs + (16 * db + fr) * VSTR + 64 * s2 + 8 * fq;
                    const u32x2 v0 = *(const LAS u32x2*)vp, v1 = *(const LAS u32x2*)(vp + 32);
                    u32x4 vv; vv.x = v0.x; vv.y = v0.y; vv.z = v1.x; vv.w = v1.y;
                    oacc[db] = __builtin_amdgcn_mfma_f32_16x16x32_bf16(__builtin_bit_cast(bf16x8, vv), pf, oacc[db], 0, 0, 0);
                }
            }
            if (it + 1 < nti) ATT_WRITE((it + 1) & 1);
#ifndef NO_EARLY_EXIT
            LAS int* flg = (LAS int*)(lds + 2 * STGB + 8192) + (it & 1) * 8;
            { const int dead = __all(carry == 0.f); if (lane == 0) flg[w] = dead; }
            __syncthreads();
            { int alld = 1;
#pragma unroll
              for (int x = 0; x < 8; ++x) alld &= flg[x];
              if (alld) break; }
#else
            __syncthreads();
#endif
        }
#undef ATT_LOAD
#undef ATT_WRITE
        if (tq >= 0) {
#pragma unroll
            for (int db = 0; db < 8; ++db) { u32x2 o; o.x = cvt_pk_bf16(oacc[db][0], oacc[db][1]); o.y = cvt_pk_bf16(oacc[db][2], oacc[db][3]);
                *(u32x2*)(OB + (size_t)qrow * D + 128 * h + 16 * db + 4 * fq) = o; }
        }
    }
}

#define XB_TMO      128
#define XB_XCNT(j)  (256  + 64 * (j))
#define XB_XSUB(j)  (1280 + 64 * (j))
#define XB_XGEN(j)  (2304 + 64 * (j))
#define XB_TOP      3328
#define XB_TOPGEN   3392
#define XCD_BAR_WORDS 3456
#define XB_SPIN_CAP (1u << 18)

__device__ __forceinline__ unsigned xb_ld(unsigned* p)              { return __hip_atomic_load(p, __ATOMIC_RELAXED, __HIP_MEMORY_SCOPE_AGENT); }
__device__ __forceinline__ unsigned xb_add(unsigned* p, unsigned v) { return __hip_atomic_fetch_add(p, v, __ATOMIC_RELAXED, __HIP_MEMORY_SCOPE_AGENT); }
__device__ __forceinline__ unsigned xb_xcc_id() { return (unsigned)__builtin_amdgcn_s_getreg((3 << 11) | 20) & 0xFu; }
#define XB_SPIN(cond, bar) do { unsigned _sp = 0; while (cond) { __builtin_amdgcn_s_sleep(1); \
    if ((++_sp & 255u) == 0u) { if (xb_ld(&(bar)[XB_TMO])) break; if (_sp > XB_SPIN_CAP) { atomicAdd(&(bar)[XB_TMO], 1u); break; } } } } while (0)

struct XcdBarrier {
    unsigned* bar; unsigned x;
    volatile LAS unsigned* st;
};

__device__ __forceinline__ XcdBarrier xcd_barrier_post(unsigned* bar, volatile LAS unsigned* st) {
    XcdBarrier b; b.bar = bar; b.x = xb_xcc_id(); b.st = st;
    if (threadIdx.x == 0) (void)xb_add(&bar[XB_XCNT(b.x)], 1u);
    return b;
}
__device__ __forceinline__ void xcd_barrier_complete(unsigned* bar, unsigned x, unsigned& nloc, unsigned& nx) {
    const unsigned G = gridDim.x * gridDim.y * gridDim.z;
    unsigned sum, cnt, mine, sp = 0u;
    for (;;) {
        sum = 0u; cnt = 0u; mine = 0u;
#pragma unroll
        for (unsigned j = 0; j < 16; ++j) { const unsigned c = xb_ld(&bar[XB_XCNT(j)]); sum += c; cnt += (c > 0u) ? 1u : 0u; mine = (j == x) ? c : mine; }
        if (sum == G) break;
        __builtin_amdgcn_s_sleep(1);
        if ((++sp & 255u) == 0u) { if (xb_ld(&bar[XB_TMO])) break; if (sp > XB_SPIN_CAP) { atomicAdd(&bar[XB_TMO], 1u); break; } }
    }
    nloc = mine > 0u ? mine : 1u; nx = cnt > 0u ? cnt : 1u;
}

__device__ __forceinline__ void xcd_barrier(const XcdBarrier& b) {
    asm volatile("s_waitcnt vmcnt(0)" ::: "memory");
    __syncthreads();
    if (threadIdx.x == 0) {
        unsigned* bar = b.bar;
        __builtin_amdgcn_s_waitcnt(0);
        unsigned nloc = b.st[0], nx = b.st[1];
        if (nloc == 0u) { xcd_barrier_complete(bar, b.x, nloc, nx); b.st[0] = nloc; b.st[1] = nx; }
        const unsigned old = xb_add(&bar[XB_XSUB(b.x)], 1u);
        const unsigned gen = old / nloc;
        if (old + 1u == (gen + 1u) * nloc) {
            __builtin_amdgcn_fence(__ATOMIC_RELEASE, "agent");
            asm volatile("s_waitcnt vmcnt(0)" ::: "memory");
            const unsigned og = xb_add(&bar[XB_TOP], 1u);
            const unsigned tg = og / nx;
            if (og + 1u == (tg + 1u) * nx) xb_add(&bar[XB_TOPGEN], 1u);
            else XB_SPIN(xb_ld(&bar[XB_TOPGEN]) == tg, bar);
            __builtin_amdgcn_fence(__ATOMIC_ACQUIRE, "agent");
            xb_add(&bar[XB_XGEN(b.x)], 1u);
            asm volatile("s_waitcnt vmcnt(0)" ::: "memory");
        } else {
            XB_SPIN(xb_ld(&bar[XB_XGEN(b.x)]) == gen, bar);
            __builtin_amdgcn_fence(__ATOMIC_ACQUIRE, "agent");
            asm volatile("s_waitcnt vmcnt(0)" ::: "memory");
        }
    }
    __syncthreads();
}


__device__ __forceinline__ void grid_barrier(unsigned* ctr, unsigned target) {
    asm volatile("s_waitcnt vmcnt(0) lgkmcnt(0)" ::: "memory");
    __syncthreads();
    if (threadIdx.x == 0) {
        __builtin_amdgcn_fence(__ATOMIC_RELEASE, "agent");
        asm volatile("s_waitcnt vmcnt(0)" ::: "memory");
        __hip_atomic_fetch_add(ctr, 1u, __ATOMIC_RELAXED, __HIP_MEMORY_SCOPE_AGENT);
        while (__hip_atomic_load(ctr, __ATOMIC_RELAXED, __HIP_MEMORY_SCOPE_AGENT) < target) __builtin_amdgcn_s_sleep(2);
        __builtin_amdgcn_fence(__ATOMIC_ACQUIRE, "agent");
        asm volatile("s_waitcnt vmcnt(0)" ::: "memory");
    }
    __syncthreads();
}

#ifndef DUP_ATTN
#define DUP_ATTN 0
#endif
#ifndef DUP_FFN1
#define DUP_FFN1 0
#endif
#ifndef DUP_SCAN
#define DUP_SCAN 0
#endif
constexpr int NPHASE = 35 + 2 * DUP_ATTN + 4 * DUP_FFN1 + 2 * DUP_SCAN;
enum { K_INIT = 0, K_MIXPREP, K_GEMM, K_SCAN, K_POST, K_NORMF, K_NORMSB, K_HEADNORM, K_ATTN };
struct Tab { PE e[NPHASE]; };
constexpr GD mkgd(size_t A, size_t Bt, int N, int mode, size_t o0, size_t o1, int bin, int boff, int ldo) {
    GD g{}; g.A = A; g.Bt = Bt; g.o0 = o0; g.o1 = o1; g.N = N; g.mode = mode; g.bin = bin; g.boff = boff; g.ldo = ldo; g.pad = 0; return g;
}
constexpr PE mkgemm(int layer, int sub) {
    PE p{}; p.kind = K_GEMM; p.layer = layer; p.sub = sub; p.ng = 1; p.K = D; p.pad = 0;
    const int i = layer;
    for (int q = 0; q < 4; ++q) p.g[q] = mkgd(0, 0, 256, 0, 0, 0, 0, 0, D);
    if (sub == 0) {
        p.g[0] = mkgd(OFF_MIX, OFF_WA + WA_W0, D, 0, OFF_RB, 0, 0, 0, D);
        p.g[1] = mkgd(OFF_MIX + SZB, OFF_WA + WA_W1, D, 0, OFF_KF, 0, 0, 0, D);
        p.g[2] = mkgd(OFF_MIX + 2 * SZB, OFF_WA + WA_W2, D, 0, i == 0 ? OFF_VFIRST : OFF_VF, 0, 0, 0, D);
        p.ng = 3;
    } else if (sub == 1) {
        p.g[0] = mkgd(OFF_DEC, OFF_WA + WA_L1 + 0 * WSLOT, 256, 3, OFF_LORA + 0 * SZLORA, 0, 0, 0, 256);
        p.g[1] = mkgd(OFF_DEC + SZB, OFF_WA + WA_L1 + 1 * WSLOT, 256, 0, OFF_LORA + 1 * SZLORA, 0, 0, 0, 256);
        p.g[2] = mkgd(OFF_KF, OFF_WA + WA_L1 + 2 * WSLOT, 256, 4, OFF_LORA + 2 * SZLORA, 0, 0, 0, 256);
        p.ng = 3;
        if (i >= 1) { p.g[3] = mkgd(OFF_MIX + 2 * SZB, OFF_WA + WA_L1 + 3 * WSLOT, 256, 0, OFF_LORA + 3 * SZLORA, 0, 0, 0, 256); p.ng = 4; }
    } else if (sub == 2) {
        p.K = 256;
        p.g[0] = mkgd(OFF_LORA + 0 * SZLORA, OFF_WA + WA_L2 + 0 * WSLOT, D, 5, OFF_DEC, 0, 12, i * D, D);
        p.g[1] = mkgd(OFF_LORA + 1 * SZLORA, OFF_WA + WA_L2 + 1 * WSLOT, D, 6, OFF_MIX, 0, 15, i * D, D);
        p.g[2] = mkgd(OFF_LORA + 2 * SZLORA, OFF_WA + WA_L2 + 2 * WSLOT, D, 0, OFF_MIX + SZB, 0, 0, 0, D);
        p.ng = 3;
        if (i >= 1) { p.g[3] = mkgd(OFF_LORA + 3 * SZLORA, OFF_WA + WA_L2 + 3 * WSLOT, D, 7, OFF_VF, OFF_VFIRST, 25, (i - 1) * D, D); p.ng = 4; }
    } else if (sub == 3) {
        p.g[0] = mkgd(OFF_MIX + 2 * SZB, OFF_WB + WB_WO, D, 8, 0, 0, 0, 0, D);
    } else if (sub == 4) {
        p.g[0] = mkgd(OFF_HN2, OFF_WB + WB_F1, 2 * FF, 9, OFF_ACT, 0, 0, 0, FF);
    } else if (sub == 5) {
        p.K = FF;
        p.g[0] = mkgd(OFF_ACT, OFF_WB + WB_F2, D, 8, 0, 0, 0, 0, D);
    } else if (sub == 6) {
        p.g[0] = mkgd(OFF_MIX, OFF_WA + WA_W0, D, 0, OFF_RB, 0, 0, 0, D);
        if (layer == 2) {
            p.g[1] = mkgd(OFF_MIX + SZB, OFF_WA + WA_W1, D, 0, OFF_KF, 0, 0, 0, D);
            p.g[2] = mkgd(OFF_MIX + SZB, OFF_WA + WA_W2, D, 0, OFF_VF, 0, 0, 0, D);
            p.ng = 3;
        }
    } else {
        p.g[0] = mkgd(OFF_MIX, OFF_WB + WB_WO, D, 8, 0, 0, 0, 0, D);
    }
    return p;
}
constexpr PE mkother(int kind, int layer, int sub) { PE p{}; p.kind = kind; p.layer = layer; p.sub = sub; p.ng = 0; p.K = D; p.pad = 0; for (int q = 0; q < 4; ++q) p.g[q] = mkgd(0, 0, 256, 0, 0, 0, 0, 0, D); return p; }
constexpr Tab make_tab() {
    Tab t{};
    int n = 0;
    for (int i = 0; i < 2; ++i) {
        t.e[n++] = mkother(K_MIXPREP, i, 0);
        t.e[n++] = mkgemm(i, 1);
        t.e[n++] = mkgemm(i, 0);
        t.e[n++] = mkgemm(i, 2);
        t.e[n++] = mkother(K_SCAN, i, 0);
        if (DUP_SCAN) t.e[n++] = mkother(K_SCAN, i, 0);
        t.e[n++] = mkother(K_POST, i, 0);
        t.e[n++] = mkgemm(i, 3);
        t.e[n++] = mkother(K_NORMF, i, 0);
        t.e[n++] = mkgemm(i, 4);
        if (DUP_FFN1) t.e[n++] = mkgemm(i, 4);
        t.e[n++] = mkgemm(i, 5);
    }
    for (int j = 0; j < 2; ++j) {
        const int layer = 2 + j;
        t.e[n++] = mkother(K_NORMSB, layer, 0);
        t.e[n++] = mkgemm(layer, 6);
        if (j == 0) t.e[n++] = mkother(K_HEADNORM, layer, 0);
        t.e[n++] = mkother(K_ATTN, layer, 0);
        if (DUP_ATTN) t.e[n++] = mkother(K_ATTN, layer, 0);
        t.e[n++] = mkgemm(layer, 7);
        t.e[n++] = mkother(K_NORMF, layer, 0);
        t.e[n++] = mkgemm(layer, 4);
        if (DUP_FFN1) t.e[n++] = mkgemm(layer, 4);
        t.e[n++] = mkgemm(layer, 5);
    }
    return t;
}
__constant__ const Tab TAB = make_tab();

#ifndef ONLY
#define ONLY -1
#endif
#define EN(k) (ONLY < 0 || ONLY == (k))

__global__ void __launch_bounds__(512, 2) mk_forward(Params P, int ph_lo, int ph_hi) {
    extern __shared__ __attribute__((aligned(16))) unsigned char shm[];
    LAS unsigned char* lds = (LAS unsigned char*)shm;
    cg::grid_group grid = cg::this_grid();
    __shared__ uint4 xb_words;
    if (threadIdx.x == 0) xb_words = make_uint4(0u, 0u, 0u, 0u);
    unsigned* const xbar = (unsigned*)(P.ws + WS_END);
    XcdBarrier xb; xb.bar = xbar; xb.x = 0; xb.st = (volatile LAS unsigned*)&xb_words;
    for (int ph = ph_lo; ph < ph_hi; ++ph) {
        const PE* pe = &TAB.e[ph];
        const int kind = pe->kind, layer = pe->layer, sub = pe->sub;
        if (kind == K_GEMM) { if (EN(K_GEMM)) {
            const bool tail_first = (blockIdx.x & 1) != 0;
            if (tail_first) { tail_gemm(lds, pe, P); __syncthreads(); }
            gemm_phase(lds, pe, P);
            if (!tail_first) tail_gemm(lds, pe, P); } }
        else if (!EN(kind)) {}
        else if (kind == K_MIXPREP) { mixprep_phase(P, layer, lds); convert_layer(P, layer, lds); }
        else if (kind == K_SCAN) scan_phase(P, layer, lds);
        else if (kind == K_POST) post_phase(P, layer);
        else if (kind == K_NORMF) norm_phase(P, P.in[3] + (size_t)layer * D, (bf16_t*)(P.ws + OFF_HN2), nullptr, nullptr, lds);
        else if (kind == K_NORMSB) {
            norm_phase(P, P.in[2] + (size_t)layer * D, (bf16_t*)(P.ws + OFF_MIX), layer == 2 ? P.in[28] : nullptr, (bf16_t*)(P.ws + OFF_MIX + SZB), lds);
            convert_layer(P, layer, lds);
        }
        else if (kind == K_HEADNORM) { if (layer == 2) headnorm_phase(P, lds); }
        else if (kind == K_ATTN) attn_phase(P, layer - 2, lds);
        if (ph + 1 < ph_hi) {
#ifdef USE_CG_SYNC
            grid.sync();
#else
            if (ph == ph_lo) {
                if (blockIdx.x == 0) for (int q = threadIdx.x; q < XCD_BAR_WORDS; q += NTHR) __hip_atomic_store(xbar + q, 0u, __ATOMIC_RELAXED, __HIP_MEMORY_SCOPE_AGENT);
                grid.sync();
                xb = xcd_barrier_post(xbar, (volatile LAS unsigned*)&xb_words);
            }
            else xcd_barrier(xb);
#endif
        }
    }
}

__global__ void dbg_copy(Params P, size_t off_bf16a, size_t off_bf16b, size_t off_f32) {
    const size_t n = (size_t)MMAIN * D;
    for (size_t i = (size_t)blockIdx.x * blockDim.x + threadIdx.x; i < n; i += (size_t)gridDim.x * blockDim.x) {
        float v = 0.f;
        if (off_bf16a) v += __uint_as_float(((unsigned)((const bf16_t*)(P.ws + off_bf16a))[i]) << 16);
        if (off_bf16b) v += __uint_as_float(((unsigned)((const bf16_t*)(P.ws + off_bf16b))[i]) << 16);
        if (off_f32) v += ((const float*)(P.ws + off_f32))[i];
        P.out[i] = v;
    }
}
extern "C" void kernel_launch(void* const* d_in, const int* in_sizes, int n_in, void* d_out, int out_size, void* d_ws, size_t ws_size, hipStream_t stream) {
    constexpr size_t kDynLds = 131072;
    static int grid_blocks = 0;
    if (!grid_blocks) {
        hipFuncSetAttribute((const void*)mk_forward, hipFuncAttributeMaxDynamicSharedMemorySize, (int)kDynLds);
        int dev = 0, cus = 0, per_cu = 0;
        hipGetDevice(&dev);
        hipDeviceGetAttribute(&cus, hipDeviceAttributeMultiprocessorCount, dev);
        hipOccupancyMaxActiveBlocksPerMultiprocessor(&per_cu, mk_forward, NTHR, kDynLds);
        if (per_cu < 1) per_cu = 1;
        grid_blocks = cus * per_cu;
        if (ws_size < WS_END) fprintf(stderr, "workspace too small: %zu < %zu\n", ws_size, (size_t)WS_END);
    }
    Params p{};
    for (int i = 0; i < 35; ++i) p.in[i] = (const float*)d_in[i];
    p.out = (float*)d_out; p.ws = (unsigned char*)d_ws;
#ifdef MULTI_LAUNCH
    for (int ph = 0; ph < NPHASE; ++ph) hipLaunchKernelGGL(mk_forward, dim3(grid_blocks), dim3(NTHR), kDynLds, stream, p, ph, ph + 1);
#ifdef DBG_A
    hipLaunchKernelGGL(dbg_copy, dim3(2048), dim3(256), 0, stream, p, (size_t)DBG_A, (size_t)DBG_B, (size_t)DBG_F);
#endif
#else
    int lo = 0, hi = NPHASE;
    void* args[] = {&p, &lo, &hi};
    hipError_t e = hipLaunchCooperativeKernel((void*)mk_forward, dim3(grid_blocks), dim3(NTHR), args, kDynLds, stream);
    if (e != hipSuccess) fprintf(stderr, "cooperative launch failed: %s (grid %d)\n", hipGetErrorString(e), grid_blocks);
#endif
}
```
